# Optimizing an MI355X kernel written in HIP

```python
import math
import jax, jax.numpy as jnp
from jax import lax
import numpy as np

D_MODEL = 4096
BATCH = 2
SEQ = 8192
DEPTH = 1

N_META = 16
CHUNK = 128
Q_BLOCK = 128
H_RET = 16
RET_DK = D_MODEL // H_RET
RET_DV = D_MODEL // H_RET
RET_W = H_RET * RET_DV
DIFF_HD = 128
H_DIFF = D_MODEL // (2 * DIFF_HD)
DIFF_W = H_DIFF * 2 * DIFF_HD
D_FF = ((8 * D_MODEL + 3 * 256 - 1) // (3 * 256)) * 256
EPS = 1e-6
SPLIT_SIZES = (H_RET * RET_DK, H_RET * RET_DK, RET_W, RET_W,
               DIFF_W, DIFF_W, DIFF_W,
               D_MODEL, D_MODEL)
D_IN = sum(SPLIT_SIZES)
SPLIT_POINTS = tuple(int(v) for v in np.cumsum(SPLIT_SIZES)[:-1])

kernel_name = "hybrid_retention_diffattn_gated_encoder"


def _rmsnorm(x, g):
    x32 = x.astype(jnp.float32)
    y = x32 * lax.rsqrt(jnp.mean(x32 * x32, axis=-1, keepdims=True) + EPS)
    return (y * g.astype(jnp.float32)).astype(x.dtype)


def _unit_rms(x32):
    return x32 * lax.rsqrt(jnp.mean(x32 * x32, axis=-1, keepdims=True) + EPS)


def _lambda_init(layer):
    return 0.8 - 0.6 * math.exp(-0.3 * layer)


def _retention_scan(q, k, v, log_g, include_diag):
    b, h, t, dk = q.shape
    dv = v.shape[-1]
    n = t // CHUNK
    idx = jnp.arange(CHUNK, dtype=jnp.float32)
    dist = idx[:, None] - idx[None, :]
    keep = (dist >= 0) if include_diag else (dist > 0)
    intra = jnp.where(keep[None], jnp.exp(log_g[:, None, None] * jnp.maximum(dist, 0.0)[None]), 0.0)
    q_dec = jnp.exp(log_g[:, None] * (idx + 1.0)[None])[..., None]
    k_dec = jnp.exp(log_g[:, None] * (CHUNK - 1.0 - idx)[None])[..., None]
    c_dec = jnp.exp(log_g * CHUNK)[:, None, None]

    def chunks(a):
        return a.reshape(b, h, n, CHUNK, a.shape[-1]).transpose(2, 0, 1, 3, 4)

    def step(state, qkv):
        qc, kc, vc = qkv
        scores = jnp.einsum('bhid,bhjd->bhij', qc, kc) * intra
        out = (jnp.einsum('bhij,bhjv->bhiv', scores, vc)
               + jnp.einsum('bhid,bhdv->bhiv', qc * q_dec, state))
        state = state * c_dec + jnp.einsum('bhjd,bhjv->bhdv', kc * k_dec, vc)
        return state, out

    s0 = jnp.zeros((b, h, dk, dv), jnp.float32)
    _, out = lax.scan(step, s0, (chunks(q), chunks(k), chunks(v)))
    return out.transpose(1, 2, 0, 3, 4).reshape(b, h, t, dv)


def _retention_branch(q, k, v, g, log_decay_param, w_branch):
    b, l, _ = q.shape
    pad = CHUNK - N_META

    def heads(a, d):
        a = a.astype(jnp.float32).reshape(b, l, H_RET, d).transpose(0, 2, 1, 3)
        return jnp.pad(a, ((0, 0), (0, 0), (pad, 0), (0, 0)))

    qh = heads(q, RET_DK)
    kh = heads(k, RET_DK) * (RET_DK ** -0.5)
    vh = heads(v, RET_DV)
    log_g = -jnp.exp(log_decay_param.astype(jnp.float32))
    fwd = _retention_scan(qh, kh, vh, log_g[0], True)
    rev = lambda a: a[:, :, ::-1]
    bwd = rev(_retention_scan(rev(qh), rev(kh), rev(vh), log_g[1], False))
    y = _unit_rms((fwd + bwd)[:, :, pad:])
    y = y.transpose(0, 2, 1, 3).reshape(b, l, RET_W).astype(q.dtype)
    return (jax.nn.silu(g) * y) @ w_branch


def _diff_attn_branch(q, k, v, lam_params, subln_g, lam_init, w_branch):
    b, l, _ = q.shape
    qh = q.reshape(b, l, H_DIFF, 2, DIFF_HD).transpose(0, 2, 3, 1, 4) * (DIFF_HD ** -0.5)
    kh = k.reshape(b, l, H_DIFF, 2, DIFF_HD).transpose(0, 2, 3, 1, 4)
    vh = v.reshape(b, l, H_DIFF, 2 * DIFF_HD).transpose(0, 2, 1, 3)
    n_blk = -(-l // Q_BLOCK)
    qh = jnp.pad(qh, ((0, 0), (0, 0), (0, 0), (0, n_blk * Q_BLOCK - l), (0, 0)))
    lp = lam_params.astype(jnp.float32)
    lam = jnp.exp(jnp.sum(lp[0] * lp[1])) - jnp.exp(jnp.sum(lp[2] * lp[3])) + lam_init
    slopes = 2.0 ** (-8.0 * jnp.arange(1, H_DIFF + 1, dtype=jnp.float32) / H_DIFF)
    kpos = jnp.arange(l, dtype=jnp.float32)

    def block(i):
        qb = lax.dynamic_slice_in_dim(qh, i * Q_BLOCK, Q_BLOCK, axis=3)
        s = jnp.einsum('bhmqd,bhmkd->bhmqk', qb, kh).astype(jnp.float32)
        qpos = (i * Q_BLOCK + jnp.arange(Q_BLOCK)).astype(jnp.float32)
        alibi = -slopes[:, None, None] * jnp.abs(qpos[:, None] - kpos[None, :])[None]
        p = jax.nn.softmax(s + alibi[None, :, None], axis=-1)
        a = p[:, :, 0] - lam * p[:, :, 1]
        return jnp.einsum('bhqk,bhkv->bhqv', a.astype(vh.dtype), vh)

    o = lax.map(block, jnp.arange(n_blk))
    o = o.transpose(1, 2, 0, 3, 4).reshape(b, H_DIFF, n_blk * Q_BLOCK, 2 * DIFF_HD)[:, :, :l]
    o = _unit_rms(o.astype(jnp.float32)) * subln_g.astype(jnp.float32) * (1.0 - lam_init)
    o = o.transpose(0, 2, 1, 3).reshape(b, l, DIFF_W).astype(q.dtype)
    return o @ w_branch


def setup_inputs(seed: int = 0) -> dict:
    key = jax.random.key(seed)
    ks = jax.random.split(key, 16)
    f32 = jnp.float32
    nrm = lambda k, shape, s: jax.random.normal(k, shape, f32) * s
    heads = jnp.arange(H_RET, dtype=f32)
    base = jnp.log(-jnp.log1p(-(2.0 ** (-5.0 - heads))))
    return {
        "x": nrm(ks[0], (BATCH, SEQ, D_MODEL), 1.0),
        "meta_tokens": nrm(ks[1], (N_META, D_MODEL), 1.0),
        "norm_mix_g": 1.0 + nrm(ks[2], (DEPTH, D_MODEL), 0.02),
        "w_in": nrm(ks[3], (DEPTH, D_MODEL, D_IN), D_MODEL ** -0.5),
        "ret_log_decay": base[None, None, :] + nrm(ks[4], (DEPTH, 2, H_RET), 0.01),
        "diff_lambda": nrm(ks[5], (DEPTH, 4, DIFF_HD), 0.1),
        "diff_subln_g": 1.0 + nrm(ks[6], (DEPTH, 2 * DIFF_HD), 0.02),
        "w_branch_ret": nrm(ks[7], (DEPTH, RET_W, D_MODEL), RET_W ** -0.5),
        "w_branch_diff": nrm(ks[8], (DEPTH, DIFF_W, D_MODEL), DIFF_W ** -0.5),
        "w_out": nrm(ks[9], (DEPTH, D_MODEL, D_MODEL), D_MODEL ** -0.5),
        "norm_ffn_g": 1.0 + nrm(ks[10], (DEPTH, D_MODEL), 0.02),
        "w_ffn_gate": nrm(ks[11], (DEPTH, D_MODEL, D_FF), D_MODEL ** -0.5),
        "w_ffn_up": nrm(ks[12], (DEPTH, D_MODEL, D_FF), D_MODEL ** -0.5),
        "w_ffn_down": nrm(ks[13], (DEPTH, D_FF, D_MODEL), D_FF ** -0.5),
        "norm_final_g": 1.0 + nrm(ks[14], (D_MODEL,), 0.02),
    }


def reference(x, meta_tokens, norm_mix_g, w_in, ret_log_decay, diff_lambda, diff_subln_g,
              w_branch_ret, w_branch_diff, w_out, norm_ffn_g, w_ffn_gate, w_ffn_up, w_ffn_down,
              norm_final_g):
    b = x.shape[0]
    meta = jnp.broadcast_to(meta_tokens[None].astype(x.dtype), (b, N_META, D_MODEL))
    h = jnp.concatenate([meta, x], axis=1)
    for layer in range(DEPTH):
        u = _rmsnorm(h, norm_mix_g[layer])
        proj = u @ w_in[layer]
        rq, rk, rv, rg, dq, dk, dv, ga, gb = jnp.split(proj, SPLIT_POINTS, axis=-1)
        y_ret = _retention_branch(rq, rk, rv, rg, ret_log_decay[layer], w_branch_ret[layer])
        y_diff = _diff_attn_branch(dq, dk, dv, diff_lambda[layer], diff_subln_g[layer],
                                   _lambda_init(layer), w_branch_diff[layer])
        mixed = jax.nn.sigmoid(ga) * y_ret + jax.nn.sigmoid(gb) * y_diff
        h = h + mixed @ w_out[layer]
        u = _rmsnorm(h, norm_ffn_g[layer])
        h = h + (jax.nn.silu(u @ w_ffn_gate[layer]) * (u @ w_ffn_up[layer])) @ w_ffn_down[layer]
    return _rmsnorm(h, norm_final_g)[:, N_META:]
```

```cpp
#include <hip/hip_runtime.h>
#include <cstdio>
#include <cstdint>
#define LAS __attribute__((address_space(3)))
namespace pg8 {
#define PG8_LAS __attribute__((address_space(3)))
typedef unsigned short bf16_t;
typedef short bf16x8 __attribute__((ext_vector_type(8)));
typedef float f32x4 __attribute__((ext_vector_type(4)));
typedef unsigned u32x4 __attribute__((ext_vector_type(4)));
constexpr int BM = 256, BK = 64, HALF = 128, HTB = HALF * BK * 2  , STAGE_BYTES = 8 * HTB, NXCD = 8, WGM = 8;

__host__ __device__ __forceinline__ int lds_byte(int r, int c) { const int st = (r >> 4) * 2 + (c >> 5), rr = r & 15, cc = c & 31, ob = rr * 64 + cc * 2; return st * 1024 + (ob ^ (((ob >> 9) & 1) << 5)); }
__host__ __device__ __forceinline__ void stage_rc(int b, int& R, int& C) { const int st = b / 1024, sb = b % 1024, swz = sb ^ (((sb >> 9) & 1) << 5); R = (st >> 1) * 16 + swz / 64; C = (st & 1) * 32 + (swz % 64) / 2; }
__host__ __device__ __forceinline__ int perm32(int rho) { const int n = rho >> 4, i = rho & 15; return 8 * (i >> 2) + 4 * n + (i & 3); }

struct Unit { int pm, pn; };
struct Gemm { const bf16_t* A; const bf16_t* Bt; int M, N, K; };

struct StaticOrder {
    int nM, nN, nwg, G, c, wgm = WGM;
    __host__ __device__ void init(int M, int N, int G_, int c_, int wgm_ = WGM) { nM = M / BM; nN = N / BM; nwg = nM * nN; G = G_; c = c_; wgm = wgm_; }
    __host__ __device__ bool next(int i, Unit& u) const {
        const long L = (long)i * G + c; if (L >= nwg) return false;
        int wgid = (int)L; { const int q = nwg / NXCD, r = nwg % NXCD, xcd = wgid % NXCD, off = wgid / NXCD; wgid = (xcd < r ? xcd * (q + 1) : r * (q + 1) + (xcd - r) * q) + off; }
        const int nig = wgm * nN, gid = wgid / nig, fm = gid * wgm, gsz = (nM - fm) < wgm ? (nM - fm) : wgm;
        u.pm = fm + ((wgid % nig) % gsz); u.pn = (wgid % nig) / gsz; return true;
    }
    __device__ __forceinline__ void a_ready(const Unit&) const {}
    __device__ __forceinline__ void done(const Unit&) const {}
};

__device__ __forceinline__ unsigned cvt_pk_bf16(float lo, float hi) { unsigned r; asm volatile("v_cvt_pk_bf16_f32 %0, %1, %2" : "=v"(r) : "v"(lo), "v"(hi)); return r; }
typedef float f32x2 __attribute__((ext_vector_type(2)));
__device__ __forceinline__ float sigmoid_f(float x) { return __builtin_amdgcn_rcpf(1.0f + __builtin_amdgcn_exp2f(-1.4426950408889634f * x)); }
__device__ __forceinline__ float silu_f(float x) { return x * sigmoid_f(x); }
__device__ __forceinline__ float bf_lo(unsigned w) { return __uint_as_float(w << 16); }
__device__ __forceinline__ float bf_hi(unsigned w) { return __uint_as_float(w & 0xffff0000u); }

struct EpiProj {
    static constexpr bool PERM = true, AFTER_DRAIN = false;
    bf16_t* P; size_t gstride;
    __device__ __forceinline__ void operator()(const f32x4 (&acc)[2][2][4][2], const Unit& u, int wr, int wc, int fr, int fq) const {
        const int t = (u.pn * BM) >> 12, colt = (u.pn * BM) & 4095;
        bf16_t* base = P + (size_t)t * gstride;
        const int mode = (t == 1) ? 1 : (t == 3) ? 2 : (t >= 7) ? 3 : 0;
        const bool hm = t < 4; const int pitch = hm ? 256 : 4096;
        const size_t org = hm ? ((size_t)(((u.pm >> 5) * 16 + (colt >> 8)) * 8192 + (u.pm & 31) * 256) * 256) : ((size_t)(u.pm * BM) * 4096 + colt);
        const int rloc = wr * 64 + fr, col0 = wc * 32 + 8 * fq;
#pragma unroll
        for (int ai = 0; ai < 2; ++ai)
#pragma unroll
            for (int m = 0; m < 4; ++m) { bf16_t* rowp = base + org + (size_t)(rloc + ai * HALF + m * 16) * pitch + col0;
#pragma unroll
                for (int bj = 0; bj < 2; ++bj) { f32x4 v0 = acc[ai][bj][m][0], v1 = acc[ai][bj][m][1];
                    if (mode == 1) { v0 = v0 * 0.0625f; v1 = v1 * 0.0625f; }
                    else if (mode == 2) {
#pragma unroll
                        for (int j = 0; j < 4; ++j) { v0[j] = silu_f(v0[j]); v1[j] = silu_f(v1[j]); } }
                    else if (mode == 3) {
#pragma unroll
                        for (int j = 0; j < 4; ++j) { v0[j] = sigmoid_f(v0[j]); v1[j] = sigmoid_f(v1[j]); } }
                    u32x4 w; w.x = cvt_pk_bf16(v0[0], v0[1]); w.y = cvt_pk_bf16(v0[2], v0[3]); w.z = cvt_pk_bf16(v1[0], v1[1]); w.w = cvt_pk_bf16(v1[2], v1[3]);
                    *(u32x4*)(rowp + bj * HALF) = w; } }
    }
};
struct EpiGateT {
    static constexpr bool PERM = true, AFTER_DRAIN = false;
    const bf16_t* G; float* T;
    __device__ __forceinline__ void operator()(const f32x4 (&acc)[2][2][4][2], const Unit& u, int wr, int wc, int fr, int fq) const {
        const int row0 = u.pm * BM + wr * 64 + fr, col0 = u.pn * BM + wc * 32 + 8 * fq;
#pragma unroll
        for (int ai = 0; ai < 2; ++ai)
#pragma unroll
            for (int m = 0; m < 4; ++m) { const size_t off = (size_t)(row0 + ai * HALF + m * 16) * 4096 + col0;
#pragma unroll
                for (int bj = 0; bj < 2; ++bj) { const u32x4 g = *(const u32x4*)(G + off + bj * HALF);
                    const f32x4 g0 = {bf_lo(g.x), bf_hi(g.x), bf_lo(g.y), bf_hi(g.y)}, g1 = {bf_lo(g.z), bf_hi(g.z), bf_lo(g.w), bf_hi(g.w)};
                    *(f32x4*)(T + off + bj * HALF) = acc[ai][bj][m][0] * g0; *(f32x4*)(T + off + bj * HALF + 4) = acc[ai][bj][m][1] * g1; } }
    }
};
struct EpiMix {
    static constexpr bool PERM = true, AFTER_DRAIN = false;
    const bf16_t* G; const float* T; bf16_t* O;
    __device__ __forceinline__ void operator()(const f32x4 (&acc)[2][2][4][2], const Unit& u, int wr, int wc, int fr, int fq) const {
        const int row0 = u.pm * BM + wr * 64 + fr, col0 = u.pn * BM + wc * 32 + 8 * fq;
#pragma unroll
        for (int ai = 0; ai < 2; ++ai)
#pragma unroll
            for (int m = 0; m < 4; ++m) { const size_t off = (size_t)(row0 + ai * HALF + m * 16) * 4096 + col0;
#pragma unroll
                for (int bj = 0; bj < 2; ++bj) { const u32x4 g = *(const u32x4*)(G + off + bj * HALF);
                    const f32x4 g0 = {bf_lo(g.x), bf_hi(g.x), bf_lo(g.y), bf_hi(g.y)}, g1 = {bf_lo(g.z), bf_hi(g.z), bf_lo(g.w), bf_hi(g.w)};
                    const f32x4 t0 = *(const f32x4*)(T + off + bj * HALF), t1 = *(const f32x4*)(T + off + bj * HALF + 4);
                    const f32x4 v0 = t0 + acc[ai][bj][m][0] * g0, v1 = t1 + acc[ai][bj][m][1] * g1;
                    u32x4 w; w.x = cvt_pk_bf16(v0[0], v0[1]); w.y = cvt_pk_bf16(v0[2], v0[3]); w.z = cvt_pk_bf16(v1[0], v1[1]); w.w = cvt_pk_bf16(v1[2], v1[3]);
                    *(u32x4*)(O + off + bj * HALF) = w; } }
    }
};
struct EpiRes {
    static constexpr bool PERM = false, AFTER_DRAIN = false;
    const float* R; float* C; int ldc;
    __device__ __forceinline__ void operator()(const f32x4 (&acc)[2][2][4][2], const Unit& u, int wr, int wc, int fr, int fq) const {
        const int row0 = u.pm * BM + wr * 64 + fr, col0 = u.pn * BM + wc * 32 + 4 * fq;
#pragma unroll
        for (int ai = 0; ai < 2; ++ai)
#pragma unroll
            for (int m = 0; m < 4; ++m) { const size_t off = (size_t)(row0 + ai * HALF + m * 16) * ldc + col0;
#pragma unroll
                for (int bj = 0; bj < 2; ++bj)
#pragma unroll
                    for (int n = 0; n < 2; ++n) { const f32x4 r = *(const f32x4*)(R + off + bj * HALF + n * 16); *(f32x4*)(C + off + bj * HALF + n * 16) = r + acc[ai][bj][m][n]; } }
    }
};
struct EpiSwiGLU {
    static constexpr bool PERM = true, AFTER_DRAIN = false;
    bf16_t* O; int ldc;
    __device__ __forceinline__ void operator()(const f32x4 (&acc)[2][2][4][2], const Unit& u, int wr, int wc, int fr, int fq) const {
        const int row0 = u.pm * BM + wr * 64 + fr, col0 = u.pn * HALF + wc * 32 + 8 * fq;
#pragma unroll
        for (int ai = 0; ai < 2; ++ai)
#pragma unroll
            for (int m = 0; m < 4; ++m) { bf16_t* rowp = O + (size_t)(row0 + ai * HALF + m * 16) * ldc + col0;
                f32x4 v0, v1;
#pragma unroll
                for (int j = 0; j < 4; ++j) { v0[j] = silu_f(acc[ai][0][m][0][j]) * acc[ai][1][m][0][j]; v1[j] = silu_f(acc[ai][0][m][1][j]) * acc[ai][1][m][1][j]; }
                u32x4 w; w.x = cvt_pk_bf16(v0[0], v0[1]); w.y = cvt_pk_bf16(v0[2], v0[3]); w.z = cvt_pk_bf16(v1[0], v1[1]); w.w = cvt_pk_bf16(v1[2], v1[3]);
                *(u32x4*)rowp = w; }
    }
};

#define GBC(x) fmaxf((x), 7.888609e-31f)
#define GBR(x) __builtin_amdgcn_rcpf(GBC(x))
struct EpiMix2 {
    static constexpr bool PERM = true, AFTER_DRAIN = false;
    const bf16_t* GA; const bf16_t* GB; bf16_t* O;
    __device__ __forceinline__ void mid(f32x4 (&acc)[2][2][4][2], const Unit& u, int wr, int wc, int fr, int fq) const {
        const int row0 = u.pm * BM + wr * 64 + fr, col0 = u.pn * BM + wc * 32 + 8 * fq;
#pragma unroll
        for (int ai = 0; ai < 2; ++ai)
#pragma unroll
            for (int m = 0; m < 4; ++m) { const size_t off = (size_t)(row0 + ai * HALF + m * 16) * 4096 + col0;
#pragma unroll
                for (int bj = 0; bj < 2; ++bj) { const u32x4 a = *(const u32x4*)(GA + off + bj * HALF), b = *(const u32x4*)(GB + off + bj * HALF);
                    const f32x4 r0 = {bf_lo(a.x) * GBR(bf_lo(b.x)), bf_hi(a.x) * GBR(bf_hi(b.x)), bf_lo(a.y) * GBR(bf_lo(b.y)), bf_hi(a.y) * GBR(bf_hi(b.y))};
                    const f32x4 r1 = {bf_lo(a.z) * GBR(bf_lo(b.z)), bf_hi(a.z) * GBR(bf_hi(b.z)), bf_lo(a.w) * GBR(bf_lo(b.w)), bf_hi(a.w) * GBR(bf_hi(b.w))};
                    acc[ai][bj][m][0] = acc[ai][bj][m][0] * r0; acc[ai][bj][m][1] = acc[ai][bj][m][1] * r1; } }
    }
    __device__ __forceinline__ void operator()(const f32x4 (&acc)[2][2][4][2], const Unit& u, int wr, int wc, int fr, int fq) const {
        const int row0 = u.pm * BM + wr * 64 + fr, col0 = u.pn * BM + wc * 32 + 8 * fq;
#pragma unroll
        for (int ai = 0; ai < 2; ++ai)
#pragma unroll
            for (int m = 0; m < 4; ++m) { const size_t off = (size_t)(row0 + ai * HALF + m * 16) * 4096 + col0;
#pragma unroll
                for (int bj = 0; bj < 2; ++bj) { const u32x4 g = *(const u32x4*)(GB + off + bj * HALF);
                    const f32x4 g0 = {GBC(bf_lo(g.x)), GBC(bf_hi(g.x)), GBC(bf_lo(g.y)), GBC(bf_hi(g.y))}, g1 = {GBC(bf_lo(g.z)), GBC(bf_hi(g.z)), GBC(bf_lo(g.w)), GBC(bf_hi(g.w))};
                    const f32x4 v0 = acc[ai][bj][m][0] * g0, v1 = acc[ai][bj][m][1] * g1;
                    u32x4 w; w.x = cvt_pk_bf16(v0[0], v0[1]); w.y = cvt_pk_bf16(v0[2], v0[3]); w.z = cvt_pk_bf16(v1[0], v1[1]); w.w = cvt_pk_bf16(v1[2], v1[3]);
                    *(u32x4*)(O + off + bj * HALF) = w; } }
    }
};
#undef GBC
#undef GBR

struct EpiResBf {
    static constexpr bool PERM = true, AFTER_DRAIN = false;
    const float* X; bf16_t* O; float* PS;
    __device__ __forceinline__ void operator()(const f32x4 (&acc)[2][2][4][2], const Unit& u, int wr, int wc, int fr, int fq) const {
        const int row0 = u.pm * BM + wr * 64 + fr, col0 = u.pn * BM + wc * 32 + 8 * fq;
#pragma unroll
        for (int ai = 0; ai < 2; ++ai)
#pragma unroll
            for (int m = 0; m < 4; ++m) { const int row = row0 + ai * HALF + m * 16; const size_t off = (size_t)row * 4096 + col0; float ss = 0.f;
#pragma unroll
                for (int bj = 0; bj < 2; ++bj) { const f32x4 x0 = *(const f32x4*)(X + off + bj * HALF), x1 = *(const f32x4*)(X + off + bj * HALF + 4);
                    const f32x4 v0 = x0 + acc[ai][bj][m][0], v1 = x1 + acc[ai][bj][m][1];
                    ss += (v0[0] * v0[0] + v0[1] * v0[1]) + (v0[2] * v0[2] + v0[3] * v0[3]) + (v1[0] * v1[0] + v1[1] * v1[1]) + (v1[2] * v1[2] + v1[3] * v1[3]);
                    u32x4 w; w.x = cvt_pk_bf16(v0[0], v0[1]); w.y = cvt_pk_bf16(v0[2], v0[3]); w.z = cvt_pk_bf16(v1[0], v1[1]); w.w = cvt_pk_bf16(v1[2], v1[3]);
                    *(u32x4*)(O + off + bj * HALF) = w; }
                ss += __shfl_xor(ss, 16); ss += __shfl_xor(ss, 32);
                if (fq == 0) PS[(size_t)row * 64 + u.pn * 4 + wc] = ss; }
    }
};
struct EpiSwiGLUr {
    static constexpr bool PERM = true, AFTER_DRAIN = false;
    bf16_t* O; int ldc; const float* RSTD;
    __device__ __forceinline__ void operator()(const f32x4 (&acc)[2][2][4][2], const Unit& u, int wr, int wc, int fr, int fq) const {
        const int row0 = u.pm * BM + wr * 64 + fr, col0 = u.pn * HALF + wc * 32 + 8 * fq;
#pragma unroll
        for (int ai = 0; ai < 2; ++ai)
#pragma unroll
            for (int m = 0; m < 4; ++m) { const int row = row0 + ai * HALF + m * 16; bf16_t* rowp = O + (size_t)row * ldc + col0; const float r = RSTD[row];
                f32x4 v0, v1;
#pragma unroll
                for (int j = 0; j < 4; ++j) { v0[j] = silu_f(acc[ai][0][m][0][j] * r) * (acc[ai][1][m][0][j] * r); v1[j] = silu_f(acc[ai][0][m][1][j] * r) * (acc[ai][1][m][1][j] * r); }
                u32x4 w; w.x = cvt_pk_bf16(v0[0], v0[1]); w.y = cvt_pk_bf16(v0[2], v0[3]); w.z = cvt_pk_bf16(v1[0], v1[1]); w.w = cvt_pk_bf16(v1[2], v1[3]);
                *(u32x4*)rowp = w; }
    }
};
struct EpiResBf2 {
    static constexpr bool PERM = true, AFTER_DRAIN = false;
    const bf16_t* R; bf16_t* O;
    __device__ __forceinline__ void operator()(const f32x4 (&acc)[2][2][4][2], const Unit& u, int wr, int wc, int fr, int fq) const {
        const int row0 = u.pm * BM + wr * 64 + fr, col0 = u.pn * BM + wc * 32 + 8 * fq;
#pragma unroll
        for (int ai = 0; ai < 2; ++ai)
#pragma unroll
            for (int m = 0; m < 4; ++m) { const size_t off = (size_t)(row0 + ai * HALF + m * 16) * 4096 + col0;
#pragma unroll
                for (int bj = 0; bj < 2; ++bj) { const u32x4 r = *(const u32x4*)(R + off + bj * HALF);
                    const f32x4 v0 = acc[ai][bj][m][0] + (f32x4){bf_lo(r.x), bf_hi(r.x), bf_lo(r.y), bf_hi(r.y)}, v1 = acc[ai][bj][m][1] + (f32x4){bf_lo(r.z), bf_hi(r.z), bf_lo(r.w), bf_hi(r.w)};
                    u32x4 w; w.x = cvt_pk_bf16(v0[0], v0[1]); w.y = cvt_pk_bf16(v0[2], v0[3]); w.z = cvt_pk_bf16(v1[0], v1[1]); w.w = cvt_pk_bf16(v1[2], v1[3]);
                    *(u32x4*)(O + off + bj * HALF) = w; } }
    }
};
template <class Epi, class Sched, bool ALIGN_EPI = false, bool SP2 = false>
__device__ __forceinline__ void gemm_phase(PG8_LAS unsigned char* lds, const Gemm g, const Sched& S, const Epi& E) {
    const int tid = threadIdx.x, wid = __builtin_amdgcn_readfirstlane(tid >> 6), lane = tid & 63, wr = wid >> 2, wc = wid & 3, fr = lane & 15, fq = lane >> 4;
    const int K = g.K, nt = K / BK;
    unsigned voffA[2], voffB[2];
#pragma unroll
    for (int i = 0; i < 2; ++i) { int R, C; stage_rc(tid * 16 + i * 8192, R, C); const int Rb = Epi::PERM ? ((R & ~31) + perm32(R & 31)) : R;
        voffA[i] = (unsigned)(R * K + C) * 2u; voffB[i] = (unsigned)(Rb * K + C) * 2u; }
    const size_t kstep = (size_t)(BK * 2);
    const size_t hstep = (size_t)HALF * K * 2;
    const size_t tstep = 2 * hstep;
    const unsigned ldsw = (unsigned)wid * 1024u;
    const int aoff = lds_byte(wr * 64 + fr, fq * 8), boff = lds_byte(wc * 32 + fr, fq * 8);
#define PG8_SA(b, h) (((b) * 2 + (h)) * HTB)
#define PG8_SB(b, h) ((4 + (b) * 2 + (h)) * HTB)
#define PG8_STAGE(bufoff, gbase, voff) do { _Pragma("unroll") for (int _i = 0; _i < 2; ++_i) \
        __builtin_amdgcn_global_load_lds((const unsigned*)((const char*)(gbase) + (voff)[_i]), (PG8_LAS unsigned*)(lds + (bufoff) + ldsw + _i * 8192), 16, 0, 0); } while (0)
#define PG8_LDA(dst, b, h) do { _Pragma("unroll") for (int m = 0; m < 4; ++m) _Pragma("unroll") for (int k = 0; k < 2; ++k) dst[m][k] = *(const PG8_LAS bf16x8*)(lds + PG8_SA(b, h) + aoff + m * 2048 + k * 1024); } while (0)
#define PG8_LDB(dst, b, h) do { _Pragma("unroll") for (int n = 0; n < 2; ++n) _Pragma("unroll") for (int k = 0; k < 2; ++k) dst[n][k] = *(const PG8_LAS bf16x8*)(lds + PG8_SB(b, h) + boff + n * 2048 + k * 1024); } while (0)
#define PG8_MMA(ai, bj, At, Bt) do { __builtin_amdgcn_s_setprio(1); _Pragma("unroll") for (int m = 0; m < 4; ++m) _Pragma("unroll") for (int n = 0; n < 2; ++n) _Pragma("unroll") for (int k = 0; k < 2; ++k) \
        acc[ai][bj][m][n] = __builtin_amdgcn_mfma_f32_16x16x32_bf16(Bt[n][k], At[m][k], acc[ai][bj][m][n], 0, 0, 0); __builtin_amdgcn_s_setprio(0); } while (0)
#define PG8_WAIT_V(n) asm volatile("s_waitcnt vmcnt(" #n ")" ::: "memory")
#define PG8_WAIT_L(n) asm volatile("s_waitcnt lgkmcnt(" #n ")" ::: "memory")
#define PG8_BAR __builtin_amdgcn_s_barrier()
#define PG8_SCHED __builtin_amdgcn_sched_barrier(0)
    Unit cur, nxt; int ui = 0;
    if (!S.next(0, cur)) return;
    f32x4 acc[2][2][4][2];
#pragma unroll
    for (int a = 0; a < 2; ++a)
#pragma unroll
        for (int b = 0; b < 2; ++b)
#pragma unroll
            for (int m = 0; m < 4; ++m)
#pragma unroll
                for (int n = 0; n < 2; ++n) acc[a][b][m][n] = (f32x4){0.f, 0.f, 0.f, 0.f};
    bf16x8 At[4][2], B0[2][2], B1[2][2];
    const char* cA = (const char*)g.A + (size_t)cur.pm * tstep; const char* cB = (const char*)g.Bt + (size_t)cur.pn * tstep;
    S.a_ready(cur);
    if constexpr (SP2) {
        PG8_STAGE(PG8_SB(0, 0), cB, voffB); PG8_STAGE(PG8_SB(0, 1), cB + hstep, voffB); PG8_STAGE(PG8_SA(0, 0), cA, voffA); PG8_STAGE(PG8_SA(0, 1), cA + hstep, voffA);
        if (wr == 1) PG8_BAR;
        PG8_WAIT_V(2); PG8_BAR;
        PG8_STAGE(PG8_SB(1, 0), cB + kstep, voffB); PG8_STAGE(PG8_SA(1, 0), cA + kstep, voffA); PG8_STAGE(PG8_SB(1, 1), cB + hstep + kstep, voffB);
        PG8_WAIT_V(6); PG8_BAR;
    } else {
        PG8_STAGE(PG8_SB(0, 0), cB, voffB); PG8_STAGE(PG8_SA(0, 0), cA, voffA); PG8_STAGE(PG8_SB(0, 1), cB + hstep, voffB); PG8_STAGE(PG8_SA(0, 1), cA + hstep, voffA);
        if (wr == 1) PG8_BAR;
        PG8_WAIT_V(4); PG8_BAR;
        PG8_STAGE(PG8_SB(1, 0), cB + kstep, voffB); PG8_STAGE(PG8_SA(1, 0), cA + kstep, voffA); PG8_STAGE(PG8_SB(1, 1), cB + hstep + kstep, voffB);
        PG8_WAIT_V(6); PG8_BAR;
    }
    for (;;) {
        const bool has_next = S.next(ui + 1, nxt);
        const char* nA = has_next ? (const char*)g.A + (size_t)nxt.pm * tstep : cA; const char* nB = has_next ? (const char*)g.Bt + (size_t)nxt.pn * tstep : cB;
        for (int t = 0; t < nt; t += 2) {
            const bool last = (t == nt - 2);
            const char* a1 = cA + (size_t)(t + 1) * kstep;
            const char* a2 = last ? nA : cA + (size_t)(t + 2) * kstep; const char* b2 = last ? nB : cB + (size_t)(t + 2) * kstep;
            const char* a3 = a2 + kstep; const char* b3 = b2 + kstep;
            if (last && has_next) S.a_ready(nxt);
            if constexpr (SP2) {
            PG8_LDB(B0, 0, 0); PG8_LDB(B1, 0, 1); PG8_SCHED; PG8_LDA(At, 0, 0); PG8_STAGE(PG8_SA(1, 1), a1 + hstep, voffA);
            PG8_WAIT_V(8); PG8_WAIT_L(0); PG8_BAR; PG8_MMA(0, 0, At, B0); PG8_MMA(0, 1, At, B1); PG8_BAR; PG8_SCHED;
            PG8_LDA(At, 0, 1); PG8_STAGE(PG8_SB(0, 0), b2, voffB); PG8_STAGE(PG8_SB(0, 1), b2 + hstep, voffB); PG8_STAGE(PG8_SA(0, 0), a2, voffA);
            PG8_WAIT_V(8); PG8_WAIT_L(0); PG8_BAR; PG8_MMA(1, 0, At, B0); PG8_MMA(1, 1, At, B1); PG8_BAR; PG8_SCHED;
            PG8_LDB(B0, 1, 0); PG8_LDB(B1, 1, 1); PG8_SCHED; PG8_LDA(At, 1, 0); PG8_STAGE(PG8_SA(0, 1), a2 + hstep, voffA);
            PG8_WAIT_V(8); PG8_WAIT_L(0); PG8_BAR; PG8_MMA(0, 0, At, B0); PG8_MMA(0, 1, At, B1); PG8_BAR; PG8_SCHED;
            PG8_LDA(At, 1, 1); PG8_STAGE(PG8_SB(1, 0), b3, voffB); PG8_STAGE(PG8_SB(1, 1), b3 + hstep, voffB); PG8_STAGE(PG8_SA(1, 0), a3, voffA);
            PG8_WAIT_V(8); PG8_WAIT_L(0); PG8_BAR; PG8_MMA(1, 0, At, B0); PG8_MMA(1, 1, At, B1); PG8_BAR; PG8_SCHED;
            } else {
            PG8_LDB(B0, 0, 0); PG8_SCHED; PG8_LDA(At, 0, 0); PG8_STAGE(PG8_SA(1, 1), a1 + hstep, voffA);
            PG8_WAIT_L(8); PG8_BAR; PG8_WAIT_L(0); PG8_MMA(0, 0, At, B0); PG8_BAR; PG8_SCHED;
            PG8_LDB(B1, 0, 1); PG8_STAGE(PG8_SB(0, 0), b2, voffB);
            PG8_BAR; PG8_WAIT_L(0); PG8_MMA(0, 1, At, B1); PG8_BAR;
            PG8_LDA(At, 0, 1); PG8_STAGE(PG8_SA(0, 0), a2, voffA);
            PG8_BAR; PG8_WAIT_L(0); PG8_MMA(1, 0, At, B0); PG8_BAR; PG8_SCHED;
            PG8_STAGE(PG8_SB(0, 1), b2 + hstep, voffB);
            PG8_WAIT_V(6); PG8_BAR; PG8_MMA(1, 1, At, B1); PG8_BAR;
            PG8_LDB(B0, 1, 0); PG8_SCHED; PG8_LDA(At, 1, 0); PG8_STAGE(PG8_SA(0, 1), a2 + hstep, voffA);
            PG8_WAIT_L(8); PG8_BAR; PG8_WAIT_L(0); PG8_MMA(0, 0, At, B0); PG8_BAR; PG8_SCHED;
            PG8_LDB(B1, 1, 1); PG8_STAGE(PG8_SB(1, 0), b3, voffB);
            PG8_BAR; PG8_WAIT_L(0); PG8_MMA(0, 1, At, B1); PG8_BAR;
            PG8_LDA(At, 1, 1); PG8_STAGE(PG8_SA(1, 0), a3, voffA);
            PG8_BAR; PG8_WAIT_L(0); PG8_MMA(1, 0, At, B0); PG8_BAR; PG8_SCHED;
            PG8_STAGE(PG8_SB(1, 1), b3 + hstep, voffB);
            PG8_WAIT_V(6); PG8_BAR; PG8_MMA(1, 1, At, B1); PG8_BAR;
            }
        }
        if constexpr (ALIGN_EPI) { if (wr == 0) PG8_BAR; }
        if constexpr (!Epi::AFTER_DRAIN) { E(acc, cur, wr, wc, fr, fq); S.done(cur); }
        if (!has_next) break;
#pragma unroll
        for (int a = 0; a < 2; ++a)
#pragma unroll
            for (int b = 0; b < 2; ++b)
#pragma unroll
                for (int m = 0; m < 4; ++m)
#pragma unroll
                    for (int n = 0; n < 2; ++n) acc[a][b][m][n] = (f32x4){0.f, 0.f, 0.f, 0.f};
        cur = nxt; cA = nA; cB = nB; ++ui;
        if constexpr (ALIGN_EPI) { if (wr == 1) PG8_BAR; }
    }
    PG8_WAIT_V(0);
    if constexpr (!ALIGN_EPI) { if (wr == 0) PG8_BAR; }
    PG8_BAR;
    if constexpr (Epi::AFTER_DRAIN) { E.fused(acc, cur, wr, wc, fr, fq, lds, wid, lane); S.done(cur); }
#undef PG8_SA
#undef PG8_SB
#undef PG8_STAGE
#undef PG8_LDA
#undef PG8_LDB
#undef PG8_MMA
#undef PG8_WAIT_V
#undef PG8_WAIT_L
#undef PG8_BAR
#undef PG8_SCHED
}
template <class Epi, class Sched, bool ALIGN_EPI = false, bool SP2 = false>
__device__ __forceinline__ void gemm_phase2(PG8_LAS unsigned char* lds, const Gemm g, const Gemm g2, const Sched& S, const Epi& E) {
    const int tid = threadIdx.x, wid = __builtin_amdgcn_readfirstlane(tid >> 6), lane = tid & 63, wr = wid >> 2, wc = wid & 3, fr = lane & 15, fq = lane >> 4;
    const int K = g.K, nt = K / BK;
    unsigned voffA[2], voffB[2];
#pragma unroll
    for (int i = 0; i < 2; ++i) { int R, C; stage_rc(tid * 16 + i * 8192, R, C); const int Rb = Epi::PERM ? ((R & ~31) + perm32(R & 31)) : R;
        voffA[i] = (unsigned)(R * K + C) * 2u; voffB[i] = (unsigned)(Rb * K + C) * 2u; }
    const size_t kstep = (size_t)(BK * 2);
    const size_t hstep = (size_t)HALF * K * 2;
    const size_t tstep = 2 * hstep;
    const unsigned ldsw = (unsigned)wid * 1024u;
    const int aoff = lds_byte(wr * 64 + fr, fq * 8), boff = lds_byte(wc * 32 + fr, fq * 8);
#define PG8_SA(b, h) (((b) * 2 + (h)) * HTB)
#define PG8_SB(b, h) ((4 + (b) * 2 + (h)) * HTB)
#define PG8_STAGE(bufoff, gbase, voff) do { _Pragma("unroll") for (int _i = 0; _i < 2; ++_i) \
        __builtin_amdgcn_global_load_lds((const unsigned*)((const char*)(gbase) + (voff)[_i]), (PG8_LAS unsigned*)(lds + (bufoff) + ldsw + _i * 8192), 16, 0, 0); } while (0)
#define PG8_LDA(dst, b, h) do { _Pragma("unroll") for (int m = 0; m < 4; ++m) _Pragma("unroll") for (int k = 0; k < 2; ++k) dst[m][k] = *(const PG8_LAS bf16x8*)(lds + PG8_SA(b, h) + aoff + m * 2048 + k * 1024); } while (0)
#define PG8_LDB(dst, b, h) do { _Pragma("unroll") for (int n = 0; n < 2; ++n) _Pragma("unroll") for (int k = 0; k < 2; ++k) dst[n][k] = *(const PG8_LAS bf16x8*)(lds + PG8_SB(b, h) + boff + n * 2048 + k * 1024); } while (0)
#define PG8_MMA(ai, bj, At, Bt) do { __builtin_amdgcn_s_setprio(1); _Pragma("unroll") for (int m = 0; m < 4; ++m) _Pragma("unroll") for (int n = 0; n < 2; ++n) _Pragma("unroll") for (int k = 0; k < 2; ++k) \
        acc[ai][bj][m][n] = __builtin_amdgcn_mfma_f32_16x16x32_bf16(Bt[n][k], At[m][k], acc[ai][bj][m][n], 0, 0, 0); __builtin_amdgcn_s_setprio(0); } while (0)
#define PG8_WAIT_V(n) asm volatile("s_waitcnt vmcnt(" #n ")" ::: "memory")
#define PG8_WAIT_L(n) asm volatile("s_waitcnt lgkmcnt(" #n ")" ::: "memory")
#define PG8_BAR __builtin_amdgcn_s_barrier()
#define PG8_SCHED __builtin_amdgcn_sched_barrier(0)
    Unit cur, nxt; int ui = 0, seg = 0;
    if (!S.next(0, cur)) return;
    f32x4 acc[2][2][4][2];
#pragma unroll
    for (int a = 0; a < 2; ++a)
#pragma unroll
        for (int b = 0; b < 2; ++b)
#pragma unroll
            for (int m = 0; m < 4; ++m)
#pragma unroll
                for (int n = 0; n < 2; ++n) acc[a][b][m][n] = (f32x4){0.f, 0.f, 0.f, 0.f};
    bf16x8 At[4][2], B0[2][2], B1[2][2];
    const char* cA = (const char*)g.A + (size_t)cur.pm * tstep; const char* cB = (const char*)g.Bt + (size_t)cur.pn * tstep;
    S.a_ready(cur);
    if constexpr (SP2) {
        PG8_STAGE(PG8_SB(0, 0), cB, voffB); PG8_STAGE(PG8_SB(0, 1), cB + hstep, voffB); PG8_STAGE(PG8_SA(0, 0), cA, voffA); PG8_STAGE(PG8_SA(0, 1), cA + hstep, voffA);
        if (wr == 1) PG8_BAR;
        PG8_WAIT_V(2); PG8_BAR;
        PG8_STAGE(PG8_SB(1, 0), cB + kstep, voffB); PG8_STAGE(PG8_SA(1, 0), cA + kstep, voffA); PG8_STAGE(PG8_SB(1, 1), cB + hstep + kstep, voffB);
        PG8_WAIT_V(6); PG8_BAR;
    } else {
        PG8_STAGE(PG8_SB(0, 0), cB, voffB); PG8_STAGE(PG8_SA(0, 0), cA, voffA); PG8_STAGE(PG8_SB(0, 1), cB + hstep, voffB); PG8_STAGE(PG8_SA(0, 1), cA + hstep, voffA);
        if (wr == 1) PG8_BAR;
        PG8_WAIT_V(4); PG8_BAR;
        PG8_STAGE(PG8_SB(1, 0), cB + kstep, voffB); PG8_STAGE(PG8_SA(1, 0), cA + kstep, voffA); PG8_STAGE(PG8_SB(1, 1), cB + hstep + kstep, voffB);
        PG8_WAIT_V(6); PG8_BAR;
    }
    for (;;) {
        bool has_next; if (seg == 0) has_next = true; else has_next = S.next(ui + 1, nxt);
        const char* nA; const char* nB;
        if (seg == 0) { nA = (const char*)g2.A + (size_t)cur.pm * tstep; nB = (const char*)g2.Bt + (size_t)cur.pn * tstep; }
        else { nA = has_next ? (const char*)g.A + (size_t)nxt.pm * tstep : cA; nB = has_next ? (const char*)g.Bt + (size_t)nxt.pn * tstep : cB; }
        for (int t = 0; t < nt; t += 2) {
            const bool last = (t == nt - 2);
            const char* a1 = cA + (size_t)(t + 1) * kstep;
            const char* a2 = last ? nA : cA + (size_t)(t + 2) * kstep; const char* b2 = last ? nB : cB + (size_t)(t + 2) * kstep;
            const char* a3 = a2 + kstep; const char* b3 = b2 + kstep;
            if (last && has_next) S.a_ready(nxt);
            if constexpr (SP2) {
            PG8_LDB(B0, 0, 0); PG8_LDB(B1, 0, 1); PG8_SCHED; PG8_LDA(At, 0, 0); PG8_STAGE(PG8_SA(1, 1), a1 + hstep, voffA);
            PG8_WAIT_V(8); PG8_WAIT_L(0); PG8_BAR; PG8_MMA(0, 0, At, B0); PG8_MMA(0, 1, At, B1); PG8_BAR; PG8_SCHED;
            PG8_LDA(At, 0, 1); PG8_STAGE(PG8_SB(0, 0), b2, voffB); PG8_STAGE(PG8_SB(0, 1), b2 + hstep, voffB); PG8_STAGE(PG8_SA(0, 0), a2, voffA);
            PG8_WAIT_V(8); PG8_WAIT_L(0); PG8_BAR; PG8_MMA(1, 0, At, B0); PG8_MMA(1, 1, At, B1); PG8_BAR; PG8_SCHED;
            PG8_LDB(B0, 1, 0); PG8_LDB(B1, 1, 1); PG8_SCHED; PG8_LDA(At, 1, 0); PG8_STAGE(PG8_SA(0, 1), a2 + hstep, voffA);
            PG8_WAIT_V(8); PG8_WAIT_L(0); PG8_BAR; PG8_MMA(0, 0, At, B0); PG8_MMA(0, 1, At, B1); PG8_BAR; PG8_SCHED;
            PG8_LDA(At, 1, 1); PG8_STAGE(PG8_SB(1, 0), b3, voffB); PG8_STAGE(PG8_SB(1, 1), b3 + hstep, voffB); PG8_STAGE(PG8_SA(1, 0), a3, voffA);
            PG8_WAIT_V(8); PG8_WAIT_L(0); PG8_BAR; PG8_MMA(1, 0, At, B0); PG8_MMA(1, 1, At, B1); PG8_BAR; PG8_SCHED;
            } else {
            PG8_LDB(B0, 0, 0); PG8_SCHED; PG8_LDA(At, 0, 0); PG8_STAGE(PG8_SA(1, 1), a1 + hstep, voffA);
            PG8_WAIT_L(8); PG8_BAR; PG8_WAIT_L(0); PG8_MMA(0, 0, At, B0); PG8_BAR; PG8_SCHED;
            PG8_LDB(B1, 0, 1); PG8_STAGE(PG8_SB(0, 0), b2, voffB);
            PG8_BAR; PG8_WAIT_L(0); PG8_MMA(0, 1, At, B1); PG8_BAR;
            PG8_LDA(At, 0, 1); PG8_STAGE(PG8_SA(0, 0), a2, voffA);
            PG8_BAR; PG8_WAIT_L(0); PG8_MMA(1, 0, At, B0); PG8_BAR; PG8_SCHED;
            PG8_STAGE(PG8_SB(0, 1), b2 + hstep, voffB);
            PG8_WAIT_V(6); PG8_BAR; PG8_MMA(1, 1, At, B1); PG8_BAR;
            PG8_LDB(B0, 1, 0); PG8_SCHED; PG8_LDA(At, 1, 0); PG8_STAGE(PG8_SA(0, 1), a2 + hstep, voffA);
            PG8_WAIT_L(8); PG8_BAR; PG8_WAIT_L(0); PG8_MMA(0, 0, At, B0); PG8_BAR; PG8_SCHED;
            PG8_LDB(B1, 1, 1); PG8_STAGE(PG8_SB(1, 0), b3, voffB);
            PG8_BAR; PG8_WAIT_L(0); PG8_MMA(0, 1, At, B1); PG8_BAR;
            PG8_LDA(At, 1, 1); PG8_STAGE(PG8_SA(1, 0), a3, voffA);
            PG8_BAR; PG8_WAIT_L(0); PG8_MMA(1, 0, At, B0); PG8_BAR; PG8_SCHED;
            PG8_STAGE(PG8_SB(1, 1), b3 + hstep, voffB);
            PG8_WAIT_V(6); PG8_BAR; PG8_MMA(1, 1, At, B1); PG8_BAR;
            }
        }
        if constexpr (ALIGN_EPI) { if (wr == 0) PG8_BAR; }
        if (seg == 0) E.mid(acc, cur, wr, wc, fr, fq); else { E(acc, cur, wr, wc, fr, fq); S.done(cur); }
        if (!has_next) break;
        if (seg == 1) {
#pragma unroll
        for (int a = 0; a < 2; ++a)
#pragma unroll
            for (int b = 0; b < 2; ++b)
#pragma unroll
                for (int m = 0; m < 4; ++m)
#pragma unroll
                    for (int n = 0; n < 2; ++n) acc[a][b][m][n] = (f32x4){0.f, 0.f, 0.f, 0.f};
        cur = nxt; ++ui; }
        cA = nA; cB = nB; seg ^= 1;
        if constexpr (ALIGN_EPI) { if (wr == 1) PG8_BAR; }
    }
    PG8_WAIT_V(0);
    if constexpr (!ALIGN_EPI) { if (wr == 0) PG8_BAR; }
    PG8_BAR;
#undef PG8_SA
#undef PG8_SB
#undef PG8_STAGE
#undef PG8_LDA
#undef PG8_LDB
#undef PG8_MMA
#undef PG8_WAIT_V
#undef PG8_WAIT_L
#undef PG8_BAR
#undef PG8_SCHED
}
}
#define XB_TMO      128
#define XB_XCNT(j)  (256  + 64 * (j))
#define XB_XSUB(j)  (1280 + 64 * (j))
#define XB_XGEN(j)  (2304 + 64 * (j))
#define XB_TOP      3328
#define XB_TOPGEN   3392
#define XCD_BAR_WORDS 3456
#define XB_SPIN_CAP (1u << 18)

__device__ __forceinline__ unsigned xb_ld(unsigned* p)              { return __hip_atomic_load(p, __ATOMIC_RELAXED, __HIP_MEMORY_SCOPE_AGENT); }
__device__ __forceinline__ unsigned xb_add(unsigned* p, unsigned v) { return __hip_atomic_fetch_add(p, v, __ATOMIC_RELAXED, __HIP_MEMORY_SCOPE_AGENT); }
__device__ __forceinline__ unsigned xb_xcc_id() { return (unsigned)__builtin_amdgcn_s_getreg((3 << 11) | 20) & 0xFu; }
#define XB_SPIN(cond, bar) do { unsigned _sp = 0; while (cond) { __builtin_amdgcn_s_sleep(1); \
    if ((++_sp & 255u) == 0u) { if (xb_ld(&(bar)[XB_TMO])) break; if (_sp > XB_SPIN_CAP) { atomicAdd(&(bar)[XB_TMO], 1u); break; } } } } while (0)

struct XcdBarrier {
    unsigned* bar; unsigned x;
    volatile LAS unsigned* st;
};

__device__ __forceinline__ XcdBarrier xcd_barrier_post(unsigned* bar, volatile LAS unsigned* st) {
    XcdBarrier b; b.bar = bar; b.x = xb_xcc_id(); b.st = st;
    if (threadIdx.x == 0) (void)xb_add(&bar[XB_XCNT(b.x)], 1u);
    return b;
}
__device__ __forceinline__ void xcd_barrier_complete(unsigned* bar, unsigned x, unsigned& nloc, unsigned& nx) {
    const unsigned G = gridDim.x * gridDim.y * gridDim.z;
    unsigned sum, cnt, mine, sp = 0u;
    for (;;) {
        sum = 0u; cnt = 0u; mine = 0u;
#pragma unroll
        for (unsigned j = 0; j < 16; ++j) { const unsigned c = xb_ld(&bar[XB_XCNT(j)]); sum += c; cnt += (c > 0u) ? 1u : 0u; mine = (j == x) ? c : mine; }
        if (sum == G) break;
        __builtin_amdgcn_s_sleep(1);
        if ((++sp & 255u) == 0u) { if (xb_ld(&bar[XB_TMO])) break; if (sp > XB_SPIN_CAP) { atomicAdd(&bar[XB_TMO], 1u); break; } }
    }
    nloc = mine > 0u ? mine : 1u; nx = cnt > 0u ? cnt : 1u;
}

__device__ __forceinline__ void xcd_barrier(const XcdBarrier& b) {
    asm volatile("s_waitcnt vmcnt(0)" ::: "memory");
    __syncthreads();
    if (threadIdx.x == 0) {
        unsigned* bar = b.bar;
        __builtin_amdgcn_s_waitcnt(0);
        unsigned nloc = b.st[0], nx = b.st[1];
        if (nloc == 0u) { xcd_barrier_complete(bar, b.x, nloc, nx); b.st[0] = nloc; b.st[1] = nx; }
        const unsigned old = xb_add(&bar[XB_XSUB(b.x)], 1u);
        const unsigned gen = old / nloc;
        if (old + 1u == (gen + 1u) * nloc) {
            __builtin_amdgcn_fence(__ATOMIC_RELEASE, "agent");
            asm volatile("s_waitcnt vmcnt(0)" ::: "memory");
            const unsigned og = xb_add(&bar[XB_TOP], 1u);
            const unsigned tg = og / nx;
            if (og + 1u == (tg + 1u) * nx) xb_add(&bar[XB_TOPGEN], 1u);
            else XB_SPIN(xb_ld(&bar[XB_TOPGEN]) == tg, bar);
            __builtin_amdgcn_fence(__ATOMIC_ACQUIRE, "agent");
            xb_add(&bar[XB_XGEN(b.x)], 1u);
            asm volatile("s_waitcnt vmcnt(0)" ::: "memory");
        } else {
            XB_SPIN(xb_ld(&bar[XB_XGEN(b.x)]) == gen, bar);
            __builtin_amdgcn_fence(__ATOMIC_ACQUIRE, "agent");
            asm volatile("s_waitcnt vmcnt(0)" ::: "memory");
        }
    }
    __syncthreads();
}

constexpr int D = 4096, SEQ = 8192, NX = 16384  , NMETA = 16, MROWS = 16640  ;
constexpr int DIN = 36864, DFF = 11008, NH = 16;
constexpr float EPS = 1e-6f, LOG2E = 1.4426950408889634f;
constexpr size_t MiB = 1u << 20;
constexpr size_t WS_CTL = 0, CTL_ZERO_BYTES = 1 * MiB;
constexpr size_t WS_WBR = 1 * MiB, WS_WBD = 33 * MiB, WS_WO = 65 * MiB, WS_WGU = 97 * MiB, WS_WDN = 269 * MiB;
constexpr size_t WS_WIN = 355 * MiB, WS_U = 643 * MiB;
constexpr size_t WS_ST = 355 * MiB;
constexpr size_t WS_PROJ = 867 * MiB;
constexpr size_t WS_YR = 2037 * MiB, WS_END = 2165 * MiB;
constexpr size_t GS = (size_t)MROWS * D;
constexpr size_t WS_MIXED = 355 * MiB, WS_U2 = 483 * MiB, WS_ACT = 867 * MiB, WS_H2 = 355 * MiB  , WS_PS = 611 * MiB  , WS_RSTD = 616 * MiB  ;
static_assert(WS_WGU + (size_t)2 * DFF * D * 2 <= WS_WDN && WS_WDN + (size_t)D * DFF * 2 <= WS_WIN && WS_WIN + (size_t)DIN * D * 2 <= WS_U && WS_U + (size_t)MROWS * D * 2 <= WS_ST + 512 * MiB && WS_ST + 512 * MiB <= WS_PROJ && WS_PROJ + 9 * GS * 2 <= WS_END, "ws map");
constexpr int CW_BAR = 4096;
constexpr int LDS_BYTES = 163840, MISC_OFF = LDS_BYTES - 256;
constexpr int NWAVES = 8;


typedef unsigned short bf16;
typedef LAS char lchar;
#define LDS_WAIT() asm volatile("s_waitcnt lgkmcnt(0)" ::: "memory")
#define VM_WAIT() asm volatile("s_waitcnt vmcnt(0)" ::: "memory")
#define WAITBAR() do { asm volatile("s_waitcnt vmcnt(0) lgkmcnt(0)" ::: "memory"); __builtin_amdgcn_s_barrier(); asm volatile("" ::: "memory"); } while (0)

namespace mx {
using bf16x8 = __attribute__((ext_vector_type(8))) short;
using s16x4  = __attribute__((ext_vector_type(4))) short;
using f32x16 = __attribute__((ext_vector_type(16))) float;
using f32x4  = __attribute__((ext_vector_type(4))) float;
using u32x4  = __attribute__((ext_vector_type(4))) unsigned;
using u32x2  = __attribute__((ext_vector_type(2))) unsigned;
#define KSWZ(row, colB) ((row) * 256 + ((colB) ^ (((row) & 7) << 4)))
#define SBAR() __builtin_amdgcn_sched_barrier(0)
__device__ __forceinline__ int crow(int r, int hi) { return (r & 3) + 8 * (r >> 2) + 4 * hi; }
__device__ __forceinline__ unsigned cvtpk(float lo, float hi) { unsigned r; asm volatile("v_cvt_pk_bf16_f32 %0, %1, %2" : "=v"(r) : "v"(lo), "v"(hi)); return r; }
__device__ __forceinline__ float bflo(unsigned w) { return __uint_as_float(w << 16); }
__device__ __forceinline__ float bfhi(unsigned w) { return __uint_as_float(w & 0xffff0000u); }
__device__ __forceinline__ int v_rd_base(int lane) { return ((lane & 3) << 3) | (((lane >> 2) & 3) << 6) | (((lane >> 4) & 1) << 5) | (((lane >> 5) & 1) << 8); }
constexpr int vro(int d0, int ks, int half) { return d0 * 512 + ks * 8192 + half * 4096; }
template <int OFF> __device__ __forceinline__ s16x4 tr_read(int vb) { s16x4 r; asm volatile("ds_read_b64_tr_b16 %0, %1 offset:%2" : "=&v"(r) : "v"(vb), "i"(OFF) : "memory"); return r; }
#define MX_PK(L, H) (mx::bf16x8){L[0], L[1], L[2], L[3], H[0], H[1], H[2], H[3]}
__device__ __forceinline__ void vimg_rc(int P, int& k, int& c) { const int st = P >> 9, wi = P & 511, kk = (st >> 3) * 8 + (wi >> 6); c = (st & 7) * 32 + ((wi & 63) >> 1); k = (kk & ~0xC) | ((kk & 4) << 1) | ((kk & 8) >> 1); }
__device__ __forceinline__ void kimg_rc(int P, int& r, int& c) { r = P >> 8; const int cp = P & 255; c = (cp ^ ((r & 7) << 4)) >> 1; }
__device__ __forceinline__ void glds16(const void* g, lchar* l) { __builtin_amdgcn_global_load_lds((const unsigned*)g, (LAS unsigned*)l, 16, 0, 0); }
__device__ __forceinline__ int lds_addr(const lchar* p) { return (int)(unsigned)(size_t)p; }
template <int K> __device__ __forceinline__ float swz_xor(float v) { return __int_as_float(__builtin_amdgcn_ds_swizzle(__float_as_int(v), 0x1f | (K << 10))); }
__device__ __forceinline__ float half_sum(float v) { v += swz_xor<1>(v); v += swz_xor<2>(v); v += swz_xor<4>(v); v += swz_xor<8>(v); v += swz_xor<16>(v); return v; }
__device__ __forceinline__ int opaque(int x) { asm volatile("" : "+v"(x)); return x; }

template <int ND> __device__ __forceinline__ void qkt(f32x16& p0, f32x16& p1, const lchar* Ks, const bf16x8* qr, int r32, int hi) {
#pragma unroll
  for (int r = 0; r < 16; ++r) { p0[r] = 0.f; p1[r] = 0.f; }
#pragma unroll
  for (int d0 = 0; d0 < ND; ++d0) { const int cb = ((d0 & 7) * 16 + hi * 8) * 2; const lchar* Kh = Ks + (d0 >> 3) * 16384;
    const bf16x8 b0 = *(const LAS bf16x8*)(Kh + KSWZ(r32, cb));
    const bf16x8 b1 = *(const LAS bf16x8*)(Kh + KSWZ(32 + r32, cb));
    p0 = __builtin_amdgcn_mfma_f32_32x32x16_bf16(b0, qr[d0], p0, 0, 0, 0);
    p1 = __builtin_amdgcn_mfma_f32_32x32x16_bf16(b1, qr[d0], p1, 0, 0, 0); }
}
__device__ __forceinline__ void pack_p(const f32x16& p0, const f32x16& p1, bf16x8& pa0, bf16x8& pa1, bf16x8& pa2, bf16x8& pa3) {
#define PK4(P, BASE, OUT) do { unsigned a0 = cvtpk(P[BASE + 0], P[BASE + 1]), a1 = cvtpk(P[BASE + 2], P[BASE + 3]);   \
    unsigned b0 = cvtpk(P[BASE + 4], P[BASE + 5]), b1 = cvtpk(P[BASE + 6], P[BASE + 7]);                              \
    auto r0 = __builtin_amdgcn_permlane32_swap(a0, b0, false, false); auto r1 = __builtin_amdgcn_permlane32_swap(a1, b1, false, false); \
    u32x4 w = {r0[0], r1[0], r0[1], r1[1]}; OUT = *reinterpret_cast<bf16x8*>(&w); } while (0)
  PK4(p0, 0, pa0); PK4(p0, 8, pa1); PK4(p1, 0, pa2); PK4(p1, 8, pa3);
#undef PK4
}
__device__ __forceinline__ void pack_p2(const f32x16& p, bf16x8& pa0, bf16x8& pa1) {
#define PK4(P, BASE, OUT) do { unsigned a0 = cvtpk(P[BASE + 0], P[BASE + 1]), a1 = cvtpk(P[BASE + 2], P[BASE + 3]);   \
    unsigned b0 = cvtpk(P[BASE + 4], P[BASE + 5]), b1 = cvtpk(P[BASE + 6], P[BASE + 7]);                              \
    auto r0 = __builtin_amdgcn_permlane32_swap(a0, b0, false, false); auto r1 = __builtin_amdgcn_permlane32_swap(a1, b1, false, false); \
    u32x4 w = {r0[0], r1[0], r0[1], r1[1]}; OUT = *reinterpret_cast<bf16x8*>(&w); } while (0)
  PK4(p, 0, pa0); PK4(p, 8, pa1);
#undef PK4
}
template <int D0, int KH> __device__ __forceinline__ void pv_half(f32x16& od, int vb, bf16x8 a0, bf16x8 a1) {
  const s16x4 l0 = tr_read<vro(D0, 2 * KH, 0)>(vb), h0 = tr_read<vro(D0, 2 * KH, 1)>(vb), l1 = tr_read<vro(D0, 2 * KH + 1, 0)>(vb), h1 = tr_read<vro(D0, 2 * KH + 1, 1)>(vb);
  asm volatile("s_waitcnt lgkmcnt(0)" ::: "memory"); SBAR();
  od = __builtin_amdgcn_mfma_f32_32x32x16_bf16(a0, MX_PK(l0, h0), od, 0, 0, 0);
  od = __builtin_amdgcn_mfma_f32_32x32x16_bf16(a1, MX_PK(l1, h1), od, 0, 0, 0);
}
template <int D0, int KH> __device__ __forceinline__ void pv_half2(f32x16& oa, f32x16& ob, int vb, bf16x8 a0, bf16x8 a1) {
  const s16x4 l0 = tr_read<vro(D0, 2 * KH, 0)>(vb), h0 = tr_read<vro(D0, 2 * KH, 1)>(vb), l1 = tr_read<vro(D0, 2 * KH + 1, 0)>(vb), h1 = tr_read<vro(D0, 2 * KH + 1, 1)>(vb);
  const s16x4 l2 = tr_read<vro(D0 + 1, 2 * KH, 0)>(vb), h2 = tr_read<vro(D0 + 1, 2 * KH, 1)>(vb), l3 = tr_read<vro(D0 + 1, 2 * KH + 1, 0)>(vb), h3 = tr_read<vro(D0 + 1, 2 * KH + 1, 1)>(vb);
  asm volatile("s_waitcnt lgkmcnt(0)" ::: "memory"); SBAR();
  oa = __builtin_amdgcn_mfma_f32_32x32x16_bf16(a0, MX_PK(l0, h0), oa, 0, 0, 0);
  ob = __builtin_amdgcn_mfma_f32_32x32x16_bf16(a0, MX_PK(l2, h2), ob, 0, 0, 0);
  oa = __builtin_amdgcn_mfma_f32_32x32x16_bf16(a1, MX_PK(l1, h1), oa, 0, 0, 0);
  ob = __builtin_amdgcn_mfma_f32_32x32x16_bf16(a1, MX_PK(l3, h3), ob, 0, 0, 0);
}
template <int KH> __device__ __forceinline__ void pv_half8(f32x16* o, int vb, bf16x8 a0, bf16x8 a1) {
#define PV8_RD(D0, L0, H0, L1, H1, L2, H2, L3, H3) const s16x4 L0 = tr_read<vro(D0, 2 * KH, 0)>(vb), H0 = tr_read<vro(D0, 2 * KH, 1)>(vb), L1 = tr_read<vro(D0, 2 * KH + 1, 0)>(vb), H1 = tr_read<vro(D0, 2 * KH + 1, 1)>(vb), \
      L2 = tr_read<vro(D0 + 1, 2 * KH, 0)>(vb), H2 = tr_read<vro(D0 + 1, 2 * KH, 1)>(vb), L3 = tr_read<vro(D0 + 1, 2 * KH + 1, 0)>(vb), H3 = tr_read<vro(D0 + 1, 2 * KH + 1, 1)>(vb)
#define PV8_MM(D0, L0, H0, L1, H1, L2, H2, L3, H3) do { o[D0] = __builtin_amdgcn_mfma_f32_32x32x16_bf16(a0, MX_PK(L0, H0), o[D0], 0, 0, 0); o[D0 + 1] = __builtin_amdgcn_mfma_f32_32x32x16_bf16(a0, MX_PK(L2, H2), o[D0 + 1], 0, 0, 0); \
      o[D0] = __builtin_amdgcn_mfma_f32_32x32x16_bf16(a1, MX_PK(L1, H1), o[D0], 0, 0, 0); o[D0 + 1] = __builtin_amdgcn_mfma_f32_32x32x16_bf16(a1, MX_PK(L3, H3), o[D0 + 1], 0, 0, 0); } while (0)
  PV8_RD(0, a_l0, a_h0, a_l1, a_h1, a_l2, a_h2, a_l3, a_h3);
  PV8_RD(2, b_l0, b_h0, b_l1, b_h1, b_l2, b_h2, b_l3, b_h3);
  asm volatile("s_waitcnt lgkmcnt(8)" ::: "memory"); SBAR();
  PV8_MM(0, a_l0, a_h0, a_l1, a_h1, a_l2, a_h2, a_l3, a_h3); SBAR();
  PV8_RD(4, c_l0, c_h0, c_l1, c_h1, c_l2, c_h2, c_l3, c_h3);
  asm volatile("s_waitcnt lgkmcnt(8)" ::: "memory"); SBAR();
  PV8_MM(2, b_l0, b_h0, b_l1, b_h1, b_l2, b_h2, b_l3, b_h3); SBAR();
  PV8_RD(6, d_l0, d_h0, d_l1, d_h1, d_l2, d_h2, d_l3, d_h3);
  asm volatile("s_waitcnt lgkmcnt(8)" ::: "memory"); SBAR();
  PV8_MM(4, c_l0, c_h0, c_l1, c_h1, c_l2, c_h2, c_l3, c_h3); SBAR();
  asm volatile("s_waitcnt lgkmcnt(0)" ::: "memory"); SBAR();
  PV8_MM(6, d_l0, d_h0, d_l1, d_h1, d_l2, d_h2, d_l3, d_h3);
#undef PV8_RD
#undef PV8_MM
}
template <int KH> __device__ __forceinline__ void pv8_pre(int vb, s16x4* va) {
  va[0] = tr_read<vro(0, 2 * KH, 0)>(vb); va[1] = tr_read<vro(0, 2 * KH, 1)>(vb); va[2] = tr_read<vro(0, 2 * KH + 1, 0)>(vb); va[3] = tr_read<vro(0, 2 * KH + 1, 1)>(vb);
}
template <int KH> __device__ __forceinline__ void pv_half8p(f32x16* o, int vb, bf16x8 a0, bf16x8 a1, const s16x4* va) {
#define PV8_RD(D0, L0, H0, L1, H1, L2, H2, L3, H3) const s16x4 L0 = tr_read<vro(D0, 2 * KH, 0)>(vb), H0 = tr_read<vro(D0, 2 * KH, 1)>(vb), L1 = tr_read<vro(D0, 2 * KH + 1, 0)>(vb), H1 = tr_read<vro(D0, 2 * KH + 1, 1)>(vb), \
      L2 = tr_read<vro(D0 + 1, 2 * KH, 0)>(vb), H2 = tr_read<vro(D0 + 1, 2 * KH, 1)>(vb), L3 = tr_read<vro(D0 + 1, 2 * KH + 1, 0)>(vb), H3 = tr_read<vro(D0 + 1, 2 * KH + 1, 1)>(vb)
#define PV8_MM(D0, L0, H0, L1, H1, L2, H2, L3, H3) do { o[D0] = __builtin_amdgcn_mfma_f32_32x32x16_bf16(a0, MX_PK(L0, H0), o[D0], 0, 0, 0); o[D0 + 1] = __builtin_amdgcn_mfma_f32_32x32x16_bf16(a0, MX_PK(L2, H2), o[D0 + 1], 0, 0, 0); \
      o[D0] = __builtin_amdgcn_mfma_f32_32x32x16_bf16(a1, MX_PK(L1, H1), o[D0], 0, 0, 0); o[D0 + 1] = __builtin_amdgcn_mfma_f32_32x32x16_bf16(a1, MX_PK(L3, H3), o[D0 + 1], 0, 0, 0); } while (0)
  const s16x4 e0 = tr_read<vro(1, 2 * KH, 0)>(vb), e1 = tr_read<vro(1, 2 * KH, 1)>(vb), e2 = tr_read<vro(1, 2 * KH + 1, 0)>(vb), e3 = tr_read<vro(1, 2 * KH + 1, 1)>(vb);
  PV8_RD(2, b_l0, b_h0, b_l1, b_h1, b_l2, b_h2, b_l3, b_h3);
  asm volatile("s_waitcnt lgkmcnt(8)" ::: "memory"); SBAR();
  PV8_MM(0, va[0], va[1], va[2], va[3], e0, e1, e2, e3); SBAR();
  PV8_RD(4, c_l0, c_h0, c_l1, c_h1, c_l2, c_h2, c_l3, c_h3);
  asm volatile("s_waitcnt lgkmcnt(8)" ::: "memory"); SBAR();
  PV8_MM(2, b_l0, b_h0, b_l1, b_h1, b_l2, b_h2, b_l3, b_h3); SBAR();
  PV8_RD(6, d_l0, d_h0, d_l1, d_h1, d_l2, d_h2, d_l3, d_h3);
  asm volatile("s_waitcnt lgkmcnt(8)" ::: "memory"); SBAR();
  PV8_MM(4, c_l0, c_h0, c_l1, c_h1, c_l2, c_h2, c_l3, c_h3); SBAR();
  asm volatile("s_waitcnt lgkmcnt(0)" ::: "memory"); SBAR();
  PV8_MM(6, d_l0, d_h0, d_l1, d_h1, d_l2, d_h2, d_l3, d_h3);
#undef PV8_RD
#undef PV8_MM
}
template <int D0> __device__ __forceinline__ void pv_one(f32x16& od, int vb, bf16x8 a0, bf16x8 a1, bf16x8 a2, bf16x8 a3) {
  const s16x4 l0 = tr_read<vro(D0, 0, 0)>(vb), h0 = tr_read<vro(D0, 0, 1)>(vb), l1 = tr_read<vro(D0, 1, 0)>(vb), h1 = tr_read<vro(D0, 1, 1)>(vb);
  const s16x4 l2 = tr_read<vro(D0, 2, 0)>(vb), h2 = tr_read<vro(D0, 2, 1)>(vb), l3 = tr_read<vro(D0, 3, 0)>(vb), h3 = tr_read<vro(D0, 3, 1)>(vb);
  asm volatile("s_waitcnt lgkmcnt(0)" ::: "memory"); SBAR();
  od = __builtin_amdgcn_mfma_f32_32x32x16_bf16(a0, MX_PK(l0, h0), od, 0, 0, 0);
  od = __builtin_amdgcn_mfma_f32_32x32x16_bf16(a1, MX_PK(l1, h1), od, 0, 0, 0);
  od = __builtin_amdgcn_mfma_f32_32x32x16_bf16(a2, MX_PK(l2, h2), od, 0, 0, 0);
  od = __builtin_amdgcn_mfma_f32_32x32x16_bf16(a3, MX_PK(l3, h3), od, 0, 0, 0);
}
}

struct Frame {
    lchar* lds; volatile LAS unsigned* MISC; unsigned* ctl;
    int tid, lane, wave, vcu, G;
    const float* in[15]; float* out; unsigned char* ws;
};
__device__ __forceinline__ float wave_sum(float v) {
    v = mx::half_sum(v);
    auto rr = __builtin_amdgcn_permlane32_swap(__float_as_uint(v), __float_as_uint(v), false, false);
    return __uint_as_float(rr[0]) + __uint_as_float(rr[1]);
}
__device__ __forceinline__ unsigned f2bf(float f) { unsigned u = __builtin_bit_cast(unsigned, f); return (u + 0x7fffu + ((u >> 16) & 1u)) >> 16; }
__device__ __forceinline__ unsigned pk2(float lo, float hi) { return f2bf(lo) | (f2bf(hi) << 16); }

__device__ __forceinline__ void p0_transpose_item(const float* W, int K, int N, bf16* WT, int mode, LAS float* scr, int item, int lane, const float* gk = nullptr) {
    const int nblk = N / 64, kb = item / nblk, nb = item - kb * nblk, k0 = 64 * kb, n0 = 64 * nb;
    mx::f32x4 v[16];
    const float* src = W + (size_t)(k0 + (lane >> 4)) * N + n0 + 4 * (lane & 15);
#pragma unroll
    for (int i = 0; i < 16; ++i) v[i] = *(const mx::f32x4*)(src + (size_t)(4 * i) * N);
#pragma unroll
    for (int i = 0; i < 16; ++i) { LAS float* s = scr + (4 * i + (lane >> 4)) * 65 + 4 * (lane & 15); s[0] = v[i][0]; s[1] = v[i][1]; s[2] = v[i][2]; s[3] = v[i][3]; }
    LDS_WAIT(); asm volatile("" ::: "memory");
    const int c = lane & 7;
    const int nd0 = (mode == 0) ? n0 : ((n0 >> 7) * 256 + (n0 & 127) + (mode == 2 ? 128 : 0));
    mx::f32x4 ga = {1.f, 1.f, 1.f, 1.f}, gb = {1.f, 1.f, 1.f, 1.f};
    if (gk) { ga = *(const mx::f32x4*)(gk + k0 + 8 * c); gb = *(const mx::f32x4*)(gk + k0 + 8 * c + 4); }
#pragma unroll
    for (int j = 0; j < 8; ++j) { const int n = (lane >> 3) + 8 * j; const LAS float* s = scr + (8 * c) * 65 + n;
        mx::u32x4 o; o.x = pk2(s[0 * 65] * ga[0], s[1 * 65] * ga[1]); o.y = pk2(s[2 * 65] * ga[2], s[3 * 65] * ga[3]); o.z = pk2(s[4 * 65] * gb[0], s[5 * 65] * gb[1]); o.w = pk2(s[6 * 65] * gb[2], s[7 * 65] * gb[3]);
        *(mx::u32x4*)(WT + (size_t)(nd0 + n) * K + k0 + 8 * c) = o; }
    LDS_WAIT(); asm volatile("" ::: "memory");
}
template <bool OUT32> __device__ __forceinline__ void rms_row(const float* xrow, const float* g, void* orow, int lane) {
    const mx::f32x4* xr = (const mx::f32x4*)xrow + lane;
    mx::f32x4 v[16]; float s = 0.f;
#pragma unroll
    for (int j = 0; j < 16; ++j) { v[j] = xr[64 * j]; s += (v[j][0] * v[j][0] + v[j][1] * v[j][1]) + (v[j][2] * v[j][2] + v[j][3] * v[j][3]); }
    const float rstd = 1.0f / sqrtf(wave_sum(s) * (1.f / D) + EPS);
    const mx::f32x4* gr = (const mx::f32x4*)g + lane;
#pragma unroll
    for (int j = 0; j < 16; ++j) { const mx::f32x4 gg = gr[64 * j]; const mx::f32x4 y = v[j] * rstd * gg;
        if (OUT32) ((mx::f32x4*)orow)[lane + 64 * j] = y;
        else { mx::u32x2 w; w.x = pk2(y[0], y[1]); w.y = pk2(y[2], y[3]); ((mx::u32x2*)orow)[lane + 64 * j] = w; } }
}
__device__ __forceinline__ void rms_row_bf(const bf16* xrow, const float* g, float* orow, int lane) {
    const mx::u32x4* xr = (const mx::u32x4*)xrow + lane;
    mx::u32x4 v[8]; float s = 0.f;
#pragma unroll
    for (int j = 0; j < 8; ++j) { v[j] = xr[64 * j];
        s += (mx::bflo(v[j].x) * mx::bflo(v[j].x) + mx::bfhi(v[j].x) * mx::bfhi(v[j].x)) + (mx::bflo(v[j].y) * mx::bflo(v[j].y) + mx::bfhi(v[j].y) * mx::bfhi(v[j].y))
           + (mx::bflo(v[j].z) * mx::bflo(v[j].z) + mx::bfhi(v[j].z) * mx::bfhi(v[j].z)) + (mx::bflo(v[j].w) * mx::bflo(v[j].w) + mx::bfhi(v[j].w) * mx::bfhi(v[j].w)); }
    const float rstd = 1.0f / sqrtf(wave_sum(s) * (1.f / D) + EPS);
#pragma unroll
    for (int j = 0; j < 8; ++j) { const float* gp = g + 512 * j + 8 * lane; const mx::f32x4 g0 = *(const mx::f32x4*)gp, g1 = *(const mx::f32x4*)(gp + 4);
        float* op = orow + 512 * j + 8 * lane;
        *(mx::f32x4*)op = (mx::f32x4){mx::bflo(v[j].x) * rstd * g0[0], mx::bfhi(v[j].x) * rstd * g0[1], mx::bflo(v[j].y) * rstd * g0[2], mx::bfhi(v[j].y) * rstd * g0[3]};
        *(mx::f32x4*)(op + 4) = (mx::f32x4){mx::bflo(v[j].z) * rstd * g1[0], mx::bfhi(v[j].z) * rstd * g1[1], mx::bflo(v[j].w) * rstd * g1[2], mx::bfhi(v[j].w) * rstd * g1[3]}; }
}
__device__ __forceinline__ void p0_prologue(Frame& F) {
    LAS float* scr = (LAS float*)(F.lds + F.wave * 16640);
    const int gw = F.vcu * NWAVES + F.wave, NGW = F.G * NWAVES;
    bf16* WIN = (bf16*)(F.ws + WS_WIN); bf16* WBR = (bf16*)(F.ws + WS_WBR); bf16* WBD = (bf16*)(F.ws + WS_WBD); bf16* WO = (bf16*)(F.ws + WS_WO); bf16* WGU = (bf16*)(F.ws + WS_WGU); bf16* WDN = (bf16*)(F.ws + WS_WDN);
    constexpr int I_IN = (D / 64) * (DIN / 64), I_SQ = (D / 64) * (D / 64), I_FF = (D / 64) * (DFF / 64);
    constexpr int NITEMS = I_IN + 3 * I_SQ + 3 * I_FF;
    for (int it = gw; it < NITEMS; it += NGW) {
        int r = it;
        if (r < I_IN) { p0_transpose_item(F.in[3], D, DIN, WIN, 0, scr, r, F.lane); continue; } r -= I_IN;
        if (r < I_SQ) { p0_transpose_item(F.in[7], D, D, WBR, 0, scr, r, F.lane); continue; } r -= I_SQ;
        if (r < I_SQ) { p0_transpose_item(F.in[8], D, D, WBD, 0, scr, r, F.lane); continue; } r -= I_SQ;
        if (r < I_SQ) { p0_transpose_item(F.in[9], D, D, WO, 0, scr, r, F.lane); continue; } r -= I_SQ;
        if (r < I_FF) { p0_transpose_item(F.in[11], D, DFF, WGU, 1, scr, r, F.lane, F.in[10]); continue; } r -= I_FF;
        if (r < I_FF) { p0_transpose_item(F.in[12], D, DFF, WGU, 2, scr, r, F.lane, F.in[10]); continue; } r -= I_FF;
        p0_transpose_item(F.in[13], DFF, D, WDN, 0, scr, r, F.lane);
    }
    bf16* U = (bf16*)(F.ws + WS_U);
    for (int m = gw; m < MROWS; m += NGW) {
        bf16* orow = U + (size_t)m * D;
        if (m < NX) rms_row<false>(F.in[0] + (size_t)m * D, F.in[2], orow, F.lane);
        else if (m < NX + NMETA) rms_row<false>(F.in[1] + (size_t)(m - NX) * D, F.in[2], orow, F.lane);
        else {
#pragma unroll
            for (int j = 0; j < 16; ++j) ((mx::u32x2*)orow)[F.lane + 64 * j] = (mx::u32x2){0u, 0u}; }
    }
}


__device__ __forceinline__ void meta_proj(lchar* lds, const bf16* U, const bf16* WIN, bf16* PROJ, int vcu, int G) {
    using namespace mx; typedef float f32x4_t __attribute__((ext_vector_type(4)));
    const int tid = opaque((int)threadIdx.x), wid = __builtin_amdgcn_readfirstlane(tid >> 6), lane = tid & 63, cg = wid & 3, kh = wid >> 2;
    LAS float* red = (LAS float*)lds;
    for (int c = vcu; c < 256; c += G) {
        const int g0 = c * 64, gi = g0 >> 12, grp = (gi == 0) ? 1 : (gi == 1) ? 2 : (gi == 2) ? 5 : 6, col0 = (g0 & 4095) + cg * 16;
        const bf16* wrow = WIN + (size_t)(grp * 4096 + col0 + (lane & 15)) * D + kh * 2048 + (lane >> 4) * 8;
        const bf16* urow = U + (size_t)(NX + (lane & 15)) * D + kh * 2048 + (lane >> 4) * 8;
        f32x4_t acc = {0.f, 0.f, 0.f, 0.f};
#pragma unroll 8
        for (int ks = 0; ks < 64; ++ks) { const bf16x8 a = *(const bf16x8*)(urow + ks * 32), bq = *(const bf16x8*)(wrow + ks * 32);
            acc = __builtin_amdgcn_mfma_f32_16x16x32_bf16(a, bq, acc, 0, 0, 0); }
        if (kh == 1) *(LAS f32x4_t*)(red + (cg * 64 + lane) * 4) = acc;
        __syncthreads();
        if (kh == 0) { const f32x4_t o = *(const LAS f32x4_t*)(red + (cg * 64 + lane) * 4); acc += o;
            const float sc = (grp == 1) ? 0.0625f : 1.f; bf16* op = PROJ + (size_t)grp * GS + (size_t)(NX + (lane >> 4) * 4) * D + col0 + (lane & 15);
#pragma unroll
            for (int i = 0; i < 4; ++i) op[(size_t)i * D] = (bf16)f2bf(acc[i] * sc); }
        if (grp >= 5 && tid < 384) { bf16* zp = PROJ + (size_t)grp * GS + (size_t)(NX + 16 + (tid >> 3)) * D + (g0 & 4095) + (tid & 7) * 8; *(u32x4*)zp = (u32x4){0u, 0u, 0u, 0u}; }
        __syncthreads();
    }
}

constexpr int ATT_NT = 129;
constexpr int CW_NRM = 8192;
#define BARF() do { asm volatile("" ::: "memory"); __builtin_amdgcn_s_barrier(); asm volatile("" ::: "memory"); } while (0)
__device__ __forceinline__ void attn_unit(lchar* lds, const bf16* Qg, const bf16* Kg, const bf16* Vg, bf16* Og, float* stash, const float* subg, const unsigned* nrm, int b, int h, int qb, float lam) {
    using namespace mx;
    const int tid = threadIdx.x, wid = __builtin_amdgcn_readfirstlane(tid >> 6), lane = tid & 63, r32 = lane & 31, hi = lane >> 5, grp = wid >> 2;
    lchar* Kb = lds; lchar* Vb = lds + 32768; LAS float* li_l = (LAS float*)(lds + 147456) + wid * 64; LAS float* al_l = li_l + 32; LAS float* mslot = (LAS float*)(lds + 147456 + 2048);
    const float slope = exp2f(-0.5f * (float)(h + 1)), nsl2 = -slope * LOG2E;
    constexpr float C = 0.08838834764831845f * LOG2E, THR2 = 60.f, NEG = -1e30f;
#define RFL_F(x) __uint_as_float((unsigned)__builtin_amdgcn_readfirstlane((int)__float_as_uint(x)))
    const float asl = RFL_F(slope * LOG2E), Cq = 0.08838834764831845f / slope, THRQ = RFL_F(THR2 / asl), DEADQ = RFL_F(-150.f / asl);
#undef RFL_F
    const int qrow = b * SEQ + qb * 256 + wid * 32 + r32;
    const int qw0 = NMETA + qb * 256 + wid * 32;
#define CR(r) (((r) & 3) + 8 * ((r) >> 2))
    float crn[16];
#pragma unroll
    for (int r = 0; r < 16; ++r) { float c = -(float)CR(r); asm volatile("" : "+s"(c)); crn[r] = c; }
    const float qposf = (float)(NMETA + qb * 256 + wid * 32 + r32 - 4 * hi);
    const int vb0 = lds_addr(Vb) + v_rd_base(lane);
    const int ka0 = lds_addr(Kb) + r32 * 256 + ((hi * 16) ^ ((r32 & 7) << 4));
#pragma unroll 1
    for (int mp = 0; mp < 2; ++mp) {
        int t_lo, t_hi;
        const float smax_l2 = sqrtf(__uint_as_float(nrm[(0 * 2 + b) * 32 + h * 2 + mp])) * sqrtf(__uint_as_float(nrm[(1 * 2 + b) * 32 + h * 2 + mp])) * C;
        const bf16* Qw = Qg + (size_t)qrow * D + h * 256 + mp * 128 + hi * 8;
        bf16x8 qr[8];
#pragma unroll
        for (int d0 = 0; d0 < 8; ++d0) qr[d0] = *(const bf16x8*)(Qw + d0 * 16);
        const char* Kcol = (const char*)(Kg + h * 256 + mp * 128); const char* Vcol = (const char*)(Vg + h * 256);
        { const bf16* Kw = Kg + (size_t)qrow * D + h * 256 + mp * 128 + hi * 8; float dot = 0.f;
#pragma unroll
          for (int d0 = 0; d0 < 8; ++d0) { if ((d0 & 1) == 0) asm volatile("" ::: "memory");
              const u32x4 kk = *(const u32x4*)(Kw + d0 * 16); const u32x4 qq = *reinterpret_cast<const u32x4*>(&qr[d0]);
              dot += bflo(kk.x) * bflo(qq.x) + bfhi(kk.x) * bfhi(qq.x) + bflo(kk.y) * bflo(qq.y) + bfhi(kk.y) * bfhi(qq.y) + bflo(kk.z) * bflo(qq.z) + bfhi(kk.z) * bfhi(qq.z) + bflo(kk.w) * bflo(qq.w) + bfhi(kk.w) * bfhi(qq.w); }
          { auto rr = __builtin_amdgcn_permlane32_swap(__float_as_uint(dot), __float_as_uint(dot), false, false); dot = __uint_as_float(rr[0]) + __uint_as_float(rr[1]); }
          float mm = dot * C; mm = fminf(mm, swz_xor<1>(mm)); mm = fminf(mm, swz_xor<2>(mm)); mm = fminf(mm, swz_xor<4>(mm)); mm = fminf(mm, swz_xor<8>(mm)); mm = fminf(mm, swz_xor<16>(mm));
          if (lane == 0) mslot[wid] = mm; LDS_WAIT(); BARF();
          float mmin = mslot[0];
#pragma unroll
          for (int w = 1; w < 8; ++w) mmin = fminf(mmin, mslot[w]);
          const float wf = fminf((smax_l2 - mmin + 152.f) / (-nsl2) + 2.f, 20000.f); const int W = (int)wf;
          const int qmin = NMETA + qb * 256, qmax = qmin + 255;
          const int klo = qmin - W, khi = qmax + W;
          t_lo = (klo <= 15) ? 0 : (klo + 48) / 64; if (t_lo > 128) t_lo = 128;
          t_hi = (khi + 48) / 64; if (t_hi > 128) t_hi = 128; if (t_hi < t_lo) t_hi = t_lo;
          t_lo = __builtin_amdgcn_readfirstlane(t_lo); t_hi = __builtin_amdgcn_readfirstlane(t_hi); }
        const int ntl = t_hi - t_lo + 1;
        f32x16 o[8];
#pragma unroll
        for (int d = 0; d < 8; ++d)
#pragma unroll
            for (int r = 0; r < 16; ++r) o[d][r] = 0.f;
        float m_reg = NEG, l_reg = 0.f;
#define ATT_ISSUE(t, buf) do { const size_t rb_ = ((t) == 0) ? (size_t)NX : (size_t)(b * SEQ + 64 * ((t) - 1)); const char* kg_ = Kcol + rb_ * (D * 2); const char* vg_ = Vcol + rb_ * (D * 2); const int tq_ = opaque(tid); \
        unsigned ko_, vo_; { int r_, c_; kimg_rc(tq_ * 16, r_, c_); ko_ = (unsigned)(r_ * (D * 2) + c_ * 2); vimg_rc(tq_ * 16, r_, c_); vo_ = (unsigned)(r_ * (D * 2) + c_ * 2); }     \
        _Pragma("unroll") for (int i_ = 0; i_ < 2; ++i_) glds16(kg_ + (size_t)i_ * (32 * D * 2) + ko_, Kb + (buf) * 16384 + (i_ * 8 + wid) * 1024); \
        _Pragma("unroll") for (int i_ = 0; i_ < 4; ++i_) glds16(vg_ + (size_t)i_ * (16 * D * 2) + vo_, Vb + (buf) * 32768 + (i_ * 8 + wid) * 1024); } while (0)
#define ATT_KLOAD(BUF, KH) do { const int ka = ka0 + (BUF) * 16384 + (KH) * 8192; \
              asm volatile("ds_read_b128 %0, %1" : "=&v"(k0) : "v"(ka) : "memory"); asm volatile("ds_read_b128 %0, %1" : "=&v"(k1) : "v"(ka ^ 32) : "memory"); } while (0)
#define ATT_S1(KH, PRE) do { f32x16 p; \
            _Pragma("unroll") for (int r = 0; r < 16; ++r) p[r] = 0.f; \
            { if (!(PRE)) ATT_KLOAD(cur, KH); \
              bf16x8 k2, k3, k4, k5, k6, k7; { const int ka = ka0 + cur * 16384 + KH * 8192; \
              asm volatile("ds_read_b128 %0, %1" : "=&v"(k2) : "v"(ka ^ 64) : "memory"); asm volatile("ds_read_b128 %0, %1" : "=&v"(k3) : "v"(ka ^ 96) : "memory"); \
              asm volatile("ds_read_b128 %0, %1 offset:128" : "=&v"(k4) : "v"(ka) : "memory"); asm volatile("ds_read_b128 %0, %1 offset:128" : "=&v"(k5) : "v"(ka ^ 32) : "memory"); \
              asm volatile("ds_read_b128 %0, %1 offset:128" : "=&v"(k6) : "v"(ka ^ 64) : "memory"); asm volatile("ds_read_b128 %0, %1 offset:128" : "=&v"(k7) : "v"(ka ^ 96) : "memory"); } \
              __builtin_amdgcn_s_setprio(2); asm volatile("s_waitcnt lgkmcnt(6)" ::: "memory"); SBAR(); p = __builtin_amdgcn_mfma_f32_32x32x16_bf16(k0, qr[0], p, 0, 0, 0); p = __builtin_amdgcn_mfma_f32_32x32x16_bf16(k1, qr[1], p, 0, 0, 0); SBAR(); \
              asm volatile("s_waitcnt lgkmcnt(4)" ::: "memory"); SBAR(); p = __builtin_amdgcn_mfma_f32_32x32x16_bf16(k2, qr[2], p, 0, 0, 0); p = __builtin_amdgcn_mfma_f32_32x32x16_bf16(k3, qr[3], p, 0, 0, 0); SBAR(); \
              asm volatile("s_waitcnt lgkmcnt(2)" ::: "memory"); SBAR(); p = __builtin_amdgcn_mfma_f32_32x32x16_bf16(k4, qr[4], p, 0, 0, 0); p = __builtin_amdgcn_mfma_f32_32x32x16_bf16(k5, qr[5], p, 0, 0, 0); SBAR(); \
              asm volatile("s_waitcnt lgkmcnt(0)" ::: "memory"); SBAR(); p = __builtin_amdgcn_mfma_f32_32x32x16_bf16(k6, qr[6], p, 0, 0, 0); p = __builtin_amdgcn_mfma_f32_32x32x16_bf16(k7, qr[7], p, 0, 0, 0); SBAR(); __builtin_amdgcn_s_setprio(0); } \
            float off; { const int sd = (KH == 0) ? sd0 : sd1; \
            if (sd < 0) { off = (27.f + 32.f * KH) - qrel; _Pragma("unroll") for (int r = 0; r < 16; ++r) { p[r] = fmaf(p[r], Cq, crn[15 - r]); asm("" : "+v"(p[r])); } } \
            else if (sd > 0) { off = qrel - 32.f * KH; _Pragma("unroll") for (int r = 0; r < 16; ++r) { p[r] = fmaf(p[r], Cq, crn[r]); asm("" : "+v"(p[r])); } } \
            else { off = 0.f; _Pragma("unroll") for (int r = 0; r < 16; ++r) { const float dd = ((KH == 0 && r >= 8) ? q8 : qrel) - (float)(CR(r) + 32 * KH); p[r] = fmaf(p[r], Cq, -fabsf(dd)); asm("" : "+v"(p[r])); } } } \
            float pmax = fmaxf(fmaxf(p[0], p[1]), p[2]); \
            _Pragma("unroll") for (int r = 3; r < 15; r += 2) pmax = fmaxf(fmaxf(pmax, p[r]), p[r + 1]); \
            pmax = fmaxf(pmax, p[15]) + off; \
            { auto rr = __builtin_amdgcn_permlane32_swap(__float_as_uint(pmax), __float_as_uint(pmax), false, false); pmax = fmaxf(__uint_as_float(rr[0]), __uint_as_float(rr[1])); } \
              \
              \
            dead = __all(pmax - m_reg < DEADQ); \
            if (!dead) { float mn; \
            if (__builtin_expect(__all(pmax - m_reg <= THRQ), 1)) { mn = m_reg; alpha = 1.f; } \
            else { mn = fmaxf(m_reg, pmax); alpha = __builtin_amdgcn_exp2f((m_reg - mn) * asl); m_reg = mn; } \
            float ps = 0.f; const float nm = (off - mn) * asl; \
            _Pragma("unroll") for (int r = 0; r < 16; ++r) { p[r] = __builtin_amdgcn_exp2f(fmaf(p[r], asl, nm)); ps += p[r]; } \
            l_reg = l_reg * alpha + ps; \
            pack_p2(p, pa0, pa1); pv8_pre<KH>(vb, va); } } while (0)
#define ATT_S2(KH) do { if (!dead) { \
            if (__any(alpha < 1.f)) { const int ln_ = opaque(tid) & 63, hi_ = ln_ >> 5; LAS float* al_ = (LAS float*)(lds + 147456) + wid * 64 + 32; if (hi_ == 0) al_[ln_] = alpha; LDS_WAIT(); \
                _Pragma("unroll") for (int r = 0; r < 16; ++r) { const float a = al_[crow(r, hi_)]; \
                    _Pragma("unroll") for (int d = 0; d < 8; ++d) o[d][r] *= a; } } \
            pv_half8p<KH>(o, vb, pa0, pa1, va); } } while (0)
        int tcn = (NMETA + qb * 256 + 128 + 48) / 64; tcn = tcn < t_lo ? t_lo : (tcn > t_hi ? t_hi : tcn);
        if (t_lo == 0 && t_hi == 128) tcn = 0;
        const int nright = t_hi - tcn + 1;
#define ATT_TILE(i) (((i) < nright) ? tcn + (i) : tcn - 1 - ((i) - nright))
        bf16x8 k0, k1; bool kpre = false;
        ATT_ISSUE(ATT_TILE(0), 0); WAITBAR();
        if (grp == 1) BARF();
#pragma unroll 1
        for (int tt = 0; tt < ntl; ++tt) {
            const int t = ATT_TILE(tt), cur = tt & 1;
            const float qrel = qposf - (float)(t == 0 ? 0 : 64 * t - 48);
            const int kb0 = (t == 0) ? 0 : 64 * t - 48, sd0 = (t == 0) ? 0 : ((kb0 >= qw0 + 31) ? 1 : ((kb0 + 31 <= qw0) ? -1 : 0)), sd1 = (kb0 + 32 >= qw0 + 31) ? 1 : ((kb0 + 63 <= qw0) ? -1 : 0);
            const float q8 = (t == 0) ? 1e30f : qrel;
            const int vb = vb0 + cur * 32768;
            bf16x8 pa0, pa1; float alpha; bool dead; s16x4 va[4];
            ATT_S1(0, kpre);
            BARF();
            if (tt + 1 < ntl) ATT_ISSUE(ATT_TILE(tt + 1), cur ^ 1);
            ATT_S2(0);
            if (t != 0) ATT_KLOAD(cur, 1);
            BARF();
            if (t != 0) ATT_S1(1, true);
            asm volatile("s_waitcnt vmcnt(0)" ::: "memory");
            BARF();
            if (t != 0) ATT_S2(1);
            kpre = (grp == 1) && (tt + 1 < ntl);
            if (kpre) ATT_KLOAD(cur ^ 1, 0);
            BARF();
        }
        if (grp == 0) BARF();
#undef ATT_ISSUE
#undef ATT_S1
#undef ATT_KLOAD
#undef ATT_S2
#undef ATT_TILE
#undef CR
        { auto rr = __builtin_amdgcn_permlane32_swap(__float_as_uint(l_reg), __float_as_uint(l_reg), false, false); l_reg = __uint_as_float(rr[0]) + __uint_as_float(rr[1]); }
        const int lno = opaque(tid) & 63, hio = lno >> 5;
        LAS float* li_l = (LAS float*)(lds + 147456) + wid * 64;
        if (hio == 0) li_l[lno] = l_reg; LDS_WAIT();
        f32x4* st4 = (f32x4*)(stash + (size_t)wid * 8192) + lno;
        if (mp == 0) {
#pragma unroll
            for (int q4 = 0; q4 < 4; ++q4) { float rl[4];
#pragma unroll
                for (int i = 0; i < 4; ++i) rl[i] = __builtin_amdgcn_rcpf(li_l[crow(4 * q4 + i, hio)]);
#pragma unroll
                for (int d = 0; d < 8; ++d) st4[(d * 4 + q4) * 64] = (f32x4){o[d][4 * q4] * rl[0], o[d][4 * q4 + 1] * rl[1], o[d][4 * q4 + 2] * rl[2], o[d][4 * q4 + 3] * rl[3]}; }
        } else {
            const int r32o = lno & 31;
            float gsc[8];
#pragma unroll
            for (int d = 0; d < 8; ++d) gsc[d] = subg[d * 32 + r32o] * 0.8f;
            lchar* tl = lds + wid * 16896;
#pragma unroll
            for (int q4 = 0; q4 < 4; ++q4) {
                f32x4 sv[8];
#pragma unroll
                for (int d = 0; d < 8; ++d) sv[d] = st4[(d * 4 + q4) * 64];
                asm volatile("" ::: "memory");
#pragma unroll
                for (int i = 0; i < 4; ++i) { const int r = 4 * q4 + i; const float rl = __builtin_amdgcn_rcpf(li_l[crow(r, hio)]) * lam; float ss = 0.f; float v[8];
#pragma unroll
                    for (int d = 0; d < 8; ++d) { v[d] = sv[d][i] - o[d][r] * rl; ss += v[d] * v[d]; }
                    ss = half_sum(ss);
                    const float rs = 1.0f / sqrtf(ss * (1.f / 256.f) + EPS);
#pragma unroll
                    for (int d = 0; d < 8; ++d) *(LAS bf16*)(tl + crow(r, hio) * 528 + (d * 32 + r32o) * 2) = (bf16)f2bf(v[d] * rs * gsc[d]); }
                asm volatile("" ::: "memory"); }
            LDS_WAIT();
            bf16* orow = Og + (size_t)(b * SEQ + qb * 256 + wid * 32 + (lno >> 5)) * D + h * 256 + (lno & 31) * 8;
#pragma unroll
            for (int i = 0; i < 16; ++i) { const lchar* sp = tl + (2 * i + (lno >> 5)) * 528 + (lno & 31) * 16; const u32x2 lo = *(const LAS u32x2*)sp, hi2 = *(const LAS u32x2*)(sp + 8);
                *(u32x4*)(orow + (size_t)(2 * i) * D) = (u32x4){lo.x, lo.y, hi2.x, hi2.y}; }
            LDS_WAIT();
        }
        BARF();
    }
}
__device__ __forceinline__ void normmax_phase(Frame& F, const bf16* Qg, const bf16* Kg, unsigned* nrm) {
    using namespace mx;
    LAS unsigned* red = (LAS unsigned*)(F.lds + 131072);
    if (F.tid < 64) red[F.tid] = 0u;
    __syncthreads();
    for (int c = F.vcu; c < 256; c += F.G) {
        const int b = c >> 7; float mq[8], mk[8];
#pragma unroll
        for (int j = 0; j < 8; ++j) { mq[j] = 0.f; mk[j] = 0.f; }
        const int nrow = (c == 0 || c == 128) ? 10 : 8;
        for (int i = 0; i < nrow; ++i) {
            const int row = (i < 8) ? c * 64 + F.wave * 8 + i : NX + F.wave * 2 + (i - 8);
#pragma unroll
            for (int j = 0; j < 8; ++j) {
                const u32x4 kv = *(const u32x4*)(Kg + (size_t)row * D + 512 * j + 8 * F.lane);
                float sk = bflo(kv.x) * bflo(kv.x) + bfhi(kv.x) * bfhi(kv.x) + bflo(kv.y) * bflo(kv.y) + bfhi(kv.y) * bfhi(kv.y) + bflo(kv.z) * bflo(kv.z) + bfhi(kv.z) * bfhi(kv.z) + bflo(kv.w) * bflo(kv.w) + bfhi(kv.w) * bfhi(kv.w);
                sk += swz_xor<1>(sk); sk += swz_xor<2>(sk); sk += swz_xor<4>(sk); sk += swz_xor<8>(sk); mk[j] = fmaxf(mk[j], sk);
                if (i < 8) { const u32x4 qv = *(const u32x4*)(Qg + (size_t)row * D + 512 * j + 8 * F.lane);
                    float sq = bflo(qv.x) * bflo(qv.x) + bfhi(qv.x) * bfhi(qv.x) + bflo(qv.y) * bflo(qv.y) + bfhi(qv.y) * bfhi(qv.y) + bflo(qv.z) * bflo(qv.z) + bfhi(qv.z) * bfhi(qv.z) + bflo(qv.w) * bflo(qv.w) + bfhi(qv.w) * bfhi(qv.w);
                    sq += swz_xor<1>(sq); sq += swz_xor<2>(sq); sq += swz_xor<4>(sq); sq += swz_xor<8>(sq); mq[j] = fmaxf(mq[j], sq); } }
        }
        if ((F.lane & 15) == 0) {
#pragma unroll
            for (int j = 0; j < 8; ++j) { const int seg = 4 * j + (F.lane >> 4); __hip_atomic_fetch_max(red + seg, __float_as_uint(mq[j]), __ATOMIC_RELAXED, __HIP_MEMORY_SCOPE_WORKGROUP); __hip_atomic_fetch_max(red + 32 + seg, __float_as_uint(mk[j]), __ATOMIC_RELAXED, __HIP_MEMORY_SCOPE_WORKGROUP); } }
        __syncthreads();
        if (F.tid < 64) { const int tsr = F.tid >> 5, seg = F.tid & 31; __hip_atomic_fetch_max(nrm + (tsr * 2 + b) * 32 + seg, red[F.tid], __ATOMIC_RELAXED, __HIP_MEMORY_SCOPE_AGENT); red[F.tid] = 0u; }
        __syncthreads();
    }
}

__device__ __forceinline__ void ret_local_unit(lchar* lds, const bf16* Kg, const bf16* Vg, bf16* ST, int b, int h, int c, float lgf2, float lgb2) {
    using namespace mx;
    const int tid = threadIdx.x, wid = __builtin_amdgcn_readfirstlane(tid >> 6), lane = tid & 63, r32 = lane & 31, hi = lane >> 5;
    __syncthreads();
    { const int tq = opaque(tid); const size_t hb = ((size_t)((b * NH + h) * SEQ + 128 * c)) * 256;
      const char* kg = (const char*)(Kg + hb); const char* vg = (const char*)(Vg + hb);
#pragma unroll
      for (int hf = 0; hf < 2; ++hf)
#pragma unroll
        for (int i = 0; i < 4; ++i) { int k, c2; vimg_rc((i * 512 + tq) * 16, k, c2); const unsigned off = (unsigned)((64 * hf + k) * 512 + c2 * 2);
            glds16(kg + off, lds + hf * 32768 + (i * 8 + wid) * 1024); glds16(vg + off, lds + 65536 + hf * 32768 + (i * 8 + wid) * 1024); } }
    WAITBAR();
    const int vbK = lds_addr(lds) + v_rd_base(lane) + wid * 512, vbV = lds_addr(lds) + 65536 + v_rd_base(lane);
#pragma unroll 1
    for (int dir = 0; dir < 2; ++dir) {
        f32x16 acc[8];
#pragma unroll
        for (int d = 0; d < 8; ++d)
#pragma unroll
            for (int r = 0; r < 16; ++r) acc[d][r] = 0.f;
        const float lg = dir == 0 ? lgf2 : lgb2;
#define RL_W(T) __builtin_amdgcn_exp2f(lg * (float)(dir == 0 ? 127 - (T) : (T)))
#define RL_STEP(HF, KS) do { const int vk_ = vbK + (HF) * 32768, vv_ = vbV + (HF) * 32768; \
            const s16x4 al = tr_read<vro(0, KS, 0)>(vk_), ah = tr_read<vro(0, KS, 1)>(vk_); \
            const s16x4 l0 = tr_read<vro(0, KS, 0)>(vv_), h0 = tr_read<vro(0, KS, 1)>(vv_), l1 = tr_read<vro(1, KS, 0)>(vv_), h1 = tr_read<vro(1, KS, 1)>(vv_), l2 = tr_read<vro(2, KS, 0)>(vv_), h2 = tr_read<vro(2, KS, 1)>(vv_), l3 = tr_read<vro(3, KS, 0)>(vv_), h3 = tr_read<vro(3, KS, 1)>(vv_); \
            const s16x4 l4 = tr_read<vro(4, KS, 0)>(vv_), h4 = tr_read<vro(4, KS, 1)>(vv_), l5 = tr_read<vro(5, KS, 0)>(vv_), h5 = tr_read<vro(5, KS, 1)>(vv_), l6 = tr_read<vro(6, KS, 0)>(vv_), h6 = tr_read<vro(6, KS, 1)>(vv_), l7 = tr_read<vro(7, KS, 0)>(vv_), h7 = tr_read<vro(7, KS, 1)>(vv_); \
            const int tb_ = 64 * (HF) + 16 * (KS) + 8 * hi; \
            const float w0 = RL_W(tb_), w1 = RL_W(tb_ + 1), w2 = RL_W(tb_ + 2), w3 = RL_W(tb_ + 3), w4 = RL_W(tb_ + 4), w5 = RL_W(tb_ + 5), w6 = RL_W(tb_ + 6), w7 = RL_W(tb_ + 7); \
            asm volatile("s_waitcnt lgkmcnt(0)" ::: "memory"); SBAR(); \
            const bf16x8 ar = MX_PK(al, ah); const u32x4 aw = *reinterpret_cast<const u32x4*>(&ar); u32x4 as_; \
            as_.x = cvtpk(bflo(aw.x) * w0, bfhi(aw.x) * w1); as_.y = cvtpk(bflo(aw.y) * w2, bfhi(aw.y) * w3); as_.z = cvtpk(bflo(aw.z) * w4, bfhi(aw.z) * w5); as_.w = cvtpk(bflo(aw.w) * w6, bfhi(aw.w) * w7); \
            const bf16x8 a = *reinterpret_cast<const bf16x8*>(&as_); \
            acc[0] = __builtin_amdgcn_mfma_f32_32x32x16_bf16(a, MX_PK(l0, h0), acc[0], 0, 0, 0); acc[1] = __builtin_amdgcn_mfma_f32_32x32x16_bf16(a, MX_PK(l1, h1), acc[1], 0, 0, 0); \
            acc[2] = __builtin_amdgcn_mfma_f32_32x32x16_bf16(a, MX_PK(l2, h2), acc[2], 0, 0, 0); acc[3] = __builtin_amdgcn_mfma_f32_32x32x16_bf16(a, MX_PK(l3, h3), acc[3], 0, 0, 0); \
            acc[4] = __builtin_amdgcn_mfma_f32_32x32x16_bf16(a, MX_PK(l4, h4), acc[4], 0, 0, 0); acc[5] = __builtin_amdgcn_mfma_f32_32x32x16_bf16(a, MX_PK(l5, h5), acc[5], 0, 0, 0); \
            acc[6] = __builtin_amdgcn_mfma_f32_32x32x16_bf16(a, MX_PK(l6, h6), acc[6], 0, 0, 0); acc[7] = __builtin_amdgcn_mfma_f32_32x32x16_bf16(a, MX_PK(l7, h7), acc[7], 0, 0, 0); } while (0)
        RL_STEP(0, 0); RL_STEP(0, 1); RL_STEP(0, 2); RL_STEP(0, 3); RL_STEP(1, 0); RL_STEP(1, 1); RL_STEP(1, 2); RL_STEP(1, 3);
#undef RL_STEP
#undef RL_W
        bf16* S = ST + ((size_t)(((b * NH + h) * 2 + dir) * 64 + c) << 16);
        const int hio = opaque(hi), r32o = opaque(r32);
#pragma unroll
        for (int r = 0; r < 16; ++r) { bf16* sp = S + (size_t)(32 * wid + crow(r, hio)) * 256 + r32o;
#pragma unroll
            for (int d = 0; d < 8; ++d) sp[d * 32] = (bf16)f2bf(acc[d][r]); }
    }
}
__device__ __forceinline__ void ret_scan(Frame& F, const bf16* Kg, const bf16* Vg, bf16* ST, const float* logdec) {
    using namespace mx;
    const int gid = F.vcu * 512 + F.tid, NT = F.G * 512, NV = 64 * 8192;
    for (int vb = gid; vb < NV; vb += 4 * NT) {
        float s[4][8], dec[4]; bf16* base[4]; int dirs[4]; bool ok[4]; u32x4 nx[4];
#pragma unroll
        for (int q = 0; q < 4; ++q) {
            const int v0 = vb + q * NT; ok[q] = v0 < NV; const int vv0 = ok[q] ? v0 : gid;
            const int seq = vv0 >> 13, e = (vv0 & 8191) * 8, dir = seq & 1, h = (seq >> 1) & 15, dk = e >> 8, dv = e & 255; dirs[q] = dir;
            const float lg2 = -expf(logdec[dir * NH + h]) * LOG2E; dec[q] = __builtin_amdgcn_exp2f(lg2 * 128.f);
#pragma unroll
            for (int j = 0; j < 8; ++j) s[q][j] = 0.f;
            if (dir == 0) {
                for (int m = 0; m < NMETA; ++m) { const float w = __builtin_amdgcn_exp2f(lg2 * (float)(15 - m)) * __uint_as_float((unsigned)Kg[(size_t)(NX + m) * D + h * 256 + dk] << 16);
                    const u32x4 vv = *(const u32x4*)(Vg + (size_t)(NX + m) * D + h * 256 + dv);
                    s[q][0] += w * bflo(vv.x); s[q][1] += w * bfhi(vv.x); s[q][2] += w * bflo(vv.y); s[q][3] += w * bfhi(vv.y); s[q][4] += w * bflo(vv.z); s[q][5] += w * bfhi(vv.z); s[q][6] += w * bflo(vv.w); s[q][7] += w * bfhi(vv.w); }
            }
            base[q] = ST + ((size_t)(seq * 64) << 16) + e;
            nx[q] = *(const u32x4*)(base[q] + ((size_t)(dir == 0 ? 0 : 63) << 16));
        }
#pragma unroll 2
        for (int st = 0; st < 64; ++st) {
            u32x4 t[4];
#pragma unroll
            for (int q = 0; q < 4; ++q) { t[q] = nx[q]; if (st + 1 < 64) nx[q] = *(const u32x4*)(base[q] + ((size_t)(dirs[q] == 0 ? st + 1 : 62 - st) << 16)); }
#pragma unroll
            for (int q = 0; q < 4; ++q) { bf16* p = base[q] + ((size_t)(dirs[q] == 0 ? st : 63 - st) << 16);
                u32x4 w; w.x = pk2(s[q][0], s[q][1]); w.y = pk2(s[q][2], s[q][3]); w.z = pk2(s[q][4], s[q][5]); w.w = pk2(s[q][6], s[q][7]);
                if (ok[q]) *(u32x4*)p = w;
                const float d = dec[q];
                s[q][0] = s[q][0] * d + bflo(t[q].x); s[q][1] = s[q][1] * d + bfhi(t[q].x); s[q][2] = s[q][2] * d + bflo(t[q].y); s[q][3] = s[q][3] * d + bfhi(t[q].y);
                s[q][4] = s[q][4] * d + bflo(t[q].z); s[q][5] = s[q][5] * d + bfhi(t[q].z); s[q][6] = s[q][6] * d + bflo(t[q].w); s[q][7] = s[q][7] * d + bfhi(t[q].w); }
        }
    }
}
struct RoUnit { int b, h, c; };
__device__ __forceinline__ RoUnit ro_unit(int id) { RoUnit u; const int bh = id >> 6; u.b = bh >> 4; u.h = bh & 15; u.c = id & 63; return u; }
__device__ __forceinline__ void ret_out_phase(lchar* lds, const bf16* Qg, const bf16* Kg, const bf16* Vg, const bf16* Gg, const bf16* ST, bf16* Og, const float* logdec, int vcu, int G) {
    using namespace mx;
    const int tid = threadIdx.x, wid = __builtin_amdgcn_readfirstlane(tid >> 6), lane = tid & 63, r32 = lane & 31, hi = lane >> 5, rb = wid & 3, dh = wid >> 2;
    LAS unsigned* offl = (LAS unsigned*)(lds + 131072);
    LAS float* ssl = (LAS float*)(lds + 147456);
    { const int tq = opaque(tid);
#pragma unroll
      for (int i = 0; i < 4; ++i) { const int P = (i * 512 + tq) * 16; int r, cc; kimg_rc(P & 16383, r, cc); cc += (P >> 14) * 128; int k, c2; vimg_rc(P, k, c2);
          offl[i * 512 + tq] = (unsigned)(r * 512 + cc * 2); offl[(4 + i) * 512 + tq] = (unsigned)(k * 512 + c2 * 2); } }
    __syncthreads();
    const int nun = (2048 - vcu + G - 1) / G;
#define RO_ISSUE(u, k, SLOT) do { const size_t hb_ = ((size_t)(((u).b * NH + (u).h) * SEQ + 128 * (u).c)) * 256; const LAS unsigned* of_ = offl + opaque(tid); \
        if ((k) < 4) { const bf16* src_ = (((k) & 1) ? Vg : Kg) + hb_ + (size_t)(64 * ((k) >> 1)) * 256; \
            _Pragma("unroll") for (int i_ = 0; i_ < 4; ++i_) glds16((const char*)src_ + of_[(((k) & 1) * 4 + i_) * 512], lds + (SLOT) * 32768 + (i_ * 8 + wid) * 1024); } \
        else { const char* src_ = (const char*)(ST + ((size_t)((((u).b * NH + (u).h) * 2 + (((k) - 4) >> 2)) * 64 + (u).c) << 16)) + (size_t)(((k) - 4) & 3) * 64 * 512; \
            _Pragma("unroll") for (int i_ = 0; i_ < 4; ++i_) glds16(src_ + of_[(4 + i_) * 512], lds + (SLOT) * 32768 + (i_ * 8 + wid) * 1024); } } while (0)
    RoUnit cu = ro_unit(vcu);
    RO_ISSUE(cu, 0, 0); RO_ISSUE(cu, 1, 1); RO_ISSUE(cu, 2, 2);
    const int ka0 = lds_addr(lds) + r32 * 256 + ((hi * 16) ^ ((r32 & 7) << 4));
    const int vb0 = lds_addr(lds) + v_rd_base(lane) + dh * 2048;
#pragma unroll 1
    for (int ui = 0; ui < nun; ++ui) {
        const bool lastu = (ui + 1 == nun); const RoUnit nu = ro_unit(vcu + (ui + 1) * G);
        const float lgf2 = -expf(logdec[cu.h]) * LOG2E, lgb2 = -expf(logdec[NH + cu.h]) * LOG2E;
        const int r0 = cu.b * SEQ + 128 * cu.c, ii = 32 * rb + r32;
        bf16x8 qr[16];
        const size_t hb = ((size_t)((cu.b * NH + cu.h) * SEQ + 128 * cu.c)) * 256;
        { const bf16* Qw = Qg + hb + (size_t)opaque(ii) * 256 + opaque(hi) * 8;
#pragma unroll
          for (int d0 = 0; d0 < 16; ++d0) qr[d0] = *(const bf16x8*)(Qw + d0 * 16); }
        f32x16 o[4]; bf16x8 pa0, pa1, pa2, pa3;
#pragma unroll
        for (int d = 0; d < 4; ++d)
#pragma unroll
            for (int r = 0; r < 16; ++r) o[d][r] = 0.f;
#define RO_OPEN(k) do { if (lastu && (k) >= 10) { if ((k) == 10) asm volatile("s_waitcnt vmcnt(4)" ::: "memory"); else asm volatile("s_waitcnt vmcnt(0)" ::: "memory"); } else asm volatile("s_waitcnt vmcnt(8)" ::: "memory"); \
        BARF(); if ((k) + 3 < 12) RO_ISSUE(cu, (k) + 3, ((k) + 3) & 3); else if (!lastu) RO_ISSUE(nu, (k) + 3 - 12, ((k) + 3) & 3); } while (0)
#define RO_QKCHAIN(P, KB, OFF) do { bf16x8 k0, k1, k2, k3, k4, k5, k6, k7; \
            asm volatile("ds_read_b128 %0, %1 offset:%2" : "=&v"(k0) : "v"(KB), "i"(OFF) : "memory"); asm volatile("ds_read_b128 %0, %1 offset:%2" : "=&v"(k1) : "v"(KB ^ 32), "i"(OFF) : "memory"); \
            asm volatile("ds_read_b128 %0, %1 offset:%2" : "=&v"(k2) : "v"(KB ^ 64), "i"(OFF) : "memory"); asm volatile("ds_read_b128 %0, %1 offset:%2" : "=&v"(k3) : "v"(KB ^ 96), "i"(OFF) : "memory"); \
            asm volatile("ds_read_b128 %0, %1 offset:%2" : "=&v"(k4) : "v"(KB), "i"(OFF + 128) : "memory"); asm volatile("ds_read_b128 %0, %1 offset:%2" : "=&v"(k5) : "v"(KB ^ 32), "i"(OFF + 128) : "memory"); \
            asm volatile("ds_read_b128 %0, %1 offset:%2" : "=&v"(k6) : "v"(KB ^ 64), "i"(OFF + 128) : "memory"); asm volatile("ds_read_b128 %0, %1 offset:%2" : "=&v"(k7) : "v"(KB ^ 96), "i"(OFF + 128) : "memory"); \
            asm volatile("s_waitcnt lgkmcnt(4)" ::: "memory"); SBAR(); \
            P = __builtin_amdgcn_mfma_f32_32x32x16_bf16(k0, qr[(OFF >= 16384 ? 8 : 0) + 0], P, 0, 0, 0); P = __builtin_amdgcn_mfma_f32_32x32x16_bf16(k1, qr[(OFF >= 16384 ? 8 : 0) + 1], P, 0, 0, 0); \
            P = __builtin_amdgcn_mfma_f32_32x32x16_bf16(k2, qr[(OFF >= 16384 ? 8 : 0) + 2], P, 0, 0, 0); P = __builtin_amdgcn_mfma_f32_32x32x16_bf16(k3, qr[(OFF >= 16384 ? 8 : 0) + 3], P, 0, 0, 0); SBAR(); \
            asm volatile("s_waitcnt lgkmcnt(0)" ::: "memory"); SBAR(); \
            P = __builtin_amdgcn_mfma_f32_32x32x16_bf16(k4, qr[(OFF >= 16384 ? 8 : 0) + 4], P, 0, 0, 0); P = __builtin_amdgcn_mfma_f32_32x32x16_bf16(k5, qr[(OFF >= 16384 ? 8 : 0) + 5], P, 0, 0, 0); \
            P = __builtin_amdgcn_mfma_f32_32x32x16_bf16(k6, qr[(OFF >= 16384 ? 8 : 0) + 6], P, 0, 0, 0); P = __builtin_amdgcn_mfma_f32_32x32x16_bf16(k7, qr[(OFF >= 16384 ? 8 : 0) + 7], P, 0, 0, 0); SBAR(); } while (0)
#define RO_SCORES(SLOT, KT) do { f32x16 p0, p1; \
            _Pragma("unroll") for (int r = 0; r < 16; ++r) { p0[r] = 0.f; p1[r] = 0.f; } \
            { const int kb_ = opaque(ka0) + (SLOT) * 32768; RO_QKCHAIN(p0, kb_, 0); RO_QKCHAIN(p0, kb_, 16384); const int kc_ = opaque(kb_) + 8192; RO_QKCHAIN(p1, kc_, 0); RO_QKCHAIN(p1, kc_, 16384); } \
            const float df = (float)(opaque(ii) - 64 * (KT) - 4 * opaque(hi)); \
            _Pragma("unroll") for (int r = 0; r < 16; ++r) { const float d0_ = df - (float)((r & 3) + 8 * (r >> 2)), d1_ = d0_ - 32.f; \
                p0[r] *= __builtin_amdgcn_exp2f(d0_ >= 0.f ? lgf2 * d0_ : -lgb2 * d0_); p1[r] *= __builtin_amdgcn_exp2f(d1_ >= 0.f ? lgf2 * d1_ : -lgb2 * d1_); } \
            pack_p(p0, p1, pa0, pa1, pa2, pa3); } while (0)
#define RO_BRD(D0, L0, H0, L1, H1, L2, H2, L3, H3) const s16x4 L0 = tr_read<vro(D0, 0, 0)>(vb_), H0 = tr_read<vro(D0, 0, 1)>(vb_), L1 = tr_read<vro(D0, 1, 0)>(vb_), H1 = tr_read<vro(D0, 1, 1)>(vb_), \
            L2 = tr_read<vro(D0, 2, 0)>(vb_), H2 = tr_read<vro(D0, 2, 1)>(vb_), L3 = tr_read<vro(D0, 3, 0)>(vb_), H3 = tr_read<vro(D0, 3, 1)>(vb_)
#define RO_BMM(ACC, A0, A1, A2, A3, L0, H0, L1, H1, L2, H2, L3, H3) do { ACC = __builtin_amdgcn_mfma_f32_32x32x16_bf16(A0, MX_PK(L0, H0), ACC, 0, 0, 0); ACC = __builtin_amdgcn_mfma_f32_32x32x16_bf16(A1, MX_PK(L1, H1), ACC, 0, 0, 0); \
            ACC = __builtin_amdgcn_mfma_f32_32x32x16_bf16(A2, MX_PK(L2, H2), ACC, 0, 0, 0); ACC = __builtin_amdgcn_mfma_f32_32x32x16_bf16(A3, MX_PK(L3, H3), ACC, 0, 0, 0); } while (0)
#define RO_MUL(ACC, SLOT, A0, A1, A2, A3) do { const int vb_ = opaque(vb0) + (SLOT) * 32768; \
            RO_BRD(0, a_l0, a_h0, a_l1, a_h1, a_l2, a_h2, a_l3, a_h3); RO_BRD(1, b_l0, b_h0, b_l1, b_h1, b_l2, b_h2, b_l3, b_h3); \
            asm volatile("s_waitcnt lgkmcnt(8)" ::: "memory"); SBAR(); RO_BMM(ACC[0], A0, A1, A2, A3, a_l0, a_h0, a_l1, a_h1, a_l2, a_h2, a_l3, a_h3); SBAR(); \
            RO_BRD(2, c_l0, c_h0, c_l1, c_h1, c_l2, c_h2, c_l3, c_h3); \
            asm volatile("s_waitcnt lgkmcnt(8)" ::: "memory"); SBAR(); RO_BMM(ACC[1], A0, A1, A2, A3, b_l0, b_h0, b_l1, b_h1, b_l2, b_h2, b_l3, b_h3); SBAR(); \
            RO_BRD(3, d_l0, d_h0, d_l1, d_h1, d_l2, d_h2, d_l3, d_h3); \
            asm volatile("s_waitcnt lgkmcnt(8)" ::: "memory"); SBAR(); RO_BMM(ACC[2], A0, A1, A2, A3, c_l0, c_h0, c_l1, c_h1, c_l2, c_h2, c_l3, c_h3); SBAR(); \
            asm volatile("s_waitcnt lgkmcnt(0)" ::: "memory"); SBAR(); RO_BMM(ACC[3], A0, A1, A2, A3, d_l0, d_h0, d_l1, d_h1, d_l2, d_h2, d_l3, d_h3); } while (0)
#define RO_QSC(DST, SRC, F) do { const u32x4 w_ = *reinterpret_cast<const u32x4*>(&(SRC)); u32x4 x_; x_.x = cvtpk(bflo(w_.x) * (F), bfhi(w_.x) * (F)); x_.y = cvtpk(bflo(w_.y) * (F), bfhi(w_.y) * (F)); \
            x_.z = cvtpk(bflo(w_.z) * (F), bfhi(w_.z) * (F)); x_.w = cvtpk(bflo(w_.w) * (F), bfhi(w_.w) * (F)); DST = *reinterpret_cast<bf16x8*>(&x_); } while (0)
#define RO_STATE(SLOT, DT, F) do { bf16x8 q0_, q1_, q2_, q3_; RO_QSC(q0_, qr[4 * (DT)], F); RO_QSC(q1_, qr[4 * (DT) + 1], F); RO_QSC(q2_, qr[4 * (DT) + 2], F); RO_QSC(q3_, qr[4 * (DT) + 3], F); RO_MUL(o, SLOT, q0_, q1_, q2_, q3_); } while (0)
        RO_OPEN(0); RO_SCORES(0, 0);
        RO_OPEN(1); RO_MUL(o, 1, pa0, pa1, pa2, pa3);
        RO_OPEN(2); RO_SCORES(2, 1);
        RO_OPEN(3); RO_MUL(o, 3, pa0, pa1, pa2, pa3);
        { const float ff = __builtin_amdgcn_exp2f(lgf2 * (float)(opaque(ii) + 1));
          RO_OPEN(4); RO_STATE(0, 0, ff);
          RO_OPEN(5); RO_STATE(1, 1, ff);
          RO_OPEN(6); RO_STATE(2, 2, ff);
          RO_OPEN(7); RO_STATE(3, 3, ff); }
        { const float fb = __builtin_amdgcn_exp2f(lgb2 * (float)(128 - opaque(ii)));
          RO_OPEN(8); RO_STATE(0, 0, fb);
          RO_OPEN(9); RO_STATE(1, 1, fb);
          RO_OPEN(10); RO_STATE(2, 2, fb);
          RO_OPEN(11); RO_STATE(3, 3, fb); }
        { const int hio = opaque(hi), r32o = opaque(r32);
#pragma unroll
          for (int r = 0; r < 16; ++r) { float ss = 0.f;
#pragma unroll
              for (int d = 0; d < 4; ++d) ss += o[d][r] * o[d][r];
              ss = half_sum(ss);
              if (r32 == 0) ssl[(rb * 2 + dh) * 32 + crow(r, hio)] = ss; }
          LDS_WAIT(); BARF();
#pragma unroll
          for (int r = 0; r < 16; ++r) { const int rw = crow(r, hio); const float tot = ssl[(rb * 2) * 32 + rw] + ssl[(rb * 2 + 1) * 32 + rw]; const float rs = 1.0f / sqrtf(tot * (1.f / 256.f) + EPS);
              const size_t gi = hb + (size_t)(32 * rb + rw) * 256 + 128 * dh + r32o, go = (size_t)(r0 + 32 * rb + rw) * D + cu.h * 256 + 128 * dh + r32o;
#pragma unroll
              for (int d = 0; d < 4; ++d) { const float g = __uint_as_float((unsigned)Gg[gi + d * 32] << 16); Og[go + d * 32] = (bf16)f2bf(o[d][r] * rs * g); } }
          asm volatile("s_waitcnt vmcnt(0) lgkmcnt(0)" ::: "memory"); BARF(); }
        cu = nu;
    }
#undef RO_ISSUE
#undef RO_OPEN
#undef RO_QKCHAIN
#undef RO_SCORES
#undef RO_BRD
#undef RO_BMM
#undef RO_MUL
#undef RO_QSC
#undef RO_STATE
}

#ifndef MK_N_LAUNCHES
#define MK_N_LAUNCHES 1
#endif
#ifndef WGM_P1
#define WGM_P1 4
#endif
#ifndef WGM_SQ
#define WGM_SQ 4
#endif
#ifndef WGM_P9
#define WGM_P9 4
#endif
#ifndef WGM_P10
#define WGM_P10 4
#endif
constexpr int NPH = 12;
struct Args { const float* in[15]; float* out; unsigned char* ws; int ph_lo, ph_hi, flags, pad; };
__global__ void __launch_bounds__(NWAVES * 64, 2) fwd(Args args) {
    extern __shared__ __attribute__((aligned(16))) unsigned char lds_raw[];
    Frame F;
    F.lds = (lchar*)lds_raw; F.MISC = (volatile LAS unsigned*)(F.lds + MISC_OFF);
    F.tid = threadIdx.x; F.lane = F.tid & 63; F.wave = __builtin_amdgcn_readfirstlane(F.tid >> 6);
    F.G = gridDim.x; { const int bx = blockIdx.x; F.vcu = (F.G % 8 == 0) ? (bx % 8) * (F.G / 8) + bx / 8 : bx; }
    F.ws = args.ws; F.ctl = (unsigned*)(args.ws + WS_CTL); F.out = args.out;
#pragma unroll
    for (int i = 0; i < 15; ++i) F.in[i] = args.in[i];
    if (F.tid < 64) ((LAS unsigned*)(F.lds + MISC_OFF))[F.tid] = 0u;
    __syncthreads();
    const int lo = args.ph_lo, hi = args.ph_hi;
    XcdBarrier bar; bar.bar = F.ctl + CW_BAR; bar.x = 0; bar.st = nullptr;
    if (hi - lo > 1) bar = xcd_barrier_post(F.ctl + CW_BAR, F.MISC + 8);
#ifndef PH_MASK
#define PH_MASK 0xFFF
#endif
#define IN(k) (((PH_MASK >> (k)) & 1) && lo <= (k) && (k) < hi)
#define SEAM(k) do { if (IN(k) && IN((k) + 1)) xcd_barrier(bar); } while (0)
    bf16* WIN = (bf16*)(F.ws + WS_WIN); bf16* WBR = (bf16*)(F.ws + WS_WBR); bf16* WBD = (bf16*)(F.ws + WS_WBD); bf16* WO = (bf16*)(F.ws + WS_WO); bf16* WGU = (bf16*)(F.ws + WS_WGU); bf16* WDN = (bf16*)(F.ws + WS_WDN);
    bf16* U = (bf16*)(F.ws + WS_U); bf16* PROJ = (bf16*)(F.ws + WS_PROJ); bf16* ST = (bf16*)(F.ws + WS_ST);
    bf16* MIXED = (bf16*)(F.ws + WS_MIXED); bf16* U2 = (bf16*)(F.ws + WS_U2); bf16* ACT = (bf16*)(F.ws + WS_ACT);
    bf16* G_RQ = PROJ, *G_RK = PROJ + GS, *G_RV = PROJ + 2 * GS, *G_RG = PROJ + 3 * GS, *G_DQ = PROJ + 4 * GS, *G_DK = PROJ + 5 * GS, *G_DV = PROJ + 6 * GS, *G_GA = PROJ + 7 * GS, *G_GB = PROJ + 8 * GS;

    if (IN(0)) { p0_prologue(F); __syncthreads(); }
    SEAM(0);
    if (IN(1)) { pg8::Gemm g{U, WIN, NX, DIN, D}; pg8::StaticOrder S; S.init(NX, DIN, F.G, (int)blockIdx.x, WGM_P1);
        pg8::EpiProj E{PROJ, GS};
        pg8::gemm_phase<pg8::EpiProj, pg8::StaticOrder, true, true>((PG8_LAS unsigned char*)F.lds, g, S, E);
        __syncthreads();
        meta_proj(F.lds, U, WIN, PROJ, F.vcu, F.G); }
    SEAM(1);
    if (IN(2)) {
        normmax_phase(F, G_DQ, G_DK, F.ctl + CW_NRM);
        for (int id = F.vcu; id < 2048; id += F.G) { const int bh = id >> 6, c = id & 63, h = bh & 15;
            const float lgf2 = -expf(F.in[4][h]) * LOG2E, lgb2 = -expf(F.in[4][NH + h]) * LOG2E;
            ret_local_unit(F.lds, G_RK, G_RV, ST, bh >> 4, h, c, lgf2, lgb2); }
    }
    SEAM(2);
    if (IN(3)) ret_scan(F, G_RK, G_RV, ST, F.in[4]);
    SEAM(3);
    if (IN(4)) {
        float lam; { const float* lp = F.in[5]; const float a = wave_sum(lp[F.lane] * lp[128 + F.lane] + lp[64 + F.lane] * lp[192 + F.lane]), c = wave_sum(lp[256 + F.lane] * lp[384 + F.lane] + lp[320 + F.lane] * lp[448 + F.lane]);
            lam = expf(a) - expf(c) + 0.2f; }
        float* stash = F.out + (size_t)blockIdx.x * 65536;
        for (int id = F.vcu; id < 1024; id += F.G) { const int bh = id >> 5, b = bh >> 4, hh = bh & 15, px = hh & 7, xp = (b == 0) ? px : (int)((0x32017645u >> (4 * px)) & 7u), h = (hh < 8) ? xp : 15 - xp, qb = ((id & 31) + 16 * b) & 31;
            attn_unit(F.lds, G_DQ, G_DK, G_DV, G_DQ, stash, F.in[6], F.ctl + CW_NRM, b, h, qb, lam); }
    }
    SEAM(4);
    if (IN(5)) ret_out_phase(F.lds, G_RQ, G_RK, G_RV, G_RG, ST, (bf16*)(F.ws + WS_YR), F.in[4], F.vcu, F.G);
    SEAM(5);
    if (IN(6)) { pg8::Gemm g{(const bf16*)(F.ws + WS_YR), WBR, NX, D, D}, g2{G_DQ, WBD, NX, D, D}; pg8::StaticOrder S; S.init(NX, D, F.G, (int)blockIdx.x, WGM_SQ); pg8::EpiMix2 E{G_GA, G_GB, MIXED};
        pg8::gemm_phase2<pg8::EpiMix2, pg8::StaticOrder, true, true>((PG8_LAS unsigned char*)F.lds, g, g2, S, E); }
    SEAM(6);
    if (IN(7)) { pg8::Gemm g{MIXED, WO, NX, D, D}; pg8::StaticOrder S; S.init(NX, D, F.G, (int)blockIdx.x, WGM_SQ); pg8::EpiResBf E{F.in[0], U2, (float*)(F.ws + WS_PS)};
        pg8::gemm_phase<pg8::EpiResBf, pg8::StaticOrder, true, true>((PG8_LAS unsigned char*)F.lds, g, S, E); }
    SEAM(7);
    if (IN(8)) { const float* PS = (const float*)(F.ws + WS_PS); float* RS = (float*)(F.ws + WS_RSTD);
        for (int row = F.vcu * 512 + mx::opaque((int)threadIdx.x); row < NX; row += F.G * 512) { const pg8::f32x4* p = (const pg8::f32x4*)(PS + (size_t)row * 64); float s = 0.f;
#pragma unroll
            for (int j = 0; j < 16; ++j) { const pg8::f32x4 v = p[j]; s += (v[0] + v[1]) + (v[2] + v[3]); }
            RS[row] = 1.0f / sqrtf(s * (1.f / D) + EPS); } }
    SEAM(8);
    if (IN(9)) { pg8::Gemm g{U2, WGU, NX, 2 * DFF, D}; pg8::StaticOrder S; S.init(NX, 2 * DFF, F.G, (int)blockIdx.x, WGM_P9); pg8::EpiSwiGLUr E{ACT, DFF, (const float*)(F.ws + WS_RSTD)};
        pg8::gemm_phase<pg8::EpiSwiGLUr, pg8::StaticOrder, true, true>((PG8_LAS unsigned char*)F.lds, g, S, E); }
    SEAM(9);
    if (IN(10)) { pg8::Gemm g{ACT, WDN, NX, D, DFF}; pg8::StaticOrder S; S.init(NX, D, F.G, (int)blockIdx.x, WGM_P10); pg8::EpiResBf2 E{U2, (bf16*)(F.ws + WS_H2)};
        pg8::gemm_phase<pg8::EpiResBf2, pg8::StaticOrder, true, true>((PG8_LAS unsigned char*)F.lds, g, S, E); }
    SEAM(10);
    if (IN(11)) { const int gw = F.vcu * NWAVES + F.wave, NGW = F.G * NWAVES; const bf16* H2 = (const bf16*)(F.ws + WS_H2);
        for (int m = gw; m < NX; m += NGW) rms_row_bf(H2 + (size_t)m * D, F.in[14], F.out + (size_t)m * D, F.lane); }
#undef IN
#undef SEAM
}

extern "C" void kernel_launch(void* const* d_in, const int* in_sizes, int n_in, void* d_out, int out_size, void* d_ws, size_t ws_size, hipStream_t stream) {
    static int grid = 0;
    if (grid == 0) {
        if (n_in != 15 || in_sizes[0] != NX * D || out_size != NX * D || ws_size < WS_END) { fprintf(stderr, "kernel_launch: unexpected shapes (n_in %d, in0 %d, out %d, ws %zu)\n", n_in, n_in > 0 ? in_sizes[0] : -1, out_size, ws_size); grid = -1; return; }
        int dev = 0, cus = 0, per_cu = 0;
        if (hipGetDevice(&dev) != hipSuccess || hipDeviceGetAttribute(&cus, hipDeviceAttributeMultiprocessorCount, dev) != hipSuccess) { grid = -1; return; }
        if (hipFuncSetAttribute((const void*)fwd, hipFuncAttributeMaxDynamicSharedMemorySize, LDS_BYTES) != hipSuccess) { fprintf(stderr, "kernel_launch: hipFuncSetAttribute failed\n"); grid = -1; return; }
        if (hipOccupancyMaxActiveBlocksPerMultiprocessor(&per_cu, (const void*)fwd, NWAVES * 64, LDS_BYTES) != hipSuccess || per_cu < 1) fprintf(stderr, "kernel_launch: occupancy query reports %d\n", per_cu);
        (void)hipGetLastError();
        grid = cus;
    }
    if (grid < 0) return;
    if (hipMemsetAsync((char*)d_ws + WS_CTL, 0, CTL_ZERO_BYTES, stream) != hipSuccess) return;
    Args a{};
    for (int i = 0; i < 15; ++i) a.in[i] = (const float*)d_in[i];
    a.out = (float*)d_out; a.ws = (unsigned char*)d_ws;
#if MK_N_LAUNCHES == 1
    a.ph_lo = 0; a.ph_hi = NPH;
    hipLaunchKernelGGL(fwd, dim3(grid), dim3(NWAVES * 64), LDS_BYTES, stream, a);
#else
    for (int p = 0; p < NPH; ++p) { a.ph_lo = p; a.ph_hi = p + 1;
        hipLaunchKernelGGL(fwd, dim3(grid), dim3(NWAVES * 64), LDS_BYTES, stream, a); }
#endif
    const hipError_t le = hipPeekAtLastError();
    if (le != hipSuccess) fprintf(stderr, "kernel_launch: launch failed: %s\n", hipGetErrorName(le));
}
```

```cpp
#include <hip/hip_runtime.h>
#include <cstdio>
#include <cstdint>
#define LAS __attribute__((address_space(3)))
namespace pg8 {
#define PG8_LAS __attribute__((address_space(3)))
typedef unsigned short bf16_t;
typedef short bf16x8 __attribute__((ext_vector_type(8)));
typedef float f32x4 __attribute__((ext_vector_type(4)));
typedef unsigned u32x4 __attribute__((ext_vector_type(4)));
constexpr int BM = 256, BK = 64, HALF = 128, HTB = HALF * BK * 2  , STAGE_BYTES = 8 * HTB, NXCD = 8, WGM = 8;

__host__ __device__ __forceinline__ int lds_byte(int r, int c) { const int st = (r >> 4) * 2 + (c >> 5), rr = r & 15, cc = c & 31, ob = rr * 64 + cc * 2; return st * 1024 + (ob ^ (((ob >> 9) & 1) << 5)); }
__host__ __device__ __forceinline__ void stage_rc(int b, int& R, int& C) { const int st = b / 1024, sb = b % 1024, swz = sb ^ (((sb >> 9) & 1) << 5); R = (st >> 1) * 16 + swz / 64; C = (st & 1) * 32 + (swz % 64) / 2; }
__host__ __device__ __forceinline__ int perm32(int rho) { const int n = rho >> 4, i = rho & 15; return 8 * (i >> 2) + 4 * n + (i & 3); }

struct Unit { int pm, pn; };
struct Gemm { const bf16_t* A; const bf16_t* Bt; int M, N, K; };

struct StaticOrder {
    int nM, nN, nwg, G, c, wgm = WGM;
    __host__ __device__ void init(int M, int N, int G_, int c_, int wgm_ = WGM) { nM = M / BM; nN = N / BM; nwg = nM * nN; G = G_; c = c_; wgm = wgm_; }
    __host__ __device__ bool next(int i, Unit& u) const {
        const long L = (long)i * G + c; if (L >= nwg) return false;
        int wgid = (int)L; { const int q = nwg / NXCD, r = nwg % NXCD, xcd = wgid % NXCD, off = wgid / NXCD; wgid = (xcd < r ? xcd * (q + 1) : r * (q + 1) + (xcd - r) * q) + off; }
        const int nig = wgm * nN, gid = wgid / nig, fm = gid * wgm, gsz = (nM - fm) < wgm ? (nM - fm) : wgm;
        u.pm = fm + ((wgid % nig) % gsz); u.pn = (wgid % nig) / gsz; return true;
    }
    __device__ __forceinline__ void a_ready(const Unit&) const {}
    __device__ __forceinline__ void done(const Unit&) const {}
};

__device__ __forceinline__ unsigned cvt_pk_bf16(float lo, float hi) { unsigned r; asm volatile("v_cvt_pk_bf16_f32 %0, %1, %2" : "=v"(r) : "v"(lo), "v"(hi)); return r; }
typedef float f32x2 __attribute__((ext_vector_type(2)));
__device__ __forceinline__ float sigmoid_f(float x) { return __builtin_amdgcn_rcpf(1.0f + __builtin_amdgcn_exp2f(-1.4426950408889634f * x)); }
__device__ __forceinline__ float silu_f(float x) { return x * sigmoid_f(x); }
__device__ __forceinline__ float bf_lo(unsigned w) { return __uint_as_float(w << 16); }
__device__ __forceinline__ float bf_hi(unsigned w) { return __uint_as_float(w & 0xffff0000u); }

struct EpiProj {
    static constexpr bool PERM = true, AFTER_DRAIN = false;
    bf16_t* P; size_t gstride;
    __device__ __forceinline__ void operator()(const f32x4 (&acc)[2][2][4][2], const Unit& u, int wr, int wc, int fr, int fq) const {
        const int t = (u.pn * BM) >> 12, colt = (u.pn * BM) & 4095;
        bf16_t* base = P + (size_t)t * gstride;
        const int mode = (t == 1) ? 1 : (t == 3) ? 2 : (t >= 7) ? 3 : 0;
        const bool hm = t < 4; const int pitch = hm ? 256 : 4096;
        const size_t org = hm ? ((size_t)(((u.pm >> 5) * 16 + (colt >> 8)) * 8192 + (u.pm & 31) * 256) * 256) : ((size_t)(u.pm * BM) * 4096 + colt);
        const int rloc = wr * 64 + fr, col0 = wc * 32 + 8 * fq;
#pragma unroll
        for (int ai = 0; ai < 2; ++ai)
#pragma unroll
            for (int m = 0; m < 4; ++m) { bf16_t* rowp = base + org + (size_t)(rloc + ai * HALF + m * 16) * pitch + col0;
#pragma unroll
                for (int bj = 0; bj < 2; ++bj) { f32x4 v0 = acc[ai][bj][m][0], v1 = acc[ai][bj][m][1];
                    if (mode == 1) { v0 = v0 * 0.0625f; v1 = v1 * 0.0625f; }
                    else if (mode == 2) {
#pragma unroll
                        for (int j = 0; j < 4; ++j) { v0[j] = silu_f(v0[j]); v1[j] = silu_f(v1[j]); } }
                    else if (mode == 3) {
#pragma unroll
                        for (int j = 0; j < 4; ++j) { v0[j] = sigmoid_f(v0[j]); v1[j] = sigmoid_f(v1[j]); } }
                    u32x4 w; w.x = cvt_pk_bf16(v0[0], v0[1]); w.y = cvt_pk_bf16(v0[2], v0[3]); w.z = cvt_pk_bf16(v1[0], v1[1]); w.w = cvt_pk_bf16(v1[2], v1[3]);
                    *(u32x4*)(rowp + bj * HALF) = w; } }
    }
};
struct EpiGateT {
    static constexpr bool PERM = true, AFTER_DRAIN = false;
    const bf16_t* G; float* T;
    __device__ __forceinline__ void operator()(const f32x4 (&acc)[2][2][4][2], const Unit& u, int wr, int wc, int fr, int fq) const {
        const int row0 = u.pm * BM + wr * 64 + fr, col0 = u.pn * BM + wc * 32 + 8 * fq;
#pragma unroll
        for (int ai = 0; ai < 2; ++ai)
#pragma unroll
            for (int m = 0; m < 4; ++m) { const size_t off = (size_t)(row0 + ai * HALF + m * 16) * 4096 + col0;
#pragma unroll
                for (int bj = 0; bj < 2; ++bj) { const u32x4 g = *(const u32x4*)(G + off + bj * HALF);
                    const f32x4 g0 = {bf_lo(g.x), bf_hi(g.x), bf_lo(g.y), bf_hi(g.y)}, g1 = {bf_lo(g.z), bf_hi(g.z), bf_lo(g.w), bf_hi(g.w)};
                    *(f32x4*)(T + off + bj * HALF) = acc[ai][bj][m][0] * g0; *(f32x4*)(T + off + bj * HALF + 4) = acc[ai][bj][m][1] * g1; } }
    }
};
struct EpiMix {
    static constexpr bool PERM = true, AFTER_DRAIN = false;
    const bf16_t* G; const float* T; bf16_t* O;
    __device__ __forceinline__ void operator()(const f32x4 (&acc)[2][2][4][2], const Unit& u, int wr, int wc, int fr, int fq) const {
        const int row0 = u.pm * BM + wr * 64 + fr, col0 = u.pn * BM + wc * 32 + 8 * fq;
#pragma unroll
        for (int ai = 0; ai < 2; ++ai)
#pragma unroll
            for (int m = 0; m < 4; ++m) { const size_t off = (size_t)(row0 + ai * HALF + m * 16) * 4096 + col0;
#pragma unroll
                for (int bj = 0; bj < 2; ++bj) { const u32x4 g = *(const u32x4*)(G + off + bj * HALF);
                    const f32x4 g0 = {bf_lo(g.x), bf_hi(g.x), bf_lo(g.y), bf_hi(g.y)}, g1 = {bf_lo(g.z), bf_hi(g.z), bf_lo(g.w), bf_hi(g.w)};
                    const f32x4 t0 = *(const f32x4*)(T + off + bj * HALF), t1 = *(const f32x4*)(T + off + bj * HALF + 4);
                    const f32x4 v0 = t0 + acc[ai][bj][m][0] * g0, v1 = t1 + acc[ai][bj][m][1] * g1;
                    u32x4 w; w.x = cvt_pk_bf16(v0[0], v0[1]); w.y = cvt_pk_bf16(v0[2], v0[3]); w.z = cvt_pk_bf16(v1[0], v1[1]); w.w = cvt_pk_bf16(v1[2], v1[3]);
                    *(u32x4*)(O + off + bj * HALF) = w; } }
    }
};
struct EpiRes {
    static constexpr bool PERM = false, AFTER_DRAIN = false;
    const float* R; float* C; int ldc;
    __device__ __forceinline__ void operator()(const f32x4 (&acc)[2][2][4][2], const Unit& u, int wr, int wc, int fr, int fq) const {
        const int row0 = u.pm * BM + wr * 64 + fr, col0 = u.pn * BM + wc * 32 + 4 * fq;
#pragma unroll
        for (int ai = 0; ai < 2; ++ai)
#pragma unroll
            for (int m = 0; m < 4; ++m) { const size_t off = (size_t)(row0 + ai * HALF + m * 16) * ldc + col0;
#pragma unroll
                for (int bj = 0; bj < 2; ++bj)
#pragma unroll
                    for (int n = 0; n < 2; ++n) { const f32x4 r = *(const f32x4*)(R + off + bj * HALF + n * 16); *(f32x4*)(C + off + bj * HALF + n * 16) = r + acc[ai][bj][m][n]; } }
    }
};
struct EpiSwiGLU {
    static constexpr bool PERM = true, AFTER_DRAIN = false;
    bf16_t* O; int ldc;
    __device__ __forceinline__ void operator()(const f32x4 (&acc)[2][2][4][2], const Unit& u, int wr, int wc, int fr, int fq) const {
        const int row0 = u.pm * BM + wr * 64 + fr, col0 = u.pn * HALF + wc * 32 + 8 * fq;
#pragma unroll
        for (int ai = 0; ai < 2; ++ai)
#pragma unroll
            for (int m = 0; m < 4; ++m) { bf16_t* rowp = O + (size_t)(row0 + ai * HALF + m * 16) * ldc + col0;
                f32x4 v0, v1;
#pragma unroll
                for (int j = 0; j < 4; ++j) { v0[j] = silu_f(acc[ai][0][m][0][j]) * acc[ai][1][m][0][j]; v1[j] = silu_f(acc[ai][0][m][1][j]) * acc[ai][1][m][1][j]; }
                u32x4 w; w.x = cvt_pk_bf16(v0[0], v0[1]); w.y = cvt_pk_bf16(v0[2], v0[3]); w.z = cvt_pk_bf16(v1[0], v1[1]); w.w = cvt_pk_bf16(v1[2], v1[3]);
                *(u32x4*)rowp = w; }
    }
};

#define GBC(x) fmaxf((x), 7.888609e-31f)
#define GBR(x) __builtin_amdgcn_rcpf(GBC(x))
struct EpiMix2 {
    static constexpr bool PERM = true, AFTER_DRAIN = false;
    const bf16_t* GA; const bf16_t* GB; bf16_t* O;
    __device__ __forceinline__ void mid(f32x4 (&acc)[2][2][4][2], const Unit& u, int wr, int wc, int fr, int fq) const {
        const int row0 = u.pm * BM + wr * 64 + fr, col0 = u.pn * BM + wc * 32 + 8 * fq;
#pragma unroll
        for (int ai = 0; ai < 2; ++ai)
#pragma unroll
            for (int m = 0; m < 4; ++m) { const size_t off = (size_t)(row0 + ai * HALF + m * 16) * 4096 + col0;
#pragma unroll
                for (int bj = 0; bj < 2; ++bj) { const u32x4 a = *(const u32x4*)(GA + off + bj * HALF), b = *(const u32x4*)(GB + off + bj * HALF);
                    const f32x4 r0 = {bf_lo(a.x) * GBR(bf_lo(b.x)), bf_hi(a.x) * GBR(bf_hi(b.x)), bf_lo(a.y) * GBR(bf_lo(b.y)), bf_hi(a.y) * GBR(bf_hi(b.y))};
                    const f32x4 r1 = {bf_lo(a.z) * GBR(bf_lo(b.z)), bf_hi(a.z) * GBR(bf_hi(b.z)), bf_lo(a.w) * GBR(bf_lo(b.w)), bf_hi(a.w) * GBR(bf_hi(b.w))};
                    acc[ai][bj][m][0] = acc[ai][bj][m][0] * r0; acc[ai][bj][m][1] = acc[ai][bj][m][1] * r1; } }
    }
    __device__ __forceinline__ void operator()(const f32x4 (&acc)[2][2][4][2], const Unit& u, int wr, int wc, int fr, int fq) const {
        const int row0 = u.pm * BM + wr * 64 + fr, col0 = u.pn * BM + wc * 32 + 8 * fq;
#pragma unroll
        for (int ai = 0; ai < 2; ++ai)
#pragma unroll
            for (int m = 0; m < 4; ++m) { const size_t off = (size_t)(row0 + ai * HALF + m * 16) * 4096 + col0;
#pragma unroll
                for (int bj = 0; bj < 2; ++bj) { const u32x4 g = *(const u32x4*)(GB + off + bj * HALF);
                    const f32x4 g0 = {GBC(bf_lo(g.x)), GBC(bf_hi(g.x)), GBC(bf_lo(g.y)), GBC(bf_hi(g.y))}, g1 = {GBC(bf_lo(g.z)), GBC(bf_hi(g.z)), GBC(bf_lo(g.w)), GBC(bf_hi(g.w))};
                    const f32x4 v0 = acc[ai][bj][m][0] * g0, v1 = acc[ai][bj][m][1] * g1;
                    u32x4 w; w.x = cvt_pk_bf16(v0[0], v0[1]); w.y = cvt_pk_bf16(v0[2], v0[3]); w.z = cvt_pk_bf16(v1[0], v1[1]); w.w = cvt_pk_bf16(v1[2], v1[3]);
                    *(u32x4*)(O + off + bj * HALF) = w; } }
    }
};
#undef GBC
#undef GBR

struct EpiResBf {
    static constexpr bool PERM = true, AFTER_DRAIN = false;
    const float* X; bf16_t* O; float* PS;
    __device__ __forceinline__ void operator()(const f32x4 (&acc)[2][2][4][2], const Unit& u, int wr, int wc, int fr, int fq) const {
        const int row0 = u.pm * BM + wr * 64 + fr, col0 = u.pn * BM + wc * 32 + 8 * fq;
#pragma unroll
        for (int ai = 0; ai < 2; ++ai)
#pragma unroll
            for (int m = 0; m < 4; ++m) { const int row = row0 + ai * HALF + m * 16; const size_t off = (size_t)row * 4096 + col0; float ss = 0.f;
#pragma unroll
                for (int bj = 0; bj < 2; ++bj) { const f32x4 x0 = *(const f32x4*)(X + off + bj * HALF), x1 = *(const f32x4*)(X + off + bj * HALF + 4);
                    const f32x4 v0 = x0 + acc[ai][bj][m][0], v1 = x1 + acc[ai][bj][m][1];
                    ss += (v0[0] * v0[0] + v0[1] * v0[1]) + (v0[2] * v0[2] + v0[3] * v0[3]) + (v1[0] * v1[0] + v1[1] * v1[1]) + (v1[2] * v1[2] + v1[3] * v1[3]);
                    u32x4 w; w.x = cvt_pk_bf16(v0[0], v0[1]); w.y = cvt_pk_bf16(v0[2], v0[3]); w.z = cvt_pk_bf16(v1[0], v1[1]); w.w = cvt_pk_bf16(v1[2], v1[3]);
                    *(u32x4*)(O + off + bj * HALF) = w; }
                ss += __shfl_xor(ss, 16); ss += __shfl_xor(ss, 32);
                if (fq == 0) PS[(size_t)row * 64 + u.pn * 4 + wc] = ss; }
    }
};
struct EpiSwiGLUr {
    static constexpr bool PERM = true, AFTER_DRAIN = false;
    bf16_t* O; int ldc; const float* RSTD;
    __device__ __forceinline__ void operator()(const f32x4 (&acc)[2][2][4][2], const Unit& u, int wr, int wc, int fr, int fq) const {
        const int row0 = u.pm * BM + wr * 64 + fr, col0 = u.pn * HALF + wc * 32 + 8 * fq;
#pragma unroll
        for (int ai = 0; ai < 2; ++ai)
#pragma unroll
            for (int m = 0; m < 4; ++m) { const int row = row0 + ai * HALF + m * 16; bf16_t* rowp = O + (size_t)row * ldc + col0; const float r = RSTD[row];
                f32x4 v0, v1;
#pragma unroll
                for (int j = 0; j < 4; ++j) { v0[j] = silu_f(acc[ai][0][m][0][j] * r) * (acc[ai][1][m][0][j] * r); v1[j] = silu_f(acc[ai][0][m][1][j] * r) * (acc[ai][1][m][1][j] * r); }
                u32x4 w; w.x = cvt_pk_bf16(v0[0], v0[1]); w.y = cvt_pk_bf16(v0[2], v0[3]); w.z = cvt_pk_bf16(v1[0], v1[1]); w.w = cvt_pk_bf16(v1[2], v1[3]);
                *(u32x4*)rowp = w; }
    }
};
struct EpiResBf2 {
    static constexpr bool PERM = true, AFTER_DRAIN = false;
    const bf16_t* R; bf16_t* O;
    __device__ __forceinline__ void operator()(const f32x4 (&acc)[2][2][4][2], const Unit& u, int wr, int wc, int fr, int fq) const {
        const int row0 = u.pm * BM + wr * 64 + fr, col0 = u.pn * BM + wc * 32 + 8 * fq;
#pragma unroll
        for (int ai = 0; ai < 2; ++ai)
#pragma unroll
            for (int m = 0; m < 4; ++m) { const size_t off = (size_t)(row0 + ai * HALF + m * 16) * 4096 + col0;
#pragma unroll
                for (int bj = 0; bj < 2; ++bj) { const u32x4 r = *(const u32x4*)(R + off + bj * HALF);
                    const f32x4 v0 = acc[ai][bj][m][0] + (f32x4){bf_lo(r.x), bf_hi(r.x), bf_lo(r.y), bf_hi(r.y)}, v1 = acc[ai][bj][m][1] + (f32x4){bf_lo(r.z), bf_hi(r.z), bf_lo(r.w), bf_hi(r.w)};
                    u32x4 w; w.x = cvt_pk_bf16(v0[0], v0[1]); w.y = cvt_pk_bf16(v0[2], v0[3]); w.z = cvt_pk_bf16(v1[0], v1[1]); w.w = cvt_pk_bf16(v1[2], v1[3]);
                    *(u32x4*)(O + off + bj * HALF) = w; } }
    }
};
template <class Epi, class Sched, bool ALIGN_EPI = false, bool SP2 = false>
__device__ __forceinline__ void gemm_phase(PG8_LAS unsigned char* lds, const Gemm g, const Sched& S, const Epi& E) {
    const int tid = threadIdx.x, wid = __builtin_amdgcn_readfirstlane(tid >> 6), lane = tid & 63, wr = wid >> 2, wc = wid & 3, fr = lane & 15, fq = lane >> 4;
    const int K = g.K, nt = K / BK;
    unsigned voffA[2], voffB[2];
#pragma unroll
    for (int i = 0; i < 2; ++i) { int R, C; stage_rc(tid * 16 + i * 8192, R, C); const int Rb = Epi::PERM ? ((R & ~31) + perm32(R & 31)) : R;
        voffA[i] = (unsigned)(R * K + C) * 2u; voffB[i] = (unsigned)(Rb * K + C) * 2u; }
    const size_t kstep = (size_t)(BK * 2);
    const size_t hstep = (size_t)HALF * K * 2;
    const size_t tstep = 2 * hstep;
    const unsigned ldsw = (unsigned)wid * 1024u;
    const int aoff = lds_byte(wr * 64 + fr, fq * 8), boff = lds_byte(wc * 32 + fr, fq * 8);
#define PG8_SA(b, h) (((b) * 2 + (h)) * HTB)
#define PG8_SB(b, h) ((4 + (b) * 2 + (h)) * HTB)
#define PG8_STAGE(bufoff, gbase, voff) do { _Pragma("unroll") for (int _i = 0; _i < 2; ++_i) \
        __builtin_amdgcn_global_load_lds((const unsigned*)((const char*)(gbase) + (voff)[_i]), (PG8_LAS unsigned*)(lds + (bufoff) + ldsw + _i * 8192), 16, 0, 0); } while (0)
#define PG8_LDA(dst, b, h) do { _Pragma("unroll") for (int m = 0; m < 4; ++m) _Pragma("unroll") for (int k = 0; k < 2; ++k) dst[m][k] = *(const PG8_LAS bf16x8*)(lds + PG8_SA(b, h) + aoff + m * 2048 + k * 1024); } while (0)
#define PG8_LDB(dst, b, h) do { _Pragma("unroll") for (int n = 0; n < 2; ++n) _Pragma("unroll") for (int k = 0; k < 2; ++k) dst[n][k] = *(const PG8_LAS bf16x8*)(lds + PG8_SB(b, h) + boff + n * 2048 + k * 1024); } while (0)
#define PG8_MMA(ai, bj, At, Bt) do { __builtin_amdgcn_s_setprio(1); _Pragma("unroll") for (int m = 0; m < 4; ++m) _Pragma("unroll") for (int n = 0; n < 2; ++n) _Pragma("unroll") for (int k = 0; k < 2; ++k) \
        acc[ai][bj][m][n] = __builtin_amdgcn_mfma_f32_16x16x32_bf16(Bt[n][k], At[m][k], acc[ai][bj][m][n], 0, 0, 0); __builtin_amdgcn_s_setprio(0); } while (0)
#define PG8_WAIT_V(n) asm volatile("s_waitcnt vmcnt(" #n ")" ::: "memory")
#define PG8_WAIT_L(n) asm volatile("s_waitcnt lgkmcnt(" #n ")" ::: "memory")
#define PG8_BAR __builtin_amdgcn_s_barrier()
#define PG8_SCHED __builtin_amdgcn_sched_barrier(0)
    Unit cur, nxt; int ui = 0;
    if (!S.next(0, cur)) return;
    f32x4 acc[2][2][4][2];
#pragma unroll
    for (int a = 0; a < 2; ++a)
#pragma unroll
        for (int b = 0; b < 2; ++b)
#pragma unroll
            for (int m = 0; m < 4; ++m)
#pragma unroll
                for (int n = 0; n < 2; ++n) acc[a][b][m][n] = (f32x4){0.f, 0.f, 0.f, 0.f};
    bf16x8 At[4][2], B0[2][2], B1[2][2];
    const char* cA = (const char*)g.A + (size_t)cur.pm * tstep; const char* cB = (const char*)g.Bt + (size_t)cur.pn * tstep;
    S.a_ready(cur);
    if constexpr (SP2) {
        PG8_STAGE(PG8_SB(0, 0), cB, voffB); PG8_STAGE(PG8_SB(0, 1), cB + hstep, voffB); PG8_STAGE(PG8_SA(0, 0), cA, voffA); PG8_STAGE(PG8_SA(0, 1), cA + hstep, voffA);
        if (wr == 1) PG8_BAR;
        PG8_WAIT_V(2); PG8_BAR;
        PG8_STAGE(PG8_SB(1, 0), cB + kstep, voffB); PG8_STAGE(PG8_SA(1, 0), cA + kstep, voffA); PG8_STAGE(PG8_SB(1, 1), cB + hstep + kstep, voffB);
        PG8_WAIT_V(6); PG8_BAR;
    } else {
        PG8_STAGE(PG8_SB(0, 0), cB, voffB); PG8_STAGE(PG8_SA(0, 0), cA, voffA); PG8_STAGE(PG8_SB(0, 1), cB + hstep, voffB); PG8_STAGE(PG8_SA(0, 1), cA + hstep, voffA);
        if (wr == 1) PG8_BAR;
        PG8_WAIT_V(4); PG8_BAR;
        PG8_STAGE(PG8_SB(1, 0), cB + kstep, voffB); PG8_STAGE(PG8_SA(1, 0), cA + kstep, voffA); PG8_STAGE(PG8_SB(1, 1), cB + hstep + kstep, voffB);
        PG8_WAIT_V(6); PG8_BAR;
    }
    for (;;) {
        const bool has_next = S.next(ui + 1, nxt);
        const char* nA = has_next ? (const char*)g.A + (size_t)nxt.pm * tstep : cA; const char* nB = has_next ? (const char*)g.Bt + (size_t)nxt.pn * tstep : cB;
        for (int t = 0; t < nt; t += 2) {
            const bool last = (t == nt - 2);
            const char* a1 = cA + (size_t)(t + 1) * kstep;
            const char* a2 = last ? nA : cA + (size_t)(t + 2) * kstep; const char* b2 = last ? nB : cB + (size_t)(t + 2) * kstep;
            const char* a3 = a2 + kstep; const char* b3 = b2 + kstep;
            if (last && has_next) S.a_ready(nxt);
            if constexpr (SP2) {
            PG8_LDB(B0, 0, 0); PG8_LDB(B1, 0, 1); PG8_SCHED; PG8_LDA(At, 0, 0); PG8_STAGE(PG8_SA(1, 1), a1 + hstep, voffA);
            PG8_WAIT_V(8); PG8_WAIT_L(0); PG8_BAR; PG8_MMA(0, 0, At, B0); PG8_MMA(0, 1, At, B1); PG8_BAR; PG8_SCHED;
            PG8_LDA(At, 0, 1); PG8_STAGE(PG8_SB(0, 0), b2, voffB); PG8_STAGE(PG8_SB(0, 1), b2 + hstep, voffB); PG8_STAGE(PG8_SA(0, 0), a2, voffA);
            PG8_WAIT_V(8); PG8_WAIT_L(0); PG8_BAR; PG8_MMA(1, 0, At, B0); PG8_MMA(1, 1, At, B1); PG8_BAR; PG8_SCHED;
            PG8_LDB(B0, 1, 0); PG8_LDB(B1, 1, 1); PG8_SCHED; PG8_LDA(At, 1, 0); PG8_STAGE(PG8_SA(0, 1), a2 + hstep, voffA);
            PG8_WAIT_V(8); PG8_WAIT_L(0); PG8_BAR; PG8_MMA(0, 0, At, B0); PG8_MMA(0, 1, At, B1); PG8_BAR; PG8_SCHED;
            PG8_LDA(At, 1, 1); PG8_STAGE(PG8_SB(1, 0), b3, voffB); PG8_STAGE(PG8_SB(1, 1), b3 + hstep, voffB); PG8_STAGE(PG8_SA(1, 0), a3, voffA);
            PG8_WAIT_V(8); PG8_WAIT_L(0); PG8_BAR; PG8_MMA(1, 0, At, B0); PG8_MMA(1, 1, At, B1); PG8_BAR; PG8_SCHED;
            } else {
            PG8_LDB(B0, 0, 0); PG8_SCHED; PG8_LDA(At, 0, 0); PG8_STAGE(PG8_SA(1, 1), a1 + hstep, voffA);
            PG8_WAIT_L(8); PG8_BAR; PG8_WAIT_L(0); PG8_MMA(0, 0, At, B0); PG8_BAR; PG8_SCHED;
            PG8_LDB(B1, 0, 1); PG8_STAGE(PG8_SB(0, 0), b2, voffB);
            PG8_BAR; PG8_WAIT_L(0); PG8_MMA(0, 1, At, B1); PG8_BAR;
            PG8_LDA(At, 0, 1); PG8_STAGE(PG8_SA(0, 0), a2, voffA);
            PG8_BAR; PG8_WAIT_L(0); PG8_MMA(1, 0, At, B0); PG8_BAR; PG8_SCHED;
            PG8_STAGE(PG8_SB(0, 1), b2 + hstep, voffB);
            PG8_WAIT_V(6); PG8_BAR; PG8_MMA(1, 1, At, B1); PG8_BAR;
            PG8_LDB(B0, 1, 0); PG8_SCHED; PG8_LDA(At, 1, 0); PG8_STAGE(PG8_SA(0, 1), a2 + hstep, voffA);
            PG8_WAIT_L(8); PG8_BAR; PG8_WAIT_L(0); PG8_MMA(0, 0, At, B0); PG8_BAR; PG8_SCHED;
            PG8_LDB(B1, 1, 1); PG8_STAGE(PG8_SB(1, 0), b3, voffB);
            PG8_BAR; PG8_WAIT_L(0); PG8_MMA(0, 1, At, B1); PG8_BAR;
            PG8_LDA(At, 1, 1); PG8_STAGE(PG8_SA(1, 0), a3, voffA);
            PG8_BAR; PG8_WAIT_L(0); PG8_MMA(1, 0, At, B0); PG8_BAR; PG8_SCHED;
            PG8_STAGE(PG8_SB(1, 1), b3 + hstep, voffB);
            PG8_WAIT_V(6); PG8_BAR; PG8_MMA(1, 1, At, B1); PG8_BAR;
            }
        }
        if constexpr (ALIGN_EPI) { if (wr == 0) PG8_BAR; }
        if constexpr (!Epi::AFTER_DRAIN) { E(acc, cur, wr, wc, fr, fq); S.done(cur); }
        if (!has_next) break;
#pragma unroll
        for (int a = 0; a < 2; ++a)
#pragma unroll
            for (int b = 0; b < 2; ++b)
#pragma unroll
                for (int m = 0; m < 4; ++m)
#pragma unroll
                    for (int n = 0; n < 2; ++n) acc[a][b][m][n] = (f32x4){0.f, 0.f, 0.f, 0.f};
        cur = nxt; cA = nA; cB = nB; ++ui;
        if constexpr (ALIGN_EPI) { if (wr == 1) PG8_BAR; }
    }
    PG8_WAIT_V(0);
    if constexpr (!ALIGN_EPI) { if (wr == 0) PG8_BAR; }
    PG8_BAR;
    if constexpr (Epi::AFTER_DRAIN) { E.fused(acc, cur, wr, wc, fr, fq, lds, wid, lane); S.done(cur); }
#undef PG8_SA
#undef PG8_SB
#undef PG8_STAGE
#undef PG8_LDA
#undef PG8_LDB
#undef PG8_MMA
#undef PG8_WAIT_V
#undef PG8_WAIT_L
#undef PG8_BAR
#undef PG8_SCHED
}
template <class Epi, class Sched, bool ALIGN_EPI = false, bool SP2 = false>
__device__ __forceinline__ void gemm_phase2(PG8_LAS unsigned char* lds, const Gemm g, const Gemm g2, const Sched& S, const Epi& E) {
    const int tid = threadIdx.x, wid = __builtin_amdgcn_readfirstlane(tid >> 6), lane = tid & 63, wr = wid >> 2, wc = wid & 3, fr = lane & 15, fq = lane >> 4;
    const int K = g.K, nt = K / BK;
    unsigned voffA[2], voffB[2];
#pragma unroll
    for (int i = 0; i < 2; ++i) { int R, C; stage_rc(tid * 16 + i * 8192, R, C); const int Rb = Epi::PERM ? ((R & ~31) + perm32(R & 31)) : R;
        voffA[i] = (unsigned)(R * K + C) * 2u; voffB[i] = (unsigned)(Rb * K + C) * 2u; }
    const size_t kstep = (size_t)(BK * 2);
    const size_t hstep = (size_t)HALF * K * 2;
    const size_t tstep = 2 * hstep;
    const unsigned ldsw = (unsigned)wid * 1024u;
    const int aoff = lds_byte(wr * 64 + fr, fq * 8), boff = lds_byte(wc * 32 + fr, fq * 8);
#define PG8_SA(b, h) (((b) * 2 + (h)) * HTB)
#define PG8_SB(b, h) ((4 + (b) * 2 + (h)) * HTB)
#define PG8_STAGE(bufoff, gbase, voff) do { _Pragma("unroll") for (int _i = 0; _i < 2; ++_i) \
        __builtin_amdgcn_global_load_lds((const unsigned*)((const char*)(gbase) + (voff)[_i]), (PG8_LAS unsigned*)(lds + (bufoff) + ldsw + _i * 8192), 16, 0, 0); } while (0)
#define PG8_LDA(dst, b, h) do { _Pragma("unroll") for (int m = 0; m < 4; ++m) _Pragma("unroll") for (int k = 0; k < 2; ++k) dst[m][k] = *(const PG8_LAS bf16x8*)(lds + PG8_SA(b, h) + aoff + m * 2048 + k * 1024); } while (0)
#define PG8_LDB(dst, b, h) do { _Pragma("unroll") for (int n = 0; n < 2; ++n) _Pragma("unroll") for (int k = 0; k < 2; ++k) dst[n][k] = *(const PG8_LAS bf16x8*)(lds + PG8_SB(b, h) + boff + n * 2048 + k * 1024); } while (0)
#define PG8_MMA(ai, bj, At, Bt) do { __builtin_amdgcn_s_setprio(1); _Pragma("unroll") for (int m = 0; m < 4; ++m) _Pragma("unroll") for (int n = 0; n < 2; ++n) _Pragma("unroll") for (int k = 0; k < 2; ++k) \
        acc[ai][bj][m][n] = __builtin_amdgcn_mfma_f32_16x16x32_bf16(Bt[n][k], At[m][k], acc[ai][bj][m][n], 0, 0, 0); __builtin_amdgcn_s_setprio(0); } while (0)
#define PG8_WAIT_V(n) asm volatile("s_waitcnt vmcnt(" #n ")" ::: "memory")
#define PG8_WAIT_L(n) asm volatile("s_waitcnt lgkmcnt(" #n ")" ::: "memory")
#define PG8_BAR __builtin_amdgcn_s_barrier()
#define PG8_SCHED __builtin_amdgcn_sched_barrier(0)
    Unit cur, nxt; int ui = 0, seg = 0;
    if (!S.next(0, cur)) return;
    f32x4 acc[2][2][4][2];
#pragma unroll
    for (int a = 0; a < 2; ++a)
#pragma unroll
        for (int b = 0; b < 2; ++b)
#pragma unroll
            for (int m = 0; m < 4; ++m)
#pragma unroll
                for (int n = 0; n < 2; ++n) acc[a][b][m][n] = (f32x4){0.f, 0.f, 0.f, 0.f};
    bf16x8 At[4][2], B0[2][2], B1[2][2];
    const char* cA = (const char*)g.A + (size_t)cur.pm * tstep; const char* cB = (const char*)g.Bt + (size_t)cur.pn * tstep;
    S.a_ready(cur);
    if constexpr (SP2) {
        PG8_STAGE(PG8_SB(0, 0), cB, voffB); PG8_STAGE(PG8_SB(0, 1), cB + hstep, voffB); PG8_STAGE(PG8_SA(0, 0), cA, voffA); PG8_STAGE(PG8_SA(0, 1), cA + hstep, voffA);
        if (wr == 1) PG8_BAR;
        PG8_WAIT_V(2); PG8_BAR;
        PG8_STAGE(PG8_SB(1, 0), cB + kstep, voffB); PG8_STAGE(PG8_SA(1, 0), cA + kstep, voffA); PG8_STAGE(PG8_SB(1, 1), cB + hstep + kstep, voffB);
        PG8_WAIT_V(6); PG8_BAR;
    } else {
        PG8_STAGE(PG8_SB(0, 0), cB, voffB); PG8_STAGE(PG8_SA(0, 0), cA, voffA); PG8_STAGE(PG8_SB(0, 1), cB + hstep, voffB); PG8_STAGE(PG8_SA(0, 1), cA + hstep, voffA);
        if (wr == 1) PG8_BAR;
        PG8_WAIT_V(4); PG8_BAR;
        PG8_STAGE(PG8_SB(1, 0), cB + kstep, voffB); PG8_STAGE(PG8_SA(1, 0), cA + kstep, voffA); PG8_STAGE(PG8_SB(1, 1), cB + hstep + kstep, voffB);
        PG8_WAIT_V(6); PG8_BAR;
    }
    for (;;) {
        bool has_next; if (seg == 0) has_next = true; else has_next = S.next(ui + 1, nxt);
        const char* nA; const char* nB;
        if (seg == 0) { nA = (const char*)g2.A + (size_t)cur.pm * tstep; nB = (const char*)g2.Bt + (size_t)cur.pn * tstep; }
        else { nA = has_next ? (const char*)g.A + (size_t)nxt.pm * tstep : cA; nB = has_next ? (const char*)g.Bt + (size_t)nxt.pn * tstep : cB; }
        for (int t = 0; t < nt; t += 2) {
            const bool last = (t == nt - 2);
            const char* a1 = cA + (size_t)(t + 1) * kstep;
            const char* a2 = last ? nA : cA + (size_t)(t + 2) * kstep; const char* b2 = last ? nB : cB + (size_t)(t + 2) * kstep;
            const char* a3 = a2 + kstep; const char* b3 = b2 + kstep;
            if (last && has_next) S.a_ready(nxt);
            if constexpr (SP2) {
            PG8_LDB(B0, 0, 0); PG8_LDB(B1, 0, 1); PG8_SCHED; PG8_LDA(At, 0, 0); PG8_STAGE(PG8_SA(1, 1), a1 + hstep, voffA);
            PG8_WAIT_V(8); PG8_WAIT_L(0); PG8_BAR; PG8_MMA(0, 0, At, B0); PG8_MMA(0, 1, At, B1); PG8_BAR; PG8_SCHED;
            PG8_LDA(At, 0, 1); PG8_STAGE(PG8_SB(0, 0), b2, voffB); PG8_STAGE(PG8_SB(0, 1), b2 + hstep, voffB); PG8_STAGE(PG8_SA(0, 0), a2, voffA);
            PG8_WAIT_V(8); PG8_WAIT_L(0); PG8_BAR; PG8_MMA(1, 0, At, B0); PG8_MMA(1, 1, At, B1); PG8_BAR; PG8_SCHED;
            PG8_LDB(B0, 1, 0); PG8_LDB(B1, 1, 1); PG8_SCHED; PG8_LDA(At, 1, 0); PG8_STAGE(PG8_SA(0, 1), a2 + hstep, voffA);
            PG8_WAIT_V(8); PG8_WAIT_L(0); PG8_BAR; PG8_MMA(0, 0, At, B0); PG8_MMA(0, 1, At, B1); PG8_BAR; PG8_SCHED;
            PG8_LDA(At, 1, 1); PG8_STAGE(PG8_SB(1, 0), b3, voffB); PG8_STAGE(PG8_SB(1, 1), b3 + hstep, voffB); PG8_STAGE(PG8_SA(1, 0), a3, voffA);
            PG8_WAIT_V(8); PG8_WAIT_L(0); PG8_BAR; PG8_MMA(1, 0, At, B0); PG8_MMA(1, 1, At, B1); PG8_BAR; PG8_SCHED;
            } else {
            PG8_LDB(B0, 0, 0); PG8_SCHED; PG8_LDA(At, 0, 0); PG8_STAGE(PG8_SA(1, 1), a1 + hstep, voffA);
            PG8_WAIT_L(8); PG8_BAR; PG8_WAIT_L(0); PG8_MMA(0, 0, At, B0); PG8_BAR; PG8_SCHED;
            PG8_LDB(B1, 0, 1); PG8_STAGE(PG8_SB(0, 0), b2, voffB);
            PG8_BAR; PG8_WAIT_L(0); PG8_MMA(0, 1, At, B1); PG8_BAR;
            PG8_LDA(At, 0, 1); PG8_STAGE(PG8_SA(0, 0), a2, voffA);
            PG8_BAR; PG8_WAIT_L(0); PG8_MMA(1, 0, At, B0); PG8_BAR; PG8_SCHED;
            PG8_STAGE(PG8_SB(0, 1), b2 + hstep, voffB);
            PG8_WAIT_V(6); PG8_BAR; PG8_MMA(1, 1, At, B1); PG8_BAR;
            PG8_LDB(B0, 1, 0); PG8_SCHED; PG8_LDA(At, 1, 0); PG8_STAGE(PG8_SA(0, 1), a2 + hstep, voffA);
            PG8_WAIT_L(8); PG8_BAR; PG8_WAIT_L(0); PG8_MMA(0, 0, At, B0); PG8_BAR; PG8_SCHED;
            PG8_LDB(B1, 1, 1); PG8_STAGE(PG8_SB(1, 0), b3, voffB);
            PG8_BAR; PG8_WAIT_L(0); PG8_MMA(0, 1, At, B1); PG8_BAR;
            PG8_LDA(At, 1, 1); PG8_STAGE(PG8_SA(1, 0), a3, voffA);
            PG8_BAR; PG8_WAIT_L(0); PG8_MMA(1, 0, At, B0); PG8_BAR; PG8_SCHED;
            PG8_STAGE(PG8_SB(1, 1), b3 + hstep, voffB);
            PG8_WAIT_V(6); PG8_BAR; PG8_MMA(1, 1, At, B1); PG8_BAR;
            }
        }
        if constexpr (ALIGN_EPI) { if (wr == 0) PG8_BAR; }
        if (seg == 0) E.mid(acc, cur, wr, wc, fr, fq); else { E(acc, cur, wr, wc, fr, fq); S.done(cur); }
        if (!has_next) break;
        if (seg == 1) {
#pragma unroll
        for (int a = 0; a < 2; ++a)
#pragma unroll
            for (int b = 0; b < 2; ++b)
#pragma unroll
                for (int m = 0; m < 4; ++m)
#pragma unroll
                    for (int n = 0; n < 2; ++n) acc[a][b][m][n] = (f32x4){0.f, 0.f, 0.f, 0.f};
        cur = nxt; ++ui; }
        cA = nA; cB = nB; seg ^= 1;
        if constexpr (ALIGN_EPI) { if (wr == 1) PG8_BAR; }
    }
    PG8_WAIT_V(0);
    if constexpr (!ALIGN_EPI) { if (wr == 0) PG8_BAR; }
    PG8_BAR;
#undef PG8_SA
#undef PG8_SB
#undef PG8_STAGE
#undef PG8_LDA
#undef PG8_LDB
#undef PG8_MMA
#undef PG8_WAIT_V
#undef PG8_WAIT_L
#undef PG8_BAR
#undef PG8_SCHED
}
}
#define XB_TMO      128
#define XB_XCNT(j)  (256  + 64 * (j))
#define XB_XSUB(j)  (1280 + 64 * (j))
#define XB_XGEN(j)  (2304 + 64 * (j))
#define XB_TOP      3328
#define XB_TOPGEN   3392
#define XCD_BAR_WORDS 3456
#define XB_SPIN_CAP (1u << 18)

__device__ __forceinline__ unsigned xb_ld(unsigned* p)              { return __hip_atomic_load(p, __ATOMIC_RELAXED, __HIP_MEMORY_SCOPE_AGENT); }
__device__ __forceinline__ unsigned xb_add(unsigned* p, unsigned v) { return __hip_atomic_fetch_add(p, v, __ATOMIC_RELAXED, __HIP_MEMORY_SCOPE_AGENT); }
__device__ __forceinline__ unsigned xb_xcc_id() { return (unsigned)__builtin_amdgcn_s_getreg((3 << 11) | 20) & 0xFu; }
#define XB_SPIN(cond, bar) do { unsigned _sp = 0; while (cond) { __builtin_amdgcn_s_sleep(1); \
    if ((++_sp & 255u) == 0u) { if (xb_ld(&(bar)[XB_TMO])) break; if (_sp > XB_SPIN_CAP) { atomicAdd(&(bar)[XB_TMO], 1u); break; } } } } while (0)

struct XcdBarrier {
    unsigned* bar; unsigned x;
    volatile LAS unsigned* st;
};

__device__ __forceinline__ XcdBarrier xcd_barrier_post(unsigned* bar, volatile LAS unsigned* st) {
    XcdBarrier b; b.bar = bar; b.x = xb_xcc_id(); b.st = st;
    if (threadIdx.x == 0) (void)xb_add(&bar[XB_XCNT(b.x)], 1u);
    return b;
}
__device__ __forceinline__ void xcd_barrier_complete(unsigned* bar, unsigned x, unsigned& nloc, unsigned& nx) {
    const unsigned G = gridDim.x * gridDim.y * gridDim.z;
    unsigned sum, cnt, mine, sp = 0u;
    for (;;) {
        sum = 0u; cnt = 0u; mine = 0u;
#pragma unroll
        for (unsigned j = 0; j < 16; ++j) { const unsigned c = xb_ld(&bar[XB_XCNT(j)]); sum += c; cnt += (c > 0u) ? 1u : 0u; mine = (j == x) ? c : mine; }
        if (sum == G) break;
        __builtin_amdgcn_s_sleep(1);
        if ((++sp & 255u) == 0u) { if (xb_ld(&bar[XB_TMO])) break; if (sp > XB_SPIN_CAP) { atomicAdd(&bar[XB_TMO], 1u); break; } }
    }
    nloc = mine > 0u ? mine : 1u; nx = cnt > 0u ? cnt : 1u;
}

__device__ __forceinline__ void xcd_barrier(const XcdBarrier& b) {
    asm volatile("s_waitcnt vmcnt(0)" ::: "memory");
    __syncthreads();
    if (threadIdx.x == 0) {
        unsigned* bar = b.bar;
        __builtin_amdgcn_s_waitcnt(0);
        unsigned nloc = b.st[0], nx = b.st[1];
        if (nloc == 0u) { xcd_barrier_complete(bar, b.x, nloc, nx); b.st[0] = nloc; b.st[1] = nx; }
        const unsigned old = xb_add(&bar[XB_XSUB(b.x)], 1u);
        const unsigned gen = old / nloc;
        if (old + 1u == (gen + 1u) * nloc) {
            __builtin_amdgcn_fence(__ATOMIC_RELEASE, "agent");
            asm volatile("s_waitcnt vmcnt(0)" ::: "memory");
            const unsigned og = xb_add(&bar[XB_TOP], 1u);
            const unsigned tg = og / nx;
            if (og + 1u == (tg + 1u) * nx) xb_add(&bar[XB_TOPGEN], 1u);
            else XB_SPIN(xb_ld(&bar[XB_TOPGEN]) == tg, bar);
            __builtin_amdgcn_fence(__ATOMIC_ACQUIRE, "agent");
            xb_add(&bar[XB_XGEN(b.x)], 1u);
            asm volatile("s_waitcnt vmcnt(0)" ::: "memory");
        } else {
            XB_SPIN(xb_ld(&bar[XB_XGEN(b.x)]) == gen, bar);
            __builtin_amdgcn_fence(__ATOMIC_ACQUIRE, "agent");
            asm volatile("s_waitcnt vmcnt(0)" ::: "memory");
        }
    }
    __syncthreads();
}

constexpr int D = 4096, SEQ = 8192, NX = 16384  , NMETA = 16, MROWS = 16640  ;
constexpr int DIN = 36864, DFF = 11008, NH = 16;
constexpr float EPS = 1e-6f, LOG2E = 1.4426950408889634f;
constexpr size_t MiB = 1u << 20;
constexpr size_t WS_CTL = 0, CTL_ZERO_BYTES = 1 * MiB;
constexpr size_t WS_WBR = 1 * MiB, WS_WBD = 33 * MiB, WS_WO = 65 * MiB, WS_WGU = 97 * MiB, WS_WDN = 269 * MiB;
constexpr size_t WS_WIN = 355 * MiB, WS_U = 643 * MiB;
constexpr size_t WS_ST = 355 * MiB;
constexpr size_t WS_PROJ = 867 * MiB;
constexpr size_t WS_YR = 2037 * MiB, WS_END = 2165 * MiB;
constexpr size_t GS = (size_t)MROWS * D;
constexpr size_t WS_MIXED = 355 * MiB, WS_U2 = 483 * MiB, WS_ACT = 867 * MiB, WS_H2 = 355 * MiB  , WS_PS = 611 * MiB  , WS_RSTD = 616 * MiB  ;
static_assert(WS_WGU + (size_t)2 * DFF * D * 2 <= WS_WDN && WS_WDN + (size_t)D * DFF * 2 <= WS_WIN && WS_WIN + (size_t)DIN * D * 2 <= WS_U && WS_U + (size_t)MROWS * D * 2 <= WS_ST + 512 * MiB && WS_ST + 512 * MiB <= WS_PROJ && WS_PROJ + 9 * GS * 2 <= WS_END, "ws map");
constexpr int CW_BAR = 4096;
constexpr int LDS_BYTES = 163840, MISC_OFF = LDS_BYTES - 256;
constexpr int NWAVES = 8;


typedef unsigned short bf16;
typedef LAS char lchar;
#define LDS_WAIT() asm volatile("s_waitcnt lgkmcnt(0)" ::: "memory")
#define VM_WAIT() asm volatile("s_waitcnt vmcnt(0)" ::: "memory")
#define WAITBAR() do { asm volatile("s_waitcnt vmcnt(0) lgkmcnt(0)" ::: "memory"); __builtin_amdgcn_s_barrier(); asm volatile("" ::: "memory"); } while (0)

namespace mx {
using bf16x8 = __attribute__((ext_vector_type(8))) short;
using s16x4  = __attribute__((ext_vector_type(4))) short;
using f32x16 = __attribute__((ext_vector_type(16))) float;
using f32x4  = __attribute__((ext_vector_type(4))) float;
using u32x4  = __attribute__((ext_vector_type(4))) unsigned;
using u32x2  = __attribute__((ext_vector_type(2))) unsigned;
#define KSWZ(row, colB) ((row) * 256 + ((colB) ^ (((row) & 7) << 4)))
#define SBAR() __builtin_amdgcn_sched_barrier(0)
__device__ __forceinline__ int crow(int r, int hi) { return (r & 3) + 8 * (r >> 2) + 4 * hi; }
__device__ __forceinline__ unsigned cvtpk(float lo, float hi) { unsigned r; asm volatile("v_cvt_pk_bf16_f32 %0, %1, %2" : "=v"(r) : "v"(lo), "v"(hi)); return r; }
__device__ __forceinline__ float bflo(unsigned w) { return __uint_as_float(w << 16); }
__device__ __forceinline__ float bfhi(unsigned w) { return __uint_as_float(w & 0xffff0000u); }
__device__ __forceinline__ int v_rd_base(int lane) { return ((lane & 3) << 3) | (((lane >> 2) & 3) << 6) | (((lane >> 4) & 1) << 5) | (((lane >> 5) & 1) << 8); }
constexpr int vro(int d0, int ks, int half) { return d0 * 512 + ks * 8192 + half * 4096; }
template <int OFF> __device__ __forceinline__ s16x4 tr_read(int vb) { s16x4 r; asm volatile("ds_read_b64_tr_b16 %0, %1 offset:%2" : "=&v"(r) : "v"(vb), "i"(OFF) : "memory"); return r; }
#define MX_PK(L, H) (mx::bf16x8){L[0], L[1], L[2], L[3], H[0], H[1], H[2], H[3]}
__device__ __forceinline__ void vimg_rc(int P, int& k, int& c) { const int st = P >> 9, wi = P & 511, kk = (st >> 3) * 8 + (wi >> 6); c = (st & 7) * 32 + ((wi & 63) >> 1); k = (kk & ~0xC) | ((kk & 4) << 1) | ((kk & 8) >> 1); }
__device__ __forceinline__ void kimg_rc(int P, int& r, int& c) { r = P >> 8; const int cp = P & 255; c = (cp ^ ((r & 7) << 4)) >> 1; }
__device__ __forceinline__ void glds16(const void* g, lchar* l) { __builtin_amdgcn_global_load_lds((const unsigned*)g, (LAS unsigned*)l, 16, 0, 0); }
__device__ __forceinline__ int lds_addr(const lchar* p) { return (int)(unsigned)(size_t)p; }
template <int K> __device__ __forceinline__ float swz_xor(float v) { return __int_as_float(__builtin_amdgcn_ds_swizzle(__float_as_int(v), 0x1f | (K << 10))); }
__device__ __forceinline__ float half_sum(float v) { v += swz_xor<1>(v); v += swz_xor<2>(v); v += swz_xor<4>(v); v += swz_xor<8>(v); v += swz_xor<16>(v); return v; }
__device__ __forceinline__ int opaque(int x) { asm volatile("" : "+v"(x)); return x; }

template <int ND> __device__ __forceinline__ void qkt(f32x16& p0, f32x16& p1, const lchar* Ks, const bf16x8* qr, int r32, int hi) {
#pragma unroll
  for (int r = 0; r < 16; ++r) { p0[r] = 0.f; p1[r] = 0.f; }
#pragma unroll
  for (int d0 = 0; d0 < ND; ++d0) { const int cb = ((d0 & 7) * 16 + hi * 8) * 2; const lchar* Kh = Ks + (d0 >> 3) * 16384;
    const bf16x8 b0 = *(const LAS bf16x8*)(Kh + KSWZ(r32, cb));
    const bf16x8 b1 = *(const LAS bf16x8*)(Kh + KSWZ(32 + r32, cb));
    p0 = __builtin_amdgcn_mfma_f32_32x32x16_bf16(b0, qr[d0], p0, 0, 0, 0);
    p1 = __builtin_amdgcn_mfma_f32_32x32x16_bf16(b1, qr[d0], p1, 0, 0, 0); }
}
__device__ __forceinline__ void pack_p(const f32x16& p0, const f32x16& p1, bf16x8& pa0, bf16x8& pa1, bf16x8& pa2, bf16x8& pa3) {
#define PK4(P, BASE, OUT) do { unsigned a0 = cvtpk(P[BASE + 0], P[BASE + 1]), a1 = cvtpk(P[BASE + 2], P[BASE + 3]);   \
    unsigned b0 = cvtpk(P[BASE + 4], P[BASE + 5]), b1 = cvtpk(P[BASE + 6], P[BASE + 7]);                              \
    auto r0 = __builtin_amdgcn_permlane32_swap(a0, b0, false, false); auto r1 = __builtin_amdgcn_permlane32_swap(a1, b1, false, false); \
    u32x4 w = {r0[0], r1[0], r0[1], r1[1]}; OUT = *reinterpret_cast<bf16x8*>(&w); } while (0)
  PK4(p0, 0, pa0); PK4(p0, 8, pa1); PK4(p1, 0, pa2); PK4(p1, 8, pa3);
#undef PK4
}
__device__ __forceinline__ void pack_p2(const f32x16& p, bf16x8& pa0, bf16x8& pa1) {
#define PK4(P, BASE, OUT) do { unsigned a0 = cvtpk(P[BASE + 0], P[BASE + 1]), a1 = cvtpk(P[BASE + 2], P[BASE + 3]);   \
    unsigned b0 = cvtpk(P[BASE + 4], P[BASE + 5]), b1 = cvtpk(P[BASE + 6], P[BASE + 7]);                              \
    auto r0 = __builtin_amdgcn_permlane32_swap(a0, b0, false, false); auto r1 = __builtin_amdgcn_permlane32_swap(a1, b1, false, false); \
    u32x4 w = {r0[0], r1[0], r0[1], r1[1]}; OUT = *reinterpret_cast<bf16x8*>(&w); } while (0)
  PK4(p, 0, pa0); PK4(p, 8, pa1);
#undef PK4
}
template <int D0, int KH> __device__ __forceinline__ void pv_half(f32x16& od, int vb, bf16x8 a0, bf16x8 a1) {
  const s16x4 l0 = tr_read<vro(D0, 2 * KH, 0)>(vb), h0 = tr_read<vro(D0, 2 * KH, 1)>(vb), l1 = tr_read<vro(D0, 2 * KH + 1, 0)>(vb), h1 = tr_read<vro(D0, 2 * KH + 1, 1)>(vb);
  asm volatile("s_waitcnt lgkmcnt(0)" ::: "memory"); SBAR();
  od = __builtin_amdgcn_mfma_f32_32x32x16_bf16(a0, MX_PK(l0, h0), od, 0, 0, 0);
  od = __builtin_amdgcn_mfma_f32_32x32x16_bf16(a1, MX_PK(l1, h1), od, 0, 0, 0);
}
template <int D0, int KH> __device__ __forceinline__ void pv_half2(f32x16& oa, f32x16& ob, int vb, bf16x8 a0, bf16x8 a1) {
  const s16x4 l0 = tr_read<vro(D0, 2 * KH, 0)>(vb), h0 = tr_read<vro(D0, 2 * KH, 1)>(vb), l1 = tr_read<vro(D0, 2 * KH + 1, 0)>(vb), h1 = tr_read<vro(D0, 2 * KH + 1, 1)>(vb);
  const s16x4 l2 = tr_read<vro(D0 + 1, 2 * KH, 0)>(vb), h2 = tr_read<vro(D0 + 1, 2 * KH, 1)>(vb), l3 = tr_read<vro(D0 + 1, 2 * KH + 1, 0)>(vb), h3 = tr_read<vro(D0 + 1, 2 * KH + 1, 1)>(vb);
  asm volatile("s_waitcnt lgkmcnt(0)" ::: "memory"); SBAR();
  oa = __builtin_amdgcn_mfma_f32_32x32x16_bf16(a0, MX_PK(l0, h0), oa, 0, 0, 0);
  ob = __builtin_amdgcn_mfma_f32_32x32x16_bf16(a0, MX_PK(l2, h2), ob, 0, 0, 0);
  oa = __builtin_amdgcn_mfma_f32_32x32x16_bf16(a1, MX_PK(l1, h1), oa, 0, 0, 0);
  ob = __builtin_amdgcn_mfma_f32_32x32x16_bf16(a1, MX_PK(l3, h3), ob, 0, 0, 0);
}
template <int KH> __device__ __forceinline__ void pv_half8(f32x16* o, int vb, bf16x8 a0, bf16x8 a1) {
#define PV8_RD(D0, L0, H0, L1, H1, L2, H2, L3, H3) const s16x4 L0 = tr_read<vro(D0, 2 * KH, 0)>(vb), H0 = tr_read<vro(D0, 2 * KH, 1)>(vb), L1 = tr_read<vro(D0, 2 * KH + 1, 0)>(vb), H1 = tr_read<vro(D0, 2 * KH + 1, 1)>(vb), \
      L2 = tr_read<vro(D0 + 1, 2 * KH, 0)>(vb), H2 = tr_read<vro(D0 + 1, 2 * KH, 1)>(vb), L3 = tr_read<vro(D0 + 1, 2 * KH + 1, 0)>(vb), H3 = tr_read<vro(D0 + 1, 2 * KH + 1, 1)>(vb)
#define PV8_MM(D0, L0, H0, L1, H1, L2, H2, L3, H3) do { o[D0] = __builtin_amdgcn_mfma_f32_32x32x16_bf16(a0, MX_PK(L0, H0), o[D0], 0, 0, 0); o[D0 + 1] = __builtin_amdgcn_mfma_f32_32x32x16_bf16(a0, MX_PK(L2, H2), o[D0 + 1], 0, 0, 0); \
      o[D0] = __builtin_amdgcn_mfma_f32_32x32x16_bf16(a1, MX_PK(L1, H1), o[D0], 0, 0, 0); o[D0 + 1] = __builtin_amdgcn_mfma_f32_32x32x16_bf16(a1, MX_PK(L3, H3), o[D0 + 1], 0, 0, 0); } while (0)
  PV8_RD(0, a_l0, a_h0, a_l1, a_h1, a_l2, a_h2, a_l3, a_h3);
  PV8_RD(2, b_l0, b_h0, b_l1, b_h1, b_l2, b_h2, b_l3, b_h3);
  asm volatile("s_waitcnt lgkmcnt(8)" ::: "memory"); SBAR();
  PV8_MM(0, a_l0, a_h0, a_l1, a_h1, a_l2, a_h2, a_l3, a_h3); SBAR();
  PV8_RD(4, c_l0, c_h0, c_l1, c_h1, c_l2, c_h2, c_l3, c_h3);
  asm volatile("s_waitcnt lgkmcnt(8)" ::: "memory"); SBAR();
  PV8_MM(2, b_l0, b_h0, b_l1, b_h1, b_l2, b_h2, b_l3, b_h3); SBAR();
  PV8_RD(6, d_l0, d_h0, d_l1, d_h1, d_l2, d_h2, d_l3, d_h3);
  asm volatile("s_waitcnt lgkmcnt(8)" ::: "memory"); SBAR();
  PV8_MM(4, c_l0, c_h0, c_l1, c_h1, c_l2, c_h2, c_l3, c_h3); SBAR();
  asm volatile("s_waitcnt lgkmcnt(0)" ::: "memory"); SBAR();
  PV8_MM(6, d_l0, d_h0, d_l1, d_h1, d_l2, d_h2, d_l3, d_h3);
#undef PV8_RD
#undef PV8_MM
}
template <int D0> __device__ __forceinline__ void pv_one(f32x16& od, int vb, bf16x8 a0, bf16x8 a1, bf16x8 a2, bf16x8 a3) {
  const s16x4 l0 = tr_read<vro(D0, 0, 0)>(vb), h0 = tr_read<vro(D0, 0, 1)>(vb), l1 = tr_read<vro(D0, 1, 0)>(vb), h1 = tr_read<vro(D0, 1, 1)>(vb);
  const s16x4 l2 = tr_read<vro(D0, 2, 0)>(vb), h2 = tr_read<vro(D0, 2, 1)>(vb), l3 = tr_read<vro(D0, 3, 0)>(vb), h3 = tr_read<vro(D0, 3, 1)>(vb);
  asm volatile("s_waitcnt lgkmcnt(0)" ::: "memory"); SBAR();
  od = __builtin_amdgcn_mfma_f32_32x32x16_bf16(a0, MX_PK(l0, h0), od, 0, 0, 0);
  od = __builtin_amdgcn_mfma_f32_32x32x16_bf16(a1, MX_PK(l1, h1), od, 0, 0, 0);
  od = __builtin_amdgcn_mfma_f32_32x32x16_bf16(a2, MX_PK(l2, h2), od, 0, 0, 0);
  od = __builtin_amdgcn_mfma_f32_32x32x16_bf16(a3, MX_PK(l3, h3), od, 0, 0, 0);
}
}

struct Frame {
    lchar* lds; volatile LAS unsigned* MISC; unsigned* ctl;
    int tid, lane, wave, vcu, G;
    const float* in[15]; float* out; unsigned char* ws;
};
__device__ __forceinline__ float wave_sum(float v) {
    v = mx::half_sum(v);
    auto rr = __builtin_amdgcn_permlane32_swap(__float_as_uint(v), __float_as_uint(v), false, false);
    return __uint_as_float(rr[0]) + __uint_as_float(rr[1]);
}
__device__ __forceinline__ unsigned f2bf(float f) { unsigned u = __builtin_bit_cast(unsigned, f); return (u + 0x7fffu + ((u >> 16) & 1u)) >> 16; }
__device__ __forceinline__ unsigned pk2(float lo, float hi) { return f2bf(lo) | (f2bf(hi) << 16); }

__device__ __forceinline__ void p0_transpose_item(const float* W, int K, int N, bf16* WT, int mode, LAS float* scr, int item, int lane, const float* gk = nullptr) {
    const int nblk = N / 64, kb = item / nblk, nb = item - kb * nblk, k0 = 64 * kb, n0 = 64 * nb;
    mx::f32x4 v[16];
    const float* src = W + (size_t)(k0 + (lane >> 4)) * N + n0 + 4 * (lane & 15);
#pragma unroll
    for (int i = 0; i < 16; ++i) v[i] = *(const mx::f32x4*)(src + (size_t)(4 * i) * N);
#pragma unroll
    for (int i = 0; i < 16; ++i) { LAS float* s = scr + (4 * i + (lane >> 4)) * 65 + 4 * (lane & 15); s[0] = v[i][0]; s[1] = v[i][1]; s[2] = v[i][2]; s[3] = v[i][3]; }
    LDS_WAIT(); asm volatile("" ::: "memory");
    const int c = lane & 7;
    const int nd0 = (mode == 0) ? n0 : ((n0 >> 7) * 256 + (n0 & 127) + (mode == 2 ? 128 : 0));
    mx::f32x4 ga = {1.f, 1.f, 1.f, 1.f}, gb = {1.f, 1.f, 1.f, 1.f};
    if (gk) { ga = *(const mx::f32x4*)(gk + k0 + 8 * c); gb = *(const mx::f32x4*)(gk + k0 + 8 * c + 4); }
#pragma unroll
    for (int j = 0; j < 8; ++j) { const int n = (lane >> 3) + 8 * j; const LAS float* s = scr + (8 * c) * 65 + n;
        mx::u32x4 o; o.x = pk2(s[0 * 65] * ga[0], s[1 * 65] * ga[1]); o.y = pk2(s[2 * 65] * ga[2], s[3 * 65] * ga[3]); o.z = pk2(s[4 * 65] * gb[0], s[5 * 65] * gb[1]); o.w = pk2(s[6 * 65] * gb[2], s[7 * 65] * gb[3]);
        *(mx::u32x4*)(WT + (size_t)(nd0 + n) * K + k0 + 8 * c) = o; }
    LDS_WAIT(); asm volatile("" ::: "memory");
}
template <bool OUT32> __device__ __forceinline__ void rms_row(const float* xrow, const float* g, void* orow, int lane) {
    const mx::f32x4* xr = (const mx::f32x4*)xrow + lane;
    mx::f32x4 v[16]; float s = 0.f;
#pragma unroll
    for (int j = 0; j < 16; ++j) { v[j] = xr[64 * j]; s += (v[j][0] * v[j][0] + v[j][1] * v[j][1]) + (v[j][2] * v[j][2] + v[j][3] * v[j][3]); }
    const float rstd = 1.0f / sqrtf(wave_sum(s) * (1.f / D) + EPS);
    const mx::f32x4* gr = (const mx::f32x4*)g + lane;
#pragma unroll
    for (int j = 0; j < 16; ++j) { const mx::f32x4 gg = gr[64 * j]; const mx::f32x4 y = v[j] * rstd * gg;
        if (OUT32) ((mx::f32x4*)orow)[lane + 64 * j] = y;
        else { mx::u32x2 w; w.x = pk2(y[0], y[1]); w.y = pk2(y[2], y[3]); ((mx::u32x2*)orow)[lane + 64 * j] = w; } }
}
__device__ __forceinline__ void rms_row_bf(const bf16* xrow, const float* g, float* orow, int lane) {
    const mx::u32x4* xr = (const mx::u32x4*)xrow + lane;
    mx::u32x4 v[8]; float s = 0.f;
#pragma unroll
    for (int j = 0; j < 8; ++j) { v[j] = xr[64 * j];
        s += (mx::bflo(v[j].x) * mx::bflo(v[j].x) + mx::bfhi(v[j].x) * mx::bfhi(v[j].x)) + (mx::bflo(v[j].y) * mx::bflo(v[j].y) + mx::bfhi(v[j].y) * mx::bfhi(v[j].y))
           + (mx::bflo(v[j].z) * mx::bflo(v[j].z) + mx::bfhi(v[j].z) * mx::bfhi(v[j].z)) + (mx::bflo(v[j].w) * mx::bflo(v[j].w) + mx::bfhi(v[j].w) * mx::bfhi(v[j].w)); }
    const float rstd = 1.0f / sqrtf(wave_sum(s) * (1.f / D) + EPS);
#pragma unroll
    for (int j = 0; j < 8; ++j) { const float* gp = g + 512 * j + 8 * lane; const mx::f32x4 g0 = *(const mx::f32x4*)gp, g1 = *(const mx::f32x4*)(gp + 4);
        float* op = orow + 512 * j + 8 * lane;
        *(mx::f32x4*)op = (mx::f32x4){mx::bflo(v[j].x) * rstd * g0[0], mx::bfhi(v[j].x) * rstd * g0[1], mx::bflo(v[j].y) * rstd * g0[2], mx::bfhi(v[j].y) * rstd * g0[3]};
        *(mx::f32x4*)(op + 4) = (mx::f32x4){mx::bflo(v[j].z) * rstd * g1[0], mx::bfhi(v[j].z) * rstd * g1[1], mx::bflo(v[j].w) * rstd * g1[2], mx::bfhi(v[j].w) * rstd * g1[3]}; }
}
__device__ __forceinline__ void p0_prologue(Frame& F) {
    LAS float* scr = (LAS float*)(F.lds + F.wave * 16640);
    const int gw = F.vcu * NWAVES + F.wave, NGW = F.G * NWAVES;
    bf16* WIN = (bf16*)(F.ws + WS_WIN); bf16* WBR = (bf16*)(F.ws + WS_WBR); bf16* WBD = (bf16*)(F.ws + WS_WBD); bf16* WO = (bf16*)(F.ws + WS_WO); bf16* WGU = (bf16*)(F.ws + WS_WGU); bf16* WDN = (bf16*)(F.ws + WS_WDN);
    constexpr int I_IN = (D / 64) * (DIN / 64), I_SQ = (D / 64) * (D / 64), I_FF = (D / 64) * (DFF / 64);
    constexpr int NITEMS = I_IN + 3 * I_SQ + 3 * I_FF;
    for (int it = gw; it < NITEMS; it += NGW) {
        int r = it;
        if (r < I_IN) { p0_transpose_item(F.in[3], D, DIN, WIN, 0, scr, r, F.lane); continue; } r -= I_IN;
        if (r < I_SQ) { p0_transpose_item(F.in[7], D, D, WBR, 0, scr, r, F.lane); continue; } r -= I_SQ;
        if (r < I_SQ) { p0_transpose_item(F.in[8], D, D, WBD, 0, scr, r, F.lane); continue; } r -= I_SQ;
        if (r < I_SQ) { p0_transpose_item(F.in[9], D, D, WO, 0, scr, r, F.lane); continue; } r -= I_SQ;
        if (r < I_FF) { p0_transpose_item(F.in[11], D, DFF, WGU, 1, scr, r, F.lane, F.in[10]); continue; } r -= I_FF;
        if (r < I_FF) { p0_transpose_item(F.in[12], D, DFF, WGU, 2, scr, r, F.lane, F.in[10]); continue; } r -= I_FF;
        p0_transpose_item(F.in[13], DFF, D, WDN, 0, scr, r, F.lane);
    }
    bf16* U = (bf16*)(F.ws + WS_U);
    for (int m = gw; m < MROWS; m += NGW) {
        bf16* orow = U + (size_t)m * D;
        if (m < NX) rms_row<false>(F.in[0] + (size_t)m * D, F.in[2], orow, F.lane);
        else if (m < NX + NMETA) rms_row<false>(F.in[1] + (size_t)(m - NX) * D, F.in[2], orow, F.lane);
        else {
#pragma unroll
            for (int j = 0; j < 16; ++j) ((mx::u32x2*)orow)[F.lane + 64 * j] = (mx::u32x2){0u, 0u}; }
    }
}


__device__ __forceinline__ void meta_proj(lchar* lds, const bf16* U, const bf16* WIN, bf16* PROJ, int vcu, int G) {
    using namespace mx; typedef float f32x4_t __attribute__((ext_vector_type(4)));
    const int tid = opaque((int)threadIdx.x), wid = __builtin_amdgcn_readfirstlane(tid >> 6), lane = tid & 63, cg = wid & 3, kh = wid >> 2;
    LAS float* red = (LAS float*)lds;
    for (int c = vcu; c < 256; c += G) {
        const int g0 = c * 64, gi = g0 >> 12, grp = (gi == 0) ? 1 : (gi == 1) ? 2 : (gi == 2) ? 5 : 6, col0 = (g0 & 4095) + cg * 16;
        const bf16* wrow = WIN + (size_t)(grp * 4096 + col0 + (lane & 15)) * D + kh * 2048 + (lane >> 4) * 8;
        const bf16* urow = U + (size_t)(NX + (lane & 15)) * D + kh * 2048 + (lane >> 4) * 8;
        f32x4_t acc = {0.f, 0.f, 0.f, 0.f};
#pragma unroll 8
        for (int ks = 0; ks < 64; ++ks) { const bf16x8 a = *(const bf16x8*)(urow + ks * 32), bq = *(const bf16x8*)(wrow + ks * 32);
            acc = __builtin_amdgcn_mfma_f32_16x16x32_bf16(a, bq, acc, 0, 0, 0); }
        if (kh == 1) *(LAS f32x4_t*)(red + (cg * 64 + lane) * 4) = acc;
        __syncthreads();
        if (kh == 0) { const f32x4_t o = *(const LAS f32x4_t*)(red + (cg * 64 + lane) * 4); acc += o;
            const float sc = (grp == 1) ? 0.0625f : 1.f; bf16* op = PROJ + (size_t)grp * GS + (size_t)(NX + (lane >> 4) * 4) * D + col0 + (lane & 15);
#pragma unroll
            for (int i = 0; i < 4; ++i) op[(size_t)i * D] = (bf16)f2bf(acc[i] * sc); }
        if (grp >= 5 && tid < 384) { bf16* zp = PROJ + (size_t)grp * GS + (size_t)(NX + 16 + (tid >> 3)) * D + (g0 & 4095) + (tid & 7) * 8; *(u32x4*)zp = (u32x4){0u, 0u, 0u, 0u}; }
        __syncthreads();
    }
}

constexpr int ATT_NT = 129;
constexpr int CW_NRM = 8192;
#define BARF() do { asm volatile("" ::: "memory"); __builtin_amdgcn_s_barrier(); asm volatile("" ::: "memory"); } while (0)
__device__ __forceinline__ void attn_unit(lchar* lds, const bf16* Qg, const bf16* Kg, const bf16* Vg, bf16* Og, float* stash, const float* subg, const unsigned* nrm, int b, int h, int qb, float lam) {
    using namespace mx;
    const int tid = threadIdx.x, wid = __builtin_amdgcn_readfirstlane(tid >> 6), lane = tid & 63, r32 = lane & 31, hi = lane >> 5, grp = wid >> 2;
    lchar* Kb = lds; lchar* Vb = lds + 32768; LAS float* li_l = (LAS float*)(lds + 147456) + wid * 64; LAS float* al_l = li_l + 32; LAS float* mslot = (LAS float*)(lds + 147456 + 2048);
    const float slope = exp2f(-0.5f * (float)(h + 1)), nsl2 = -slope * LOG2E;
    constexpr float C = 0.08838834764831845f * LOG2E, THR2 = 60.f, NEG = -1e30f;
    const float asl = slope * LOG2E, Cq = 0.08838834764831845f / slope, THRQ = THR2 / asl, DEADQ = -127.f / asl;
    const int qrow = b * SEQ + qb * 256 + wid * 32 + r32;
    const float qposf = (float)(NMETA + qb * 256 + wid * 32 + r32 - 4 * hi);
    const int vb0 = lds_addr(Vb) + v_rd_base(lane);
    const int ka0 = lds_addr(Kb) + r32 * 256 + ((hi * 16) ^ ((r32 & 7) << 4));
#pragma unroll 1
    for (int mp = 0; mp < 2; ++mp) {
        int t_lo, t_hi;
        const float smax_l2 = sqrtf(__uint_as_float(nrm[(0 * 2 + b) * 32 + h * 2 + mp])) * sqrtf(__uint_as_float(nrm[(1 * 2 + b) * 32 + h * 2 + mp])) * C;
        const bf16* Qw = Qg + (size_t)qrow * D + h * 256 + mp * 128 + hi * 8;
        bf16x8 qr[8];
#pragma unroll
        for (int d0 = 0; d0 < 8; ++d0) qr[d0] = *(const bf16x8*)(Qw + d0 * 16);
        const char* Kcol = (const char*)(Kg + h * 256 + mp * 128); const char* Vcol = (const char*)(Vg + h * 256);
        { const bf16* Kw = Kg + (size_t)qrow * D + h * 256 + mp * 128 + hi * 8; float dot = 0.f;
#pragma unroll
          for (int d0 = 0; d0 < 8; ++d0) { const u32x4 kk = *(const u32x4*)(Kw + d0 * 16); const u32x4 qq = *reinterpret_cast<const u32x4*>(&qr[d0]);
              dot += bflo(kk.x) * bflo(qq.x) + bfhi(kk.x) * bfhi(qq.x) + bflo(kk.y) * bflo(qq.y) + bfhi(kk.y) * bfhi(qq.y) + bflo(kk.z) * bflo(qq.z) + bfhi(kk.z) * bfhi(qq.z) + bflo(kk.w) * bflo(qq.w) + bfhi(kk.w) * bfhi(qq.w); }
          { auto rr = __builtin_amdgcn_permlane32_swap(__float_as_uint(dot), __float_as_uint(dot), false, false); dot = __uint_as_float(rr[0]) + __uint_as_float(rr[1]); }
          float mm = dot * C; mm = fminf(mm, swz_xor<1>(mm)); mm = fminf(mm, swz_xor<2>(mm)); mm = fminf(mm, swz_xor<4>(mm)); mm = fminf(mm, swz_xor<8>(mm)); mm = fminf(mm, swz_xor<16>(mm));
          if (lane == 0) mslot[wid] = mm; LDS_WAIT(); BARF();
          float mmin = mslot[0];
#pragma unroll
          for (int w = 1; w < 8; ++w) mmin = fminf(mmin, mslot[w]);
          const float wf = fminf((smax_l2 - mmin + 152.f) / (-nsl2) + 2.f, 20000.f); const int W = (int)wf;
          const int qmin = NMETA + qb * 256, qmax = qmin + 255;
          const int klo = qmin - W, khi = qmax + W;
          t_lo = (klo <= 15) ? 0 : (klo + 48) / 64; if (t_lo > 128) t_lo = 128;
          t_hi = (khi + 48) / 64; if (t_hi > 128) t_hi = 128; if (t_hi < t_lo) t_hi = t_lo;
          t_lo = __builtin_amdgcn_readfirstlane(t_lo); t_hi = __builtin_amdgcn_readfirstlane(t_hi); }
        const int ntl = t_hi - t_lo + 1;
        f32x16 o[8];
#pragma unroll
        for (int d = 0; d < 8; ++d)
#pragma unroll
            for (int r = 0; r < 16; ++r) o[d][r] = 0.f;
        float m_reg = NEG, l_reg = 0.f;
#define ATT_ISSUE(t, buf) do { const size_t rb_ = ((t) == 0) ? (size_t)NX : (size_t)(b * SEQ + 64 * ((t) - 1)); const char* kg_ = Kcol + rb_ * (D * 2); const char* vg_ = Vcol + rb_ * (D * 2); const int tq_ = opaque(tid); \
        unsigned ko_, vo_; { int r_, c_; kimg_rc(tq_ * 16, r_, c_); ko_ = (unsigned)(r_ * (D * 2) + c_ * 2); vimg_rc(tq_ * 16, r_, c_); vo_ = (unsigned)(r_ * (D * 2) + c_ * 2); }     \
        _Pragma("unroll") for (int i_ = 0; i_ < 2; ++i_) glds16(kg_ + (size_t)i_ * (32 * D * 2) + ko_, Kb + (buf) * 16384 + (i_ * 8 + wid) * 1024); \
        _Pragma("unroll") for (int i_ = 0; i_ < 4; ++i_) glds16(vg_ + (size_t)i_ * (16 * D * 2) + vo_, Vb + (buf) * 32768 + (i_ * 8 + wid) * 1024); } while (0)
#define ATT_S1(KH) do { f32x16 p; \
            _Pragma("unroll") for (int r = 0; r < 16; ++r) p[r] = 0.f; \
            { const int ka = ka0 + cur * 16384 + KH * 8192; bf16x8 k0, k1, k2, k3, k4, k5, k6, k7;     \
              asm volatile("ds_read_b128 %0, %1" : "=&v"(k0) : "v"(ka) : "memory"); asm volatile("ds_read_b128 %0, %1" : "=&v"(k1) : "v"(ka ^ 32) : "memory"); \
              asm volatile("ds_read_b128 %0, %1" : "=&v"(k2) : "v"(ka ^ 64) : "memory"); asm volatile("ds_read_b128 %0, %1" : "=&v"(k3) : "v"(ka ^ 96) : "memory"); \
              asm volatile("ds_read_b128 %0, %1 offset:128" : "=&v"(k4) : "v"(ka) : "memory"); asm volatile("ds_read_b128 %0, %1 offset:128" : "=&v"(k5) : "v"(ka ^ 32) : "memory"); \
              asm volatile("ds_read_b128 %0, %1 offset:128" : "=&v"(k6) : "v"(ka ^ 64) : "memory"); asm volatile("ds_read_b128 %0, %1 offset:128" : "=&v"(k7) : "v"(ka ^ 96) : "memory"); \
              __builtin_amdgcn_s_setprio(2); asm volatile("s_waitcnt lgkmcnt(6)" ::: "memory"); SBAR(); p = __builtin_amdgcn_mfma_f32_32x32x16_bf16(k0, qr[0], p, 0, 0, 0); p = __builtin_amdgcn_mfma_f32_32x32x16_bf16(k1, qr[1], p, 0, 0, 0); SBAR(); \
              asm volatile("s_waitcnt lgkmcnt(4)" ::: "memory"); SBAR(); p = __builtin_amdgcn_mfma_f32_32x32x16_bf16(k2, qr[2], p, 0, 0, 0); p = __builtin_amdgcn_mfma_f32_32x32x16_bf16(k3, qr[3], p, 0, 0, 0); SBAR(); \
              asm volatile("s_waitcnt lgkmcnt(2)" ::: "memory"); SBAR(); p = __builtin_amdgcn_mfma_f32_32x32x16_bf16(k4, qr[4], p, 0, 0, 0); p = __builtin_amdgcn_mfma_f32_32x32x16_bf16(k5, qr[5], p, 0, 0, 0); SBAR(); \
              asm volatile("s_waitcnt lgkmcnt(0)" ::: "memory"); SBAR(); p = __builtin_amdgcn_mfma_f32_32x32x16_bf16(k6, qr[6], p, 0, 0, 0); p = __builtin_amdgcn_mfma_f32_32x32x16_bf16(k7, qr[7], p, 0, 0, 0); SBAR(); __builtin_amdgcn_s_setprio(0); } \
            _Pragma("unroll") for (int r = 0; r < 16; ++r) { const float dd = ((KH == 0 && r >= 8) ? q8 : qrel) - (float)((r & 3) + 8 * (r >> 2) + 32 * KH); p[r] = fmaf(p[r], Cq, -fabsf(dd)); } \
            float pmax = fmaxf(fmaxf(p[0], p[1]), p[2]); \
            _Pragma("unroll") for (int r = 3; r < 15; r += 2) pmax = fmaxf(fmaxf(pmax, p[r]), p[r + 1]); \
            pmax = fmaxf(pmax, p[15]); \
            { auto rr = __builtin_amdgcn_permlane32_swap(__float_as_uint(pmax), __float_as_uint(pmax), false, false); pmax = fmaxf(__uint_as_float(rr[0]), __uint_as_float(rr[1])); } \
              \
              \
            dead = __all(pmax - m_reg < DEADQ); \
            if (!dead) { float mn; \
            if (__builtin_expect(__all(pmax - m_reg <= THRQ), 1)) { mn = m_reg; alpha = 1.f; } \
            else { mn = fmaxf(m_reg, pmax); alpha = __builtin_amdgcn_exp2f((m_reg - mn) * asl); m_reg = mn; } \
            float ps = 0.f; const float nm = -mn * asl; \
            _Pragma("unroll") for (int r = 0; r < 16; ++r) { p[r] = __builtin_amdgcn_exp2f(fmaf(p[r], asl, nm)); ps += p[r]; } \
            { auto rr = __builtin_amdgcn_permlane32_swap(__float_as_uint(ps), __float_as_uint(ps), false, false); ps = __uint_as_float(rr[0]) + __uint_as_float(rr[1]); } \
            l_reg = l_reg * alpha + ps; \
            pack_p2(p, pa0, pa1); } } while (0)
#define ATT_S2(KH) do { if (!dead) { \
            if (__any(alpha < 1.f)) { if (hi == 0) al_l[r32] = alpha; LDS_WAIT(); \
                _Pragma("unroll") for (int r = 0; r < 16; ++r) { const float a = al_l[crow(r, hi)]; \
                    _Pragma("unroll") for (int d = 0; d < 8; ++d) o[d][r] *= a; } } \
            pv_half8<KH>(o, vb, pa0, pa1); } } while (0)
        int tcn = (NMETA + qb * 256 + 128 + 48) / 64; tcn = tcn < t_lo ? t_lo : (tcn > t_hi ? t_hi : tcn);
        if (t_lo == 0 && t_hi == 128) tcn = 0;
        const int nright = t_hi - tcn + 1;
#define ATT_TILE(i) (((i) < nright) ? tcn + (i) : tcn - 1 - ((i) - nright))
        ATT_ISSUE(ATT_TILE(0), 0); WAITBAR();
        if (grp == 1) BARF();
#pragma unroll 1
        for (int tt = 0; tt < ntl; ++tt) {
            const int t = ATT_TILE(tt), cur = tt & 1;
            const float qrel = qposf - (float)(t == 0 ? 0 : 64 * t - 48);
            const float q8 = (t == 0) ? 1e30f : qrel;
            const int vb = vb0 + cur * 32768;
            bf16x8 pa0, pa1; float alpha; bool dead;
            ATT_S1(0);
            BARF();
            if (tt + 1 < ntl) ATT_ISSUE(ATT_TILE(tt + 1), cur ^ 1);
            ATT_S2(0);
            BARF();
            if (t != 0) ATT_S1(1);
            asm volatile("s_waitcnt vmcnt(0)" ::: "memory");
            BARF();
            if (t != 0) ATT_S2(1);
            BARF();
        }
        if (grp == 0) BARF();
#undef ATT_ISSUE
#undef ATT_S1
#undef ATT_S2
#undef ATT_TILE
        if (hi == 0) li_l[r32] = l_reg; LDS_WAIT();
        const int hio = opaque(hi), lno = opaque(lane);
        f32x4* st4 = (f32x4*)(stash + (size_t)wid * 8192) + lno;
        if (mp == 0) {
#pragma unroll
            for (int q4 = 0; q4 < 4; ++q4) { float rl[4];
#pragma unroll
                for (int i = 0; i < 4; ++i) rl[i] = __builtin_amdgcn_rcpf(li_l[crow(4 * q4 + i, hio)]);
#pragma unroll
                for (int d = 0; d < 8; ++d) st4[(d * 4 + q4) * 64] = (f32x4){o[d][4 * q4] * rl[0], o[d][4 * q4 + 1] * rl[1], o[d][4 * q4 + 2] * rl[2], o[d][4 * q4 + 3] * rl[3]}; }
        } else {
            const int r32o = lno & 31;
            float gsc[8];
#pragma unroll
            for (int d = 0; d < 8; ++d) gsc[d] = subg[d * 32 + r32o] * 0.8f;
            lchar* tl = lds + wid * 16896;
#pragma unroll
            for (int q4 = 0; q4 < 4; ++q4) {
                f32x4 sv[8];
#pragma unroll
                for (int d = 0; d < 8; ++d) sv[d] = st4[(d * 4 + q4) * 64];
                asm volatile("" ::: "memory");
#pragma unroll
                for (int i = 0; i < 4; ++i) { const int r = 4 * q4 + i; const float rl = __builtin_amdgcn_rcpf(li_l[crow(r, hio)]) * lam; float ss = 0.f; float v[8];
#pragma unroll
                    for (int d = 0; d < 8; ++d) { v[d] = sv[d][i] - o[d][r] * rl; ss += v[d] * v[d]; }
                    ss = half_sum(ss);
                    const float rs = 1.0f / sqrtf(ss * (1.f / 256.f) + EPS);
#pragma unroll
                    for (int d = 0; d < 8; ++d) *(LAS bf16*)(tl + crow(r, hio) * 528 + (d * 32 + r32o) * 2) = (bf16)f2bf(v[d] * rs * gsc[d]); }
                asm volatile("" ::: "memory"); }
            LDS_WAIT();
            bf16* orow = Og + (size_t)(b * SEQ + qb * 256 + wid * 32 + (lno >> 5)) * D + h * 256 + (lno & 31) * 8;
#pragma unroll
            for (int i = 0; i < 16; ++i) { const lchar* sp = tl + (2 * i + (lno >> 5)) * 528 + (lno & 31) * 16; const u32x2 lo = *(const LAS u32x2*)sp, hi2 = *(const LAS u32x2*)(sp + 8);
                *(u32x4*)(orow + (size_t)(2 * i) * D) = (u32x4){lo.x, lo.y, hi2.x, hi2.y}; }
            LDS_WAIT();
        }
        BARF();
    }
}
__device__ __forceinline__ void normmax_phase(Frame& F, const bf16* Qg, const bf16* Kg, unsigned* nrm) {
    using namespace mx;
    LAS unsigned* red = (LAS unsigned*)(F.lds + 131072);
    if (F.tid < 64) red[F.tid] = 0u;
    __syncthreads();
    for (int c = F.vcu; c < 256; c += F.G) {
        const int b = c >> 7; float mq[8], mk[8];
#pragma unroll
        for (int j = 0; j < 8; ++j) { mq[j] = 0.f; mk[j] = 0.f; }
        const int nrow = (c == 0 || c == 128) ? 10 : 8;
        for (int i = 0; i < nrow; ++i) {
            const int row = (i < 8) ? c * 64 + F.wave * 8 + i : NX + F.wave * 2 + (i - 8);
#pragma unroll
            for (int j = 0; j < 8; ++j) {
                const u32x4 kv = *(const u32x4*)(Kg + (size_t)row * D + 512 * j + 8 * F.lane);
                float sk = bflo(kv.x) * bflo(kv.x) + bfhi(kv.x) * bfhi(kv.x) + bflo(kv.y) * bflo(kv.y) + bfhi(kv.y) * bfhi(kv.y) + bflo(kv.z) * bflo(kv.z) + bfhi(kv.z) * bfhi(kv.z) + bflo(kv.w) * bflo(kv.w) + bfhi(kv.w) * bfhi(kv.w);
                sk += swz_xor<1>(sk); sk += swz_xor<2>(sk); sk += swz_xor<4>(sk); sk += swz_xor<8>(sk); mk[j] = fmaxf(mk[j], sk);
                if (i < 8) { const u32x4 qv = *(const u32x4*)(Qg + (size_t)row * D + 512 * j + 8 * F.lane);
                    float sq = bflo(qv.x) * bflo(qv.x) + bfhi(qv.x) * bfhi(qv.x) + bflo(qv.y) * bflo(qv.y) + bfhi(qv.y) * bfhi(qv.y) + bflo(qv.z) * bflo(qv.z) + bfhi(qv.z) * bfhi(qv.z) + bflo(qv.w) * bflo(qv.w) + bfhi(qv.w) * bfhi(qv.w);
                    sq += swz_xor<1>(sq); sq += swz_xor<2>(sq); sq += swz_xor<4>(sq); sq += swz_xor<8>(sq); mq[j] = fmaxf(mq[j], sq); } }
        }
        if ((F.lane & 15) == 0) {
#pragma unroll
            for (int j = 0; j < 8; ++j) { const int seg = 4 * j + (F.lane >> 4); __hip_atomic_fetch_max(red + seg, __float_as_uint(mq[j]), __ATOMIC_RELAXED, __HIP_MEMORY_SCOPE_WORKGROUP); __hip_atomic_fetch_max(red + 32 + seg, __float_as_uint(mk[j]), __ATOMIC_RELAXED, __HIP_MEMORY_SCOPE_WORKGROUP); } }
        __syncthreads();
        if (F.tid < 64) { const int tsr = F.tid >> 5, seg = F.tid & 31; __hip_atomic_fetch_max(nrm + (tsr * 2 + b) * 32 + seg, red[F.tid], __ATOMIC_RELAXED, __HIP_MEMORY_SCOPE_AGENT); red[F.tid] = 0u; }
        __syncthreads();
    }
}

__device__ __forceinline__ void ret_local_unit(lchar* lds, const bf16* Kg, const bf16* Vg, bf16* ST, int b, int h, int c, float lgf2, float lgb2) {
    using namespace mx;
    const int tid = threadIdx.x, wid = __builtin_amdgcn_readfirstlane(tid >> 6), lane = tid & 63, r32 = lane & 31, hi = lane >> 5;
    __syncthreads();
    { const int tq = opaque(tid); const size_t hb = ((size_t)((b * NH + h) * SEQ + 128 * c)) * 256;
      const char* kg = (const char*)(Kg + hb); const char* vg = (const char*)(Vg + hb);
#pragma unroll
      for (int hf = 0; hf < 2; ++hf)
#pragma unroll
        for (int i = 0; i < 4; ++i) { int k, c2; vimg_rc((i * 512 + tq) * 16, k, c2); const unsigned off = (unsigned)((64 * hf + k) * 512 + c2 * 2);
            glds16(kg + off, lds + hf * 32768 + (i * 8 + wid) * 1024); glds16(vg + off, lds + 65536 + hf * 32768 + (i * 8 + wid) * 1024); } }
    WAITBAR();
    const int vbK = lds_addr(lds) + v_rd_base(lane) + wid * 512, vbV = lds_addr(lds) + 65536 + v_rd_base(lane);
#pragma unroll 1
    for (int dir = 0; dir < 2; ++dir) {
        f32x16 acc[8];
#pragma unroll
        for (int d = 0; d < 8; ++d)
#pragma unroll
            for (int r = 0; r < 16; ++r) acc[d][r] = 0.f;
        const float lg = dir == 0 ? lgf2 : lgb2;
#define RL_W(T) __builtin_amdgcn_exp2f(lg * (float)(dir == 0 ? 127 - (T) : (T)))
#define RL_STEP(HF, KS) do { const int vk_ = vbK + (HF) * 32768, vv_ = vbV + (HF) * 32768; \
            const s16x4 al = tr_read<vro(0, KS, 0)>(vk_), ah = tr_read<vro(0, KS, 1)>(vk_); \
            const s16x4 l0 = tr_read<vro(0, KS, 0)>(vv_), h0 = tr_read<vro(0, KS, 1)>(vv_), l1 = tr_read<vro(1, KS, 0)>(vv_), h1 = tr_read<vro(1, KS, 1)>(vv_), l2 = tr_read<vro(2, KS, 0)>(vv_), h2 = tr_read<vro(2, KS, 1)>(vv_), l3 = tr_read<vro(3, KS, 0)>(vv_), h3 = tr_read<vro(3, KS, 1)>(vv_); \
            const s16x4 l4 = tr_read<vro(4, KS, 0)>(vv_), h4 = tr_read<vro(4, KS, 1)>(vv_), l5 = tr_read<vro(5, KS, 0)>(vv_), h5 = tr_read<vro(5, KS, 1)>(vv_), l6 = tr_read<vro(6, KS, 0)>(vv_), h6 = tr_read<vro(6, KS, 1)>(vv_), l7 = tr_read<vro(7, KS, 0)>(vv_), h7 = tr_read<vro(7, KS, 1)>(vv_); \
            const int tb_ = 64 * (HF) + 16 * (KS) + 8 * hi; \
            const float w0 = RL_W(tb_), w1 = RL_W(tb_ + 1), w2 = RL_W(tb_ + 2), w3 = RL_W(tb_ + 3), w4 = RL_W(tb_ + 4), w5 = RL_W(tb_ + 5), w6 = RL_W(tb_ + 6), w7 = RL_W(tb_ + 7); \
            asm volatile("s_waitcnt lgkmcnt(0)" ::: "memory"); SBAR(); \
            const bf16x8 ar = MX_PK(al, ah); const u32x4 aw = *reinterpret_cast<const u32x4*>(&ar); u32x4 as_; \
            as_.x = cvtpk(bflo(aw.x) * w0, bfhi(aw.x) * w1); as_.y = cvtpk(bflo(aw.y) * w2, bfhi(aw.y) * w3); as_.z = cvtpk(bflo(aw.z) * w4, bfhi(aw.z) * w5); as_.w = cvtpk(bflo(aw.w) * w6, bfhi(aw.w) * w7); \
            const bf16x8 a = *reinterpret_cast<const bf16x8*>(&as_); \
            acc[0] = __builtin_amdgcn_mfma_f32_32x32x16_bf16(a, MX_PK(l0, h0), acc[0], 0, 0, 0); acc[1] = __builtin_amdgcn_mfma_f32_32x32x16_bf16(a, MX_PK(l1, h1), acc[1], 0, 0, 0); \
            acc[2] = __builtin_amdgcn_mfma_f32_32x32x16_bf16(a, MX_PK(l2, h2), acc[2], 0, 0, 0); acc[3] = __builtin_amdgcn_mfma_f32_32x32x16_bf16(a, MX_PK(l3, h3), acc[3], 0, 0, 0); \
            acc[4] = __builtin_amdgcn_mfma_f32_32x32x16_bf16(a, MX_PK(l4, h4), acc[4], 0, 0, 0); acc[5] = __builtin_amdgcn_mfma_f32_32x32x16_bf16(a, MX_PK(l5, h5), acc[5], 0, 0, 0); \
            acc[6] = __builtin_amdgcn_mfma_f32_32x32x16_bf16(a, MX_PK(l6, h6), acc[6], 0, 0, 0); acc[7] = __builtin_amdgcn_mfma_f32_32x32x16_bf16(a, MX_PK(l7, h7), acc[7], 0, 0, 0); } while (0)
        RL_STEP(0, 0); RL_STEP(0, 1); RL_STEP(0, 2); RL_STEP(0, 3); RL_STEP(1, 0); RL_STEP(1, 1); RL_STEP(1, 2); RL_STEP(1, 3);
#undef RL_STEP
#undef RL_W
        bf16* S = ST + ((size_t)(((b * NH + h) * 2 + dir) * 64 + c) << 16);
        const int hio = opaque(hi), r32o = opaque(r32);
#pragma unroll
        for (int r = 0; r < 16; ++r) { bf16* sp = S + (size_t)(32 * wid + crow(r, hio)) * 256 + r32o;
#pragma unroll
            for (int d = 0; d < 8; ++d) sp[d * 32] = (bf16)f2bf(acc[d][r]); }
    }
}
__device__ __forceinline__ void ret_scan(Frame& F, const bf16* Kg, const bf16* Vg, bf16* ST, const float* logdec) {
    using namespace mx;
    const int gid = F.vcu * 512 + F.tid, NT = F.G * 512, NV = 64 * 8192;
    for (int vb = gid; vb < NV; vb += 4 * NT) {
        float s[4][8], dec[4]; bf16* base[4]; int dirs[4]; bool ok[4]; u32x4 nx[4];
#pragma unroll
        for (int q = 0; q < 4; ++q) {
            const int v0 = vb + q * NT; ok[q] = v0 < NV; const int vv0 = ok[q] ? v0 : gid;
            const int seq = vv0 >> 13, e = (vv0 & 8191) * 8, dir = seq & 1, h = (seq >> 1) & 15, dk = e >> 8, dv = e & 255; dirs[q] = dir;
            const float lg2 = -expf(logdec[dir * NH + h]) * LOG2E; dec[q] = __builtin_amdgcn_exp2f(lg2 * 128.f);
#pragma unroll
            for (int j = 0; j < 8; ++j) s[q][j] = 0.f;
            if (dir == 0) {
                for (int m = 0; m < NMETA; ++m) { const float w = __builtin_amdgcn_exp2f(lg2 * (float)(15 - m)) * __uint_as_float((unsigned)Kg[(size_t)(NX + m) * D + h * 256 + dk] << 16);
                    const u32x4 vv = *(const u32x4*)(Vg + (size_t)(NX + m) * D + h * 256 + dv);
                    s[q][0] += w * bflo(vv.x); s[q][1] += w * bfhi(vv.x); s[q][2] += w * bflo(vv.y); s[q][3] += w * bfhi(vv.y); s[q][4] += w * bflo(vv.z); s[q][5] += w * bfhi(vv.z); s[q][6] += w * bflo(vv.w); s[q][7] += w * bfhi(vv.w); }
            }
            base[q] = ST + ((size_t)(seq * 64) << 16) + e;
            nx[q] = *(const u32x4*)(base[q] + ((size_t)(dir == 0 ? 0 : 63) << 16));
        }
#pragma unroll 2
        for (int st = 0; st < 64; ++st) {
            u32x4 t[4];
#pragma unroll
            for (int q = 0; q < 4; ++q) { t[q] = nx[q]; if (st + 1 < 64) nx[q] = *(const u32x4*)(base[q] + ((size_t)(dirs[q] == 0 ? st + 1 : 62 - st) << 16)); }
#pragma unroll
            for (int q = 0; q < 4; ++q) { bf16* p = base[q] + ((size_t)(dirs[q] == 0 ? st : 63 - st) << 16);
                u32x4 w; w.x = pk2(s[q][0], s[q][1]); w.y = pk2(s[q][2], s[q][3]); w.z = pk2(s[q][4], s[q][5]); w.w = pk2(s[q][6], s[q][7]);
                if (ok[q]) *(u32x4*)p = w;
                const float d = dec[q];
                s[q][0] = s[q][0] * d + bflo(t[q].x); s[q][1] = s[q][1] * d + bfhi(t[q].x); s[q][2] = s[q][2] * d + bflo(t[q].y); s[q][3] = s[q][3] * d + bfhi(t[q].y);
                s[q][4] = s[q][4] * d + bflo(t[q].z); s[q][5] = s[q][5] * d + bfhi(t[q].z); s[q][6] = s[q][6] * d + bflo(t[q].w); s[q][7] = s[q][7] * d + bfhi(t[q].w); }
        }
    }
}
struct RoUnit { int b, h, c; };
__device__ __forceinline__ RoUnit ro_unit(int id) { RoUnit u; const int bh = id >> 6; u.b = bh >> 4; u.h = bh & 15; u.c = id & 63; return u; }
__device__ __forceinline__ void ret_out_phase(lchar* lds, const bf16* Qg, const bf16* Kg, const bf16* Vg, const bf16* Gg, const bf16* ST, bf16* Og, const float* logdec, int vcu, int G) {
    using namespace mx;
    const int tid = threadIdx.x, wid = __builtin_amdgcn_readfirstlane(tid >> 6), lane = tid & 63, r32 = lane & 31, hi = lane >> 5, rb = wid & 3, dh = wid >> 2;
    LAS unsigned* offl = (LAS unsigned*)(lds + 131072);
    LAS float* ssl = (LAS float*)(lds + 147456);
    { const int tq = opaque(tid);
#pragma unroll
      for (int i = 0; i < 4; ++i) { const int P = (i * 512 + tq) * 16; int r, cc; kimg_rc(P & 16383, r, cc); cc += (P >> 14) * 128; int k, c2; vimg_rc(P, k, c2);
          offl[i * 512 + tq] = (unsigned)(r * 512 + cc * 2); offl[(4 + i) * 512 + tq] = (unsigned)(k * 512 + c2 * 2); } }
    __syncthreads();
    const int nun = (2048 - vcu + G - 1) / G;
#define RO_ISSUE(u, k, SLOT) do { const size_t hb_ = ((size_t)(((u).b * NH + (u).h) * SEQ + 128 * (u).c)) * 256; const LAS unsigned* of_ = offl + opaque(tid); \
        if ((k) < 4) { const bf16* src_ = (((k) & 1) ? Vg : Kg) + hb_ + (size_t)(64 * ((k) >> 1)) * 256; \
            _Pragma("unroll") for (int i_ = 0; i_ < 4; ++i_) glds16((const char*)src_ + of_[(((k) & 1) * 4 + i_) * 512], lds + (SLOT) * 32768 + (i_ * 8 + wid) * 1024); } \
        else { const char* src_ = (const char*)(ST + ((size_t)((((u).b * NH + (u).h) * 2 + (((k) - 4) >> 2)) * 64 + (u).c) << 16)) + (size_t)(((k) - 4) & 3) * 64 * 512; \
            _Pragma("unroll") for (int i_ = 0; i_ < 4; ++i_) glds16(src_ + of_[(4 + i_) * 512], lds + (SLOT) * 32768 + (i_ * 8 + wid) * 1024); } } while (0)
    RoUnit cu = ro_unit(vcu);
    RO_ISSUE(cu, 0, 0); RO_ISSUE(cu, 1, 1); RO_ISSUE(cu, 2, 2);
    const int ka0 = lds_addr(lds) + r32 * 256 + ((hi * 16) ^ ((r32 & 7) << 4));
    const int vb0 = lds_addr(lds) + v_rd_base(lane) + dh * 2048;
#pragma unroll 1
    for (int ui = 0; ui < nun; ++ui) {
        const bool lastu = (ui + 1 == nun); const RoUnit nu = ro_unit(vcu + (ui + 1) * G);
        const float lgf2 = -expf(logdec[cu.h]) * LOG2E, lgb2 = -expf(logdec[NH + cu.h]) * LOG2E;
        const int r0 = cu.b * SEQ + 128 * cu.c, ii = 32 * rb + r32;
        bf16x8 qr[16];
        const size_t hb = ((size_t)((cu.b * NH + cu.h) * SEQ + 128 * cu.c)) * 256;
        { const bf16* Qw = Qg + hb + (size_t)opaque(ii) * 256 + opaque(hi) * 8;
#pragma unroll
          for (int d0 = 0; d0 < 16; ++d0) qr[d0] = *(const bf16x8*)(Qw + d0 * 16); }
        f32x16 o[4]; bf16x8 pa0, pa1, pa2, pa3;
#pragma unroll
        for (int d = 0; d < 4; ++d)
#pragma unroll
            for (int r = 0; r < 16; ++r) o[d][r] = 0.f;
#define RO_OPEN(k) do { if (lastu && (k) >= 10) { if ((k) == 10) asm volatile("s_waitcnt vmcnt(4)" ::: "memory"); else asm volatile("s_waitcnt vmcnt(0)" ::: "memory"); } else asm volatile("s_waitcnt vmcnt(8)" ::: "memory"); \
        BARF(); if ((k) + 3 < 12) RO_ISSUE(cu, (k) + 3, ((k) + 3) & 3); else if (!lastu) RO_ISSUE(nu, (k) + 3 - 12, ((k) + 3) & 3); } while (0)
#define RO_QKCHAIN(P, KB, OFF) do { bf16x8 k0, k1, k2, k3, k4, k5, k6, k7; \
            asm volatile("ds_read_b128 %0, %1 offset:%2" : "=&v"(k0) : "v"(KB), "i"(OFF) : "memory"); asm volatile("ds_read_b128 %0, %1 offset:%2" : "=&v"(k1) : "v"(KB ^ 32), "i"(OFF) : "memory"); \
            asm volatile("ds_read_b128 %0, %1 offset:%2" : "=&v"(k2) : "v"(KB ^ 64), "i"(OFF) : "memory"); asm volatile("ds_read_b128 %0, %1 offset:%2" : "=&v"(k3) : "v"(KB ^ 96), "i"(OFF) : "memory"); \
            asm volatile("ds_read_b128 %0, %1 offset:%2" : "=&v"(k4) : "v"(KB), "i"(OFF + 128) : "memory"); asm volatile("ds_read_b128 %0, %1 offset:%2" : "=&v"(k5) : "v"(KB ^ 32), "i"(OFF + 128) : "memory"); \
            asm volatile("ds_read_b128 %0, %1 offset:%2" : "=&v"(k6) : "v"(KB ^ 64), "i"(OFF + 128) : "memory"); asm volatile("ds_read_b128 %0, %1 offset:%2" : "=&v"(k7) : "v"(KB ^ 96), "i"(OFF + 128) : "memory"); \
            asm volatile("s_waitcnt lgkmcnt(4)" ::: "memory"); SBAR(); \
            P = __builtin_amdgcn_mfma_f32_32x32x16_bf16(k0, qr[(OFF >= 16384 ? 8 : 0) + 0], P, 0, 0, 0); P = __builtin_amdgcn_mfma_f32_32x32x16_bf16(k1, qr[(OFF >= 16384 ? 8 : 0) + 1], P, 0, 0, 0); \
            P = __builtin_amdgcn_mfma_f32_32x32x16_bf16(k2, qr[(OFF >= 16384 ? 8 : 0) + 2], P, 0, 0, 0); P = __builtin_amdgcn_mfma_f32_32x32x16_bf16(k3, qr[(OFF >= 16384 ? 8 : 0) + 3], P, 0, 0, 0); SBAR(); \
            asm volatile("s_waitcnt lgkmcnt(0)" ::: "memory"); SBAR(); \
            P = __builtin_amdgcn_mfma_f32_32x32x16_bf16(k4, qr[(OFF >= 16384 ? 8 : 0) + 4], P, 0, 0, 0); P = __builtin_amdgcn_mfma_f32_32x32x16_bf16(k5, qr[(OFF >= 16384 ? 8 : 0) + 5], P, 0, 0, 0); \
            P = __builtin_amdgcn_mfma_f32_32x32x16_bf16(k6, qr[(OFF >= 16384 ? 8 : 0) + 6], P, 0, 0, 0); P = __builtin_amdgcn_mfma_f32_32x32x16_bf16(k7, qr[(OFF >= 16384 ? 8 : 0) + 7], P, 0, 0, 0); SBAR(); } while (0)
#define RO_SCORES(SLOT, KT) do { f32x16 p0, p1; \
            _Pragma("unroll") for (int r = 0; r < 16; ++r) { p0[r] = 0.f; p1[r] = 0.f; } \
            { const int kb_ = opaque(ka0) + (SLOT) * 32768; RO_QKCHAIN(p0, kb_, 0); RO_QKCHAIN(p0, kb_, 16384); const int kc_ = opaque(kb_) + 8192; RO_QKCHAIN(p1, kc_, 0); RO_QKCHAIN(p1, kc_, 16384); } \
            const float df = (float)(opaque(ii) - 64 * (KT) - 4 * opaque(hi)); \
            _Pragma("unroll") for (int r = 0; r < 16; ++r) { const float d0_ = df - (float)((r & 3) + 8 * (r >> 2)), d1_ = d0_ - 32.f; \
                p0[r] *= __builtin_amdgcn_exp2f(d0_ >= 0.f ? lgf2 * d0_ : -lgb2 * d0_); p1[r] *= __builtin_amdgcn_exp2f(d1_ >= 0.f ? lgf2 * d1_ : -lgb2 * d1_); } \
            pack_p(p0, p1, pa0, pa1, pa2, pa3); } while (0)
#define RO_BRD(D0, L0, H0, L1, H1, L2, H2, L3, H3) const s16x4 L0 = tr_read<vro(D0, 0, 0)>(vb_), H0 = tr_read<vro(D0, 0, 1)>(vb_), L1 = tr_read<vro(D0, 1, 0)>(vb_), H1 = tr_read<vro(D0, 1, 1)>(vb_), \
            L2 = tr_read<vro(D0, 2, 0)>(vb_), H2 = tr_read<vro(D0, 2, 1)>(vb_), L3 = tr_read<vro(D0, 3, 0)>(vb_), H3 = tr_read<vro(D0, 3, 1)>(vb_)
#define RO_BMM(ACC, A0, A1, A2, A3, L0, H0, L1, H1, L2, H2, L3, H3) do { ACC = __builtin_amdgcn_mfma_f32_32x32x16_bf16(A0, MX_PK(L0, H0), ACC, 0, 0, 0); ACC = __builtin_amdgcn_mfma_f32_32x32x16_bf16(A1, MX_PK(L1, H1), ACC, 0, 0, 0); \
            ACC = __builtin_amdgcn_mfma_f32_32x32x16_bf16(A2, MX_PK(L2, H2), ACC, 0, 0, 0); ACC = __builtin_amdgcn_mfma_f32_32x32x16_bf16(A3, MX_PK(L3, H3), ACC, 0, 0, 0); } while (0)
#define RO_MUL(ACC, SLOT, A0, A1, A2, A3) do { const int vb_ = opaque(vb0) + (SLOT) * 32768; \
            RO_BRD(0, a_l0, a_h0, a_l1, a_h1, a_l2, a_h2, a_l3, a_h3); RO_BRD(1, b_l0, b_h0, b_l1, b_h1, b_l2, b_h2, b_l3, b_h3); \
            asm volatile("s_waitcnt lgkmcnt(8)" ::: "memory"); SBAR(); RO_BMM(ACC[0], A0, A1, A2, A3, a_l0, a_h0, a_l1, a_h1, a_l2, a_h2, a_l3, a_h3); SBAR(); \
            RO_BRD(2, c_l0, c_h0, c_l1, c_h1, c_l2, c_h2, c_l3, c_h3); \
            asm volatile("s_waitcnt lgkmcnt(8)" ::: "memory"); SBAR(); RO_BMM(ACC[1], A0, A1, A2, A3, b_l0, b_h0, b_l1, b_h1, b_l2, b_h2, b_l3, b_h3); SBAR(); \
            RO_BRD(3, d_l0, d_h0, d_l1, d_h1, d_l2, d_h2, d_l3, d_h3); \
            asm volatile("s_waitcnt lgkmcnt(8)" ::: "memory"); SBAR(); RO_BMM(ACC[2], A0, A1, A2, A3, c_l0, c_h0, c_l1, c_h1, c_l2, c_h2, c_l3, c_h3); SBAR(); \
            asm volatile("s_waitcnt lgkmcnt(0)" ::: "memory"); SBAR(); RO_BMM(ACC[3], A0, A1, A2, A3, d_l0, d_h0, d_l1, d_h1, d_l2, d_h2, d_l3, d_h3); } while (0)
#define RO_QSC(DST, SRC, F) do { const u32x4 w_ = *reinterpret_cast<const u32x4*>(&(SRC)); u32x4 x_; x_.x = cvtpk(bflo(w_.x) * (F), bfhi(w_.x) * (F)); x_.y = cvtpk(bflo(w_.y) * (F), bfhi(w_.y) * (F)); \
            x_.z = cvtpk(bflo(w_.z) * (F), bfhi(w_.z) * (F)); x_.w = cvtpk(bflo(w_.w) * (F), bfhi(w_.w) * (F)); DST = *reinterpret_cast<bf16x8*>(&x_); } while (0)
#define RO_STATE(SLOT, DT, F) do { bf16x8 q0_, q1_, q2_, q3_; RO_QSC(q0_, qr[4 * (DT)], F); RO_QSC(q1_, qr[4 * (DT) + 1], F); RO_QSC(q2_, qr[4 * (DT) + 2], F); RO_QSC(q3_, qr[4 * (DT) + 3], F); RO_MUL(o, SLOT, q0_, q1_, q2_, q3_); } while (0)
        RO_OPEN(0); RO_SCORES(0, 0);
        RO_OPEN(1); RO_MUL(o, 1, pa0, pa1, pa2, pa3);
        RO_OPEN(2); RO_SCORES(2, 1);
        RO_OPEN(3); RO_MUL(o, 3, pa0, pa1, pa2, pa3);
        { const float ff = __builtin_amdgcn_exp2f(lgf2 * (float)(opaque(ii) + 1));
          RO_OPEN(4); RO_STATE(0, 0, ff);
          RO_OPEN(5); RO_STATE(1, 1, ff);
          RO_OPEN(6); RO_STATE(2, 2, ff);
          RO_OPEN(7); RO_STATE(3, 3, ff); }
        { const float fb = __builtin_amdgcn_exp2f(lgb2 * (float)(128 - opaque(ii)));
          RO_OPEN(8); RO_STATE(0, 0, fb);
          RO_OPEN(9); RO_STATE(1, 1, fb);
          RO_OPEN(10); RO_STATE(2, 2, fb);
          RO_OPEN(11); RO_STATE(3, 3, fb); }
        { const int hio = opaque(hi), r32o = opaque(r32);
#pragma unroll
          for (int r = 0; r < 16; ++r) { float ss = 0.f;
#pragma unroll
              for (int d = 0; d < 4; ++d) ss += o[d][r] * o[d][r];
              ss = half_sum(ss);
              if (r32 == 0) ssl[(rb * 2 + dh) * 32 + crow(r, hio)] = ss; }
          LDS_WAIT(); BARF();
#pragma unroll
          for (int r = 0; r < 16; ++r) { const int rw = crow(r, hio); const float tot = ssl[(rb * 2) * 32 + rw] + ssl[(rb * 2 + 1) * 32 + rw]; const float rs = 1.0f / sqrtf(tot * (1.f / 256.f) + EPS);
              const size_t gi = hb + (size_t)(32 * rb + rw) * 256 + 128 * dh + r32o, go = (size_t)(r0 + 32 * rb + rw) * D + cu.h * 256 + 128 * dh + r32o;
#pragma unroll
              for (int d = 0; d < 4; ++d) { const float g = __uint_as_float((unsigned)Gg[gi + d * 32] << 16); Og[go + d * 32] = (bf16)f2bf(o[d][r] * rs * g); } }
          asm volatile("s_waitcnt vmcnt(0) lgkmcnt(0)" ::: "memory"); BARF(); }
        cu = nu;
    }
#undef RO_ISSUE
#undef RO_OPEN
#undef RO_QKCHAIN
#undef RO_SCORES
#undef RO_BRD
#undef RO_BMM
#undef RO_MUL
#undef RO_QSC
#undef RO_STATE
}

#ifndef MK_N_LAUNCHES
#define MK_N_LAUNCHES 1
#endif
#ifndef WGM_P1
#define WGM_P1 4
#endif
#ifndef WGM_SQ
#define WGM_SQ 4
#endif
#ifndef WGM_P9
#define WGM_P9 4
#endif
#ifndef WGM_P10
#define WGM_P10 4
#endif
constexpr int NPH = 12;
struct Args { const float* in[15]; float* out; unsigned char* ws; int ph_lo, ph_hi, flags, pad; };
__global__ void __launch_bounds__(NWAVES * 64, 2) fwd(Args args) {
    extern __shared__ __attribute__((aligned(16))) unsigned char lds_raw[];
    Frame F;
    F.lds = (lchar*)lds_raw; F.MISC = (volatile LAS unsigned*)(F.lds + MISC_OFF);
    F.tid = threadIdx.x; F.lane = F.tid & 63; F.wave = __builtin_amdgcn_readfirstlane(F.tid >> 6);
    F.G = gridDim.x; { const int bx = blockIdx.x; F.vcu = (F.G % 8 == 0) ? (bx % 8) * (F.G / 8) + bx / 8 : bx; }
    F.ws = args.ws; F.ctl = (unsigned*)(args.ws + WS_CTL); F.out = args.out;
#pragma unroll
    for (int i = 0; i < 15; ++i) F.in[i] = args.in[i];
    if (F.tid < 64) ((LAS unsigned*)(F.lds + MISC_OFF))[F.tid] = 0u;
    __syncthreads();
    const int lo = args.ph_lo, hi = args.ph_hi;
    XcdBarrier bar; bar.bar = F.ctl + CW_BAR; bar.x = 0; bar.st = nullptr;
    if (hi - lo > 1) bar = xcd_barrier_post(F.ctl + CW_BAR, F.MISC + 8);
#ifndef PH_MASK
#define PH_MASK 0xFFF
#endif
#define IN(k) (((PH_MASK >> (k)) & 1) && lo <= (k) && (k) < hi)
#define SEAM(k) do { if (IN(k) && IN((k) + 1)) xcd_barrier(bar); } while (0)
    bf16* WIN = (bf16*)(F.ws + WS_WIN); bf16* WBR = (bf16*)(F.ws + WS_WBR); bf16* WBD = (bf16*)(F.ws + WS_WBD); bf16* WO = (bf16*)(F.ws + WS_WO); bf16* WGU = (bf16*)(F.ws + WS_WGU); bf16* WDN = (bf16*)(F.ws + WS_WDN);
    bf16* U = (bf16*)(F.ws + WS_U); bf16* PROJ = (bf16*)(F.ws + WS_PROJ); bf16* ST = (bf16*)(F.ws + WS_ST);
    bf16* MIXED = (bf16*)(F.ws + WS_MIXED); bf16* U2 = (bf16*)(F.ws + WS_U2); bf16* ACT = (bf16*)(F.ws + WS_ACT);
    bf16* G_RQ = PROJ, *G_RK = PROJ + GS, *G_RV = PROJ + 2 * GS, *G_RG = PROJ + 3 * GS, *G_DQ = PROJ + 4 * GS, *G_DK = PROJ + 5 * GS, *G_DV = PROJ + 6 * GS, *G_GA = PROJ + 7 * GS, *G_GB = PROJ + 8 * GS;

    if (IN(0)) { p0_prologue(F); __syncthreads(); }
    SEAM(0);
    if (IN(1)) { pg8::Gemm g{U, WIN, NX, DIN, D}; pg8::StaticOrder S; S.init(NX, DIN, F.G, (int)blockIdx.x, WGM_P1);
        pg8::EpiProj E{PROJ, GS};
        pg8::gemm_phase<pg8::EpiProj, pg8::StaticOrder, true, true>((PG8_LAS unsigned char*)F.lds, g, S, E);
        __syncthreads();
        meta_proj(F.lds, U, WIN, PROJ, F.vcu, F.G); }
    SEAM(1);
    if (IN(2)) {
        normmax_phase(F, G_DQ, G_DK, F.ctl + CW_NRM);
        for (int id = F.vcu; id < 2048; id += F.G) { const int bh = id >> 6, c = id & 63, h = bh & 15;
            const float lgf2 = -expf(F.in[4][h]) * LOG2E, lgb2 = -expf(F.in[4][NH + h]) * LOG2E;
            ret_local_unit(F.lds, G_RK, G_RV, ST, bh >> 4, h, c, lgf2, lgb2); }
    }
    SEAM(2);
    if (IN(3)) ret_scan(F, G_RK, G_RV, ST, F.in[4]);
    SEAM(3);
    if (IN(4)) {
        float lam; { const float* lp = F.in[5]; const float a = wave_sum(lp[F.lane] * lp[128 + F.lane] + lp[64 + F.lane] * lp[192 + F.lane]), c = wave_sum(lp[256 + F.lane] * lp[384 + F.lane] + lp[320 + F.lane] * lp[448 + F.lane]);
            lam = expf(a) - expf(c) + 0.2f; }
        float* stash = F.out + (size_t)blockIdx.x * 65536;
        for (int id = F.vcu; id < 1024; id += F.G) { const int bh = id >> 5, b = bh >> 4, hh = bh & 15, px = hh & 7, xp = (b == 0) ? px : (int)((0x32017645u >> (4 * px)) & 7u), h = (hh < 8) ? xp : 15 - xp, qb = ((id & 31) + 16 * b) & 31;
            attn_unit(F.lds, G_DQ, G_DK, G_DV, G_DQ, stash, F.in[6], F.ctl + CW_NRM, b, h, qb, lam); }
    }
    SEAM(4);
    if (IN(5)) ret_out_phase(F.lds, G_RQ, G_RK, G_RV, G_RG, ST, (bf16*)(F.ws + WS_YR), F.in[4], F.vcu, F.G);
    SEAM(5);
    if (IN(6)) { pg8::Gemm g{(const bf16*)(F.ws + WS_YR), WBR, NX, D, D}, g2{G_DQ, WBD, NX, D, D}; pg8::StaticOrder S; S.init(NX, D, F.G, (int)blockIdx.x, WGM_SQ); pg8::EpiMix2 E{G_GA, G_GB, MIXED};
        pg8::gemm_phase2<pg8::EpiMix2, pg8::StaticOrder, true, true>((PG8_LAS unsigned char*)F.lds, g, g2, S, E); }
    SEAM(6);
    if (IN(7)) { pg8::Gemm g{MIXED, WO, NX, D, D}; pg8::StaticOrder S; S.init(NX, D, F.G, (int)blockIdx.x, WGM_SQ); pg8::EpiResBf E{F.in[0], U2, (float*)(F.ws + WS_PS)};
        pg8::gemm_phase<pg8::EpiResBf, pg8::StaticOrder, true, true>((PG8_LAS unsigned char*)F.lds, g, S, E); }
    SEAM(7);
    if (IN(8)) { const float* PS = (const float*)(F.ws + WS_PS); float* RS = (float*)(F.ws + WS_RSTD);
        for (int row = F.vcu * 512 + F.tid; row < NX; row += F.G * 512) { const pg8::f32x4* p = (const pg8::f32x4*)(PS + (size_t)row * 64); float s = 0.f;
#pragma unroll
            for (int j = 0; j < 16; ++j) { const pg8::f32x4 v = p[j]; s += (v[0] + v[1]) + (v[2] + v[3]); }
            RS[row] = 1.0f / sqrtf(s * (1.f / D) + EPS); } }
    SEAM(8);
    if (IN(9)) { pg8::Gemm g{U2, WGU, NX, 2 * DFF, D}; pg8::StaticOrder S; S.init(NX, 2 * DFF, F.G, (int)blockIdx.x, WGM_P9); pg8::EpiSwiGLUr E{ACT, DFF, (const float*)(F.ws + WS_RSTD)};
        pg8::gemm_phase<pg8::EpiSwiGLUr, pg8::StaticOrder, true, true>((PG8_LAS unsigned char*)F.lds, g, S, E); }
    SEAM(9);
    if (IN(10)) { pg8::Gemm g{ACT, WDN, NX, D, DFF}; pg8::StaticOrder S; S.init(NX, D, F.G, (int)blockIdx.x, WGM_P10); pg8::EpiResBf2 E{U2, (bf16*)(F.ws + WS_H2)};
        pg8::gemm_phase<pg8::EpiResBf2, pg8::StaticOrder, true, true>((PG8_LAS unsigned char*)F.lds, g, S, E); }
    SEAM(10);
    if (IN(11)) { const int gw = F.vcu * NWAVES + F.wave, NGW = F.G * NWAVES; const bf16* H2 = (const bf16*)(F.ws + WS_H2);
        for (int m = gw; m < NX; m += NGW) rms_row_bf(H2 + (size_t)m * D, F.in[14], F.out + (size_t)m * D, F.lane); }
#undef IN
#undef SEAM
}

extern "C" void kernel_launch(void* const* d_in, const int* in_sizes, int n_in, void* d_out, int out_size, void* d_ws, size_t ws_size, hipStream_t stream) {
    static int grid = 0;
    if (grid == 0) {
        if (n_in != 15 || in_sizes[0] != NX * D || out_size != NX * D || ws_size < WS_END) { fprintf(stderr, "kernel_launch: unexpected shapes (n_in %d, in0 %d, out %d, ws %zu)\n", n_in, n_in > 0 ? in_sizes[0] : -1, out_size, ws_size); grid = -1; return; }
        int dev = 0, cus = 0, per_cu = 0;
        if (hipGetDevice(&dev) != hipSuccess || hipDeviceGetAttribute(&cus, hipDeviceAttributeMultiprocessorCount, dev) != hipSuccess) { grid = -1; return; }
        if (hipFuncSetAttribute((const void*)fwd, hipFuncAttributeMaxDynamicSharedMemorySize, LDS_BYTES) != hipSuccess) { fprintf(stderr, "kernel_launch: hipFuncSetAttribute failed\n"); grid = -1; return; }
        if (hipOccupancyMaxActiveBlocksPerMultiprocessor(&per_cu, (const void*)fwd, NWAVES * 64, LDS_BYTES) != hipSuccess || per_cu < 1) fprintf(stderr, "kernel_launch: occupancy query reports %d\n", per_cu);
        (void)hipGetLastError();
        grid = cus;
    }
    if (grid < 0) return;
    if (hipMemsetAsync((char*)d_ws + WS_CTL, 0, CTL_ZERO_BYTES, stream) != hipSuccess) return;
    Args a{};
    for (int i = 0; i < 15; ++i) a.in[i] = (const float*)d_in[i];
    a.out = (float*)d_out; a.ws = (unsigned char*)d_ws;
#if MK_N_LAUNCHES == 1
    a.ph_lo = 0; a.ph_hi = NPH;
    hipLaunchKernelGGL(fwd, dim3(grid), dim3(NWAVES * 64), LDS_BYTES, stream, a);
#else
    for (int p = 0; p < NPH; ++p) { a.ph_lo = p; a.ph_hi = p + 1;
        hipLaunchKernelGGL(fwd, dim3(grid), dim3(NWAVES * 64), LDS_BYTES, stream, a); }
#endif
    const hipError_t le = hipPeekAtLastError();
    if (le != hipSuccess) fprintf(stderr, "kernel_launch: launch failed: %s\n", hipGetErrorName(le));
}
```

```cpp
#include <hip/hip_runtime.h>
#include <cstdio>
#include <cstdint>
#define LAS __attribute__((address_space(3)))
namespace pg8 {
#define PG8_LAS __attribute__((address_space(3)))
typedef unsigned short bf16_t;
typedef short bf16x8 __attribute__((ext_vector_type(8)));
typedef float f32x4 __attribute__((ext_vector_type(4)));
typedef unsigned u32x4 __attribute__((ext_vector_type(4)));
constexpr int BM = 256, BK = 64, HALF = 128, HTB = HALF * BK * 2  , STAGE_BYTES = 8 * HTB, NXCD = 8, WGM = 8;

__host__ __device__ __forceinline__ int lds_byte(int r, int c) { const int st = (r >> 4) * 2 + (c >> 5), rr = r & 15, cc = c & 31, ob = rr * 64 + cc * 2; return st * 1024 + (ob ^ (((ob >> 9) & 1) << 5)); }
__host__ __device__ __forceinline__ void stage_rc(int b, int& R, int& C) { const int st = b / 1024, sb = b % 1024, swz = sb ^ (((sb >> 9) & 1) << 5); R = (st >> 1) * 16 + swz / 64; C = (st & 1) * 32 + (swz % 64) / 2; }
__host__ __device__ __forceinline__ int perm32(int rho) { const int n = rho >> 4, i = rho & 15; return 8 * (i >> 2) + 4 * n + (i & 3); }

struct Unit { int pm, pn; };
struct Gemm { const bf16_t* A; const bf16_t* Bt; int M, N, K; };

struct StaticOrder {
    int nM, nN, nwg, G, c, wgm = WGM;
    __host__ __device__ void init(int M, int N, int G_, int c_, int wgm_ = WGM) { nM = M / BM; nN = N / BM; nwg = nM * nN; G = G_; c = c_; wgm = wgm_; }
    __host__ __device__ bool next(int i, Unit& u) const {
        const long L = (long)i * G + c; if (L >= nwg) return false;
        int wgid = (int)L; { const int q = nwg / NXCD, r = nwg % NXCD, xcd = wgid % NXCD, off = wgid / NXCD; wgid = (xcd < r ? xcd * (q + 1) : r * (q + 1) + (xcd - r) * q) + off; }
        const int nig = wgm * nN, gid = wgid / nig, fm = gid * wgm, gsz = (nM - fm) < wgm ? (nM - fm) : wgm;
        u.pm = fm + ((wgid % nig) % gsz); u.pn = (wgid % nig) / gsz; return true;
    }
    __device__ __forceinline__ void a_ready(const Unit&) const {}
    __device__ __forceinline__ void done(const Unit&) const {}
};

__device__ __forceinline__ unsigned cvt_pk_bf16(float lo, float hi) { unsigned r; asm volatile("v_cvt_pk_bf16_f32 %0, %1, %2" : "=v"(r) : "v"(lo), "v"(hi)); return r; }
typedef float f32x2 __attribute__((ext_vector_type(2)));
__device__ __forceinline__ float sigmoid_f(float x) { return __builtin_amdgcn_rcpf(1.0f + __builtin_amdgcn_exp2f(-1.4426950408889634f * x)); }
__device__ __forceinline__ float silu_f(float x) { return x * sigmoid_f(x); }
__device__ __forceinline__ float bf_lo(unsigned w) { return __uint_as_float(w << 16); }
__device__ __forceinline__ float bf_hi(unsigned w) { return __uint_as_float(w & 0xffff0000u); }

struct EpiProj {
    static constexpr bool PERM = true, AFTER_DRAIN = false;
    bf16_t* P; size_t gstride;
    __device__ __forceinline__ void operator()(const f32x4 (&acc)[2][2][4][2], const Unit& u, int wr, int wc, int fr, int fq) const {
        const int t = (u.pn * BM) >> 12, colt = (u.pn * BM) & 4095;
        bf16_t* base = P + (size_t)t * gstride;
        const int mode = (t == 1) ? 1 : (t == 3) ? 2 : (t >= 7) ? 3 : 0;
        const bool hm = t < 4; const int pitch = hm ? 256 : 4096;
        const size_t org = hm ? ((size_t)(((u.pm >> 5) * 16 + (colt >> 8)) * 8192 + (u.pm & 31) * 256) * 256) : ((size_t)(u.pm * BM) * 4096 + colt);
        const int rloc = wr * 64 + fr, col0 = wc * 32 + 8 * fq;
#pragma unroll
        for (int ai = 0; ai < 2; ++ai)
#pragma unroll
            for (int m = 0; m < 4; ++m) { bf16_t* rowp = base + org + (size_t)(rloc + ai * HALF + m * 16) * pitch + col0;
#pragma unroll
                for (int bj = 0; bj < 2; ++bj) { f32x4 v0 = acc[ai][bj][m][0], v1 = acc[ai][bj][m][1];
                    if (mode == 1) { v0 = v0 * 0.0625f; v1 = v1 * 0.0625f; }
                    else if (mode == 2) {
#pragma unroll
                        for (int j = 0; j < 4; ++j) { v0[j] = silu_f(v0[j]); v1[j] = silu_f(v1[j]); } }
                    else if (mode == 3) {
#pragma unroll
                        for (int j = 0; j < 4; ++j) { v0[j] = sigmoid_f(v0[j]); v1[j] = sigmoid_f(v1[j]); } }
                    u32x4 w; w.x = cvt_pk_bf16(v0[0], v0[1]); w.y = cvt_pk_bf16(v0[2], v0[3]); w.z = cvt_pk_bf16(v1[0], v1[1]); w.w = cvt_pk_bf16(v1[2], v1[3]);
                    *(u32x4*)(rowp + bj * HALF) = w; } }
    }
};
struct EpiGateT {
    static constexpr bool PERM = true, AFTER_DRAIN = false;
    const bf16_t* G; float* T;
    __device__ __forceinline__ void operator()(const f32x4 (&acc)[2][2][4][2], const Unit& u, int wr, int wc, int fr, int fq) const {
        const int row0 = u.pm * BM + wr * 64 + fr, col0 = u.pn * BM + wc * 32 + 8 * fq;
#pragma unroll
        for (int ai = 0; ai < 2; ++ai)
#pragma unroll
            for (int m = 0; m < 4; ++m) { const size_t off = (size_t)(row0 + ai * HALF + m * 16) * 4096 + col0;
#pragma unroll
                for (int bj = 0; bj < 2; ++bj) { const u32x4 g = *(const u32x4*)(G + off + bj * HALF);
                    const f32x4 g0 = {bf_lo(g.x), bf_hi(g.x), bf_lo(g.y), bf_hi(g.y)}, g1 = {bf_lo(g.z), bf_hi(g.z), bf_lo(g.w), bf_hi(g.w)};
                    *(f32x4*)(T + off + bj * HALF) = acc[ai][bj][m][0] * g0; *(f32x4*)(T + off + bj * HALF + 4) = acc[ai][bj][m][1] * g1; } }
    }
};
struct EpiMix {
    static constexpr bool PERM = true, AFTER_DRAIN = false;
    const bf16_t* G; const float* T; bf16_t* O;
    __device__ __forceinline__ void operator()(const f32x4 (&acc)[2][2][4][2], const Unit& u, int wr, int wc, int fr, int fq) const {
        const int row0 = u.pm * BM + wr * 64 + fr, col0 = u.pn * BM + wc * 32 + 8 * fq;
#pragma unroll
        for (int ai = 0; ai < 2; ++ai)
#pragma unroll
            for (int m = 0; m < 4; ++m) { const size_t off = (size_t)(row0 + ai * HALF + m * 16) * 4096 + col0;
#pragma unroll
                for (int bj = 0; bj < 2; ++bj) { const u32x4 g = *(const u32x4*)(G + off + bj * HALF);
                    const f32x4 g0 = {bf_lo(g.x), bf_hi(g.x), bf_lo(g.y), bf_hi(g.y)}, g1 = {bf_lo(g.z), bf_hi(g.z), bf_lo(g.w), bf_hi(g.w)};
                    const f32x4 t0 = *(const f32x4*)(T + off + bj * HALF), t1 = *(const f32x4*)(T + off + bj * HALF + 4);
                    const f32x4 v0 = t0 + acc[ai][bj][m][0] * g0, v1 = t1 + acc[ai][bj][m][1] * g1;
                    u32x4 w; w.x = cvt_pk_bf16(v0[0], v0[1]); w.y = cvt_pk_bf16(v0[2], v0[3]); w.z = cvt_pk_bf16(v1[0], v1[1]); w.w = cvt_pk_bf16(v1[2], v1[3]);
                    *(u32x4*)(O + off + bj * HALF) = w; } }
    }
};
struct EpiRes {
    static constexpr bool PERM = false, AFTER_DRAIN = false;
    const float* R; float* C; int ldc;
    __device__ __forceinline__ void operator()(const f32x4 (&acc)[2][2][4][2], const Unit& u, int wr, int wc, int fr, int fq) const {
        const int row0 = u.pm * BM + wr * 64 + fr, col0 = u.pn * BM + wc * 32 + 4 * fq;
#pragma unroll
        for (int ai = 0; ai < 2; ++ai)
#pragma unroll
            for (int m = 0; m < 4; ++m) { const size_t off = (size_t)(row0 + ai * HALF + m * 16) * ldc + col0;
#pragma unroll
                for (int bj = 0; bj < 2; ++bj)
#pragma unroll
                    for (int n = 0; n < 2; ++n) { const f32x4 r = *(const f32x4*)(R + off + bj * HALF + n * 16); *(f32x4*)(C + off + bj * HALF + n * 16) = r + acc[ai][bj][m][n]; } }
    }
};
struct EpiSwiGLU {
    static constexpr bool PERM = true, AFTER_DRAIN = false;
    bf16_t* O; int ldc;
    __device__ __forceinline__ void operator()(const f32x4 (&acc)[2][2][4][2], const Unit& u, int wr, int wc, int fr, int fq) const {
        const int row0 = u.pm * BM + wr * 64 + fr, col0 = u.pn * HALF + wc * 32 + 8 * fq;
#pragma unroll
        for (int ai = 0; ai < 2; ++ai)
#pragma unroll
            for (int m = 0; m < 4; ++m) { bf16_t* rowp = O + (size_t)(row0 + ai * HALF + m * 16) * ldc + col0;
                f32x4 v0, v1;
#pragma unroll
                for (int j = 0; j < 4; ++j) { v0[j] = silu_f(acc[ai][0][m][0][j]) * acc[ai][1][m][0][j]; v1[j] = silu_f(acc[ai][0][m][1][j]) * acc[ai][1][m][1][j]; }
                u32x4 w; w.x = cvt_pk_bf16(v0[0], v0[1]); w.y = cvt_pk_bf16(v0[2], v0[3]); w.z = cvt_pk_bf16(v1[0], v1[1]); w.w = cvt_pk_bf16(v1[2], v1[3]);
                *(u32x4*)rowp = w; }
    }
};

#define GBC(x) fmaxf((x), 7.888609e-31f)
#define GBR(x) __builtin_amdgcn_rcpf(GBC(x))
struct EpiMix2 {
    static constexpr bool PERM = true, AFTER_DRAIN = false;
    const bf16_t* GA; const bf16_t* GB; bf16_t* O;
    __device__ __forceinline__ void mid(f32x4 (&acc)[2][2][4][2], const Unit& u, int wr, int wc, int fr, int fq) const {
        const int row0 = u.pm * BM + wr * 64 + fr, col0 = u.pn * BM + wc * 32 + 8 * fq;
#pragma unroll
        for (int ai = 0; ai < 2; ++ai)
#pragma unroll
            for (int m = 0; m < 4; ++m) { const size_t off = (size_t)(row0 + ai * HALF + m * 16) * 4096 + col0;
#pragma unroll
                for (int bj = 0; bj < 2; ++bj) { const u32x4 a = *(const u32x4*)(GA + off + bj * HALF), b = *(const u32x4*)(GB + off + bj * HALF);
                    const f32x4 r0 = {bf_lo(a.x) * GBR(bf_lo(b.x)), bf_hi(a.x) * GBR(bf_hi(b.x)), bf_lo(a.y) * GBR(bf_lo(b.y)), bf_hi(a.y) * GBR(bf_hi(b.y))};
                    const f32x4 r1 = {bf_lo(a.z) * GBR(bf_lo(b.z)), bf_hi(a.z) * GBR(bf_hi(b.z)), bf_lo(a.w) * GBR(bf_lo(b.w)), bf_hi(a.w) * GBR(bf_hi(b.w))};
                    acc[ai][bj][m][0] = acc[ai][bj][m][0] * r0; acc[ai][bj][m][1] = acc[ai][bj][m][1] * r1; } }
    }
    __device__ __forceinline__ void operator()(const f32x4 (&acc)[2][2][4][2], const Unit& u, int wr, int wc, int fr, int fq) const {
        const int row0 = u.pm * BM + wr * 64 + fr, col0 = u.pn * BM + wc * 32 + 8 * fq;
#pragma unroll
        for (int ai = 0; ai < 2; ++ai)
#pragma unroll
            for (int m = 0; m < 4; ++m) { const size_t off = (size_t)(row0 + ai * HALF + m * 16) * 4096 + col0;
#pragma unroll
                for (int bj = 0; bj < 2; ++bj) { const u32x4 g = *(const u32x4*)(GB + off + bj * HALF);
                    const f32x4 g0 = {GBC(bf_lo(g.x)), GBC(bf_hi(g.x)), GBC(bf_lo(g.y)), GBC(bf_hi(g.y))}, g1 = {GBC(bf_lo(g.z)), GBC(bf_hi(g.z)), GBC(bf_lo(g.w)), GBC(bf_hi(g.w))};
                    const f32x4 v0 = acc[ai][bj][m][0] * g0, v1 = acc[ai][bj][m][1] * g1;
                    u32x4 w; w.x = cvt_pk_bf16(v0[0], v0[1]); w.y = cvt_pk_bf16(v0[2], v0[3]); w.z = cvt_pk_bf16(v1[0], v1[1]); w.w = cvt_pk_bf16(v1[2], v1[3]);
                    *(u32x4*)(O + off + bj * HALF) = w; } }
    }
};
#undef GBC
#undef GBR

struct EpiResBf {
    static constexpr bool PERM = true, AFTER_DRAIN = false;
    const float* X; bf16_t* O; float* PS;
    __device__ __forceinline__ void operator()(const f32x4 (&acc)[2][2][4][2], const Unit& u, int wr, int wc, int fr, int fq) const {
        const int row0 = u.pm * BM + wr * 64 + fr, col0 = u.pn * BM + wc * 32 + 8 * fq;
#pragma unroll
        for (int ai = 0; ai < 2; ++ai)
#pragma unroll
            for (int m = 0; m < 4; ++m) { const int row = row0 + ai * HALF + m * 16; const size_t off = (size_t)row * 4096 + col0; float ss = 0.f;
#pragma unroll
                for (int bj = 0; bj < 2; ++bj) { const f32x4 x0 = *(const f32x4*)(X + off + bj * HALF), x1 = *(const f32x4*)(X + off + bj * HALF + 4);
                    const f32x4 v0 = x0 + acc[ai][bj][m][0], v1 = x1 + acc[ai][bj][m][1];
                    ss += (v0[0] * v0[0] + v0[1] * v0[1]) + (v0[2] * v0[2] + v0[3] * v0[3]) + (v1[0] * v1[0] + v1[1] * v1[1]) + (v1[2] * v1[2] + v1[3] * v1[3]);
                    u32x4 w; w.x = cvt_pk_bf16(v0[0], v0[1]); w.y = cvt_pk_bf16(v0[2], v0[3]); w.z = cvt_pk_bf16(v1[0], v1[1]); w.w = cvt_pk_bf16(v1[2], v1[3]);
                    *(u32x4*)(O + off + bj * HALF) = w; }
                ss += __shfl_xor(ss, 16); ss += __shfl_xor(ss, 32);
                if (fq == 0) PS[(size_t)row * 64 + u.pn * 4 + wc] = ss; }
    }
};
struct EpiSwiGLUr {
    static constexpr bool PERM = true, AFTER_DRAIN = false;
    bf16_t* O; int ldc; const float* RSTD;
    __device__ __forceinline__ void operator()(const f32x4 (&acc)[2][2][4][2], const Unit& u, int wr, int wc, int fr, int fq) const {
        const int row0 = u.pm * BM + wr * 64 + fr, col0 = u.pn * HALF + wc * 32 + 8 * fq;
#pragma unroll
        for (int ai = 0; ai < 2; ++ai)
#pragma unroll
            for (int m = 0; m < 4; ++m) { const int row = row0 + ai * HALF + m * 16; bf16_t* rowp = O + (size_t)row * ldc + col0; const float r = RSTD[row];
                f32x4 v0, v1;
#pragma unroll
                for (int j = 0; j < 4; ++j) { v0[j] = silu_f(acc[ai][0][m][0][j] * r) * (acc[ai][1][m][0][j] * r); v1[j] = silu_f(acc[ai][0][m][1][j] * r) * (acc[ai][1][m][1][j] * r); }
                u32x4 w; w.x = cvt_pk_bf16(v0[0], v0[1]); w.y = cvt_pk_bf16(v0[2], v0[3]); w.z = cvt_pk_bf16(v1[0], v1[1]); w.w = cvt_pk_bf16(v1[2], v1[3]);
                *(u32x4*)rowp = w; }
    }
};
struct EpiResBf2 {
    static constexpr bool PERM = true, AFTER_DRAIN = false;
    const bf16_t* R; bf16_t* O;
    __device__ __forceinline__ void operator()(const f32x4 (&acc)[2][2][4][2], const Unit& u, int wr, int wc, int fr, int fq) const {
        const int row0 = u.pm * BM + wr * 64 + fr, col0 = u.pn * BM + wc * 32 + 8 * fq;
#pragma unroll
        for (int ai = 0; ai < 2; ++ai)
#pragma unroll
            for (int m = 0; m < 4; ++m) { const size_t off = (size_t)(row0 + ai * HALF + m * 16) * 4096 + col0;
#pragma unroll
                for (int bj = 0; bj < 2; ++bj) { const u32x4 r = *(const u32x4*)(R + off + bj * HALF);
                    const f32x4 v0 = acc[ai][bj][m][0] + (f32x4){bf_lo(r.x), bf_hi(r.x), bf_lo(r.y), bf_hi(r.y)}, v1 = acc[ai][bj][m][1] + (f32x4){bf_lo(r.z), bf_hi(r.z), bf_lo(r.w), bf_hi(r.w)};
                    u32x4 w; w.x = cvt_pk_bf16(v0[0], v0[1]); w.y = cvt_pk_bf16(v0[2], v0[3]); w.z = cvt_pk_bf16(v1[0], v1[1]); w.w = cvt_pk_bf16(v1[2], v1[3]);
                    *(u32x4*)(O + off + bj * HALF) = w; } }
    }
};
template <class Epi, class Sched, bool ALIGN_EPI = false, bool SP2 = false>
__device__ __forceinline__ void gemm_phase(PG8_LAS unsigned char* lds, const Gemm g, const Sched& S, const Epi& E) {
    const int tid = threadIdx.x, wid = __builtin_amdgcn_readfirstlane(tid >> 6), lane = tid & 63, wr = wid >> 2, wc = wid & 3, fr = lane & 15, fq = lane >> 4;
    const int K = g.K, nt = K / BK;
    unsigned voffA[2], voffB[2];
#pragma unroll
    for (int i = 0; i < 2; ++i) { int R, C; stage_rc(tid * 16 + i * 8192, R, C); const int Rb = Epi::PERM ? ((R & ~31) + perm32(R & 31)) : R;
        voffA[i] = (unsigned)(R * K + C) * 2u; voffB[i] = (unsigned)(Rb * K + C) * 2u; }
    const size_t kstep = (size_t)(BK * 2);
    const size_t hstep = (size_t)HALF * K * 2;
    const size_t tstep = 2 * hstep;
    const unsigned ldsw = (unsigned)wid * 1024u;
    const int aoff = lds_byte(wr * 64 + fr, fq * 8), boff = lds_byte(wc * 32 + fr, fq * 8);
#define PG8_SA(b, h) (((b) * 2 + (h)) * HTB)
#define PG8_SB(b, h) ((4 + (b) * 2 + (h)) * HTB)
#define PG8_STAGE(bufoff, gbase, voff) do { _Pragma("unroll") for (int _i = 0; _i < 2; ++_i) \
        __builtin_amdgcn_global_load_lds((const unsigned*)((const char*)(gbase) + (voff)[_i]), (PG8_LAS unsigned*)(lds + (bufoff) + ldsw + _i * 8192), 16, 0, 0); } while (0)
#define PG8_LDA(dst, b, h) do { _Pragma("unroll") for (int m = 0; m < 4; ++m) _Pragma("unroll") for (int k = 0; k < 2; ++k) dst[m][k] = *(const PG8_LAS bf16x8*)(lds + PG8_SA(b, h) + aoff + m * 2048 + k * 1024); } while (0)
#define PG8_LDB(dst, b, h) do { _Pragma("unroll") for (int n = 0; n < 2; ++n) _Pragma("unroll") for (int k = 0; k < 2; ++k) dst[n][k] = *(const PG8_LAS bf16x8*)(lds + PG8_SB(b, h) + boff + n * 2048 + k * 1024); } while (0)
#define PG8_MMA(ai, bj, At, Bt) do { __builtin_amdgcn_s_setprio(1); _Pragma("unroll") for (int m = 0; m < 4; ++m) _Pragma("unroll") for (int n = 0; n < 2; ++n) _Pragma("unroll") for (int k = 0; k < 2; ++k) \
        acc[ai][bj][m][n] = __builtin_amdgcn_mfma_f32_16x16x32_bf16(Bt[n][k], At[m][k], acc[ai][bj][m][n], 0, 0, 0); __builtin_amdgcn_s_setprio(0); } while (0)
#define PG8_WAIT_V(n) asm volatile("s_waitcnt vmcnt(" #n ")" ::: "memory")
#define PG8_WAIT_L(n) asm volatile("s_waitcnt lgkmcnt(" #n ")" ::: "memory")
#define PG8_BAR __builtin_amdgcn_s_barrier()
#define PG8_SCHED __builtin_amdgcn_sched_barrier(0)
    Unit cur, nxt; int ui = 0;
    if (!S.next(0, cur)) return;
    f32x4 acc[2][2][4][2];
#pragma unroll
    for (int a = 0; a < 2; ++a)
#pragma unroll
        for (int b = 0; b < 2; ++b)
#pragma unroll
            for (int m = 0; m < 4; ++m)
#pragma unroll
                for (int n = 0; n < 2; ++n) acc[a][b][m][n] = (f32x4){0.f, 0.f, 0.f, 0.f};
    bf16x8 At[4][2], B0[2][2], B1[2][2];
    const char* cA = (const char*)g.A + (size_t)cur.pm * tstep; const char* cB = (const char*)g.Bt + (size_t)cur.pn * tstep;
    S.a_ready(cur);
    if constexpr (SP2) {
        PG8_STAGE(PG8_SB(0, 0), cB, voffB); PG8_STAGE(PG8_SB(0, 1), cB + hstep, voffB); PG8_STAGE(PG8_SA(0, 0), cA, voffA); PG8_STAGE(PG8_SA(0, 1), cA + hstep, voffA);
        if (wr == 1) PG8_BAR;
        PG8_WAIT_V(2); PG8_BAR;
        PG8_STAGE(PG8_SB(1, 0), cB + kstep, voffB); PG8_STAGE(PG8_SA(1, 0), cA + kstep, voffA); PG8_STAGE(PG8_SB(1, 1), cB + hstep + kstep, voffB);
        PG8_WAIT_V(6); PG8_BAR;
    } else {
        PG8_STAGE(PG8_SB(0, 0), cB, voffB); PG8_STAGE(PG8_SA(0, 0), cA, voffA); PG8_STAGE(PG8_SB(0, 1), cB + hstep, voffB); PG8_STAGE(PG8_SA(0, 1), cA + hstep, voffA);
        if (wr == 1) PG8_BAR;
        PG8_WAIT_V(4); PG8_BAR;
        PG8_STAGE(PG8_SB(1, 0), cB + kstep, voffB); PG8_STAGE(PG8_SA(1, 0), cA + kstep, voffA); PG8_STAGE(PG8_SB(1, 1), cB + hstep + kstep, voffB);
        PG8_WAIT_V(6); PG8_BAR;
    }
    for (;;) {
        const bool has_next = S.next(ui + 1, nxt);
        const char* nA = has_next ? (const char*)g.A + (size_t)nxt.pm * tstep : cA; const char* nB = has_next ? (const char*)g.Bt + (size_t)nxt.pn * tstep : cB;
        for (int t = 0; t < nt; t += 2) {
            const bool last = (t == nt - 2);
            const char* a1 = cA + (size_t)(t + 1) * kstep;
            const char* a2 = last ? nA : cA + (size_t)(t + 2) * kstep; const char* b2 = last ? nB : cB + (size_t)(t + 2) * kstep;
            const char* a3 = a2 + kstep; const char* b3 = b2 + kstep;
            if (last && has_next) S.a_ready(nxt);
            if constexpr (SP2) {
            PG8_LDB(B0, 0, 0); PG8_LDB(B1, 0, 1); PG8_SCHED; PG8_LDA(At, 0, 0); PG8_STAGE(PG8_SA(1, 1), a1 + hstep, voffA);
            PG8_WAIT_V(8); PG8_WAIT_L(0); PG8_BAR; PG8_MMA(0, 0, At, B0); PG8_MMA(0, 1, At, B1); PG8_BAR; PG8_SCHED;
            PG8_LDA(At, 0, 1); PG8_STAGE(PG8_SB(0, 0), b2, voffB); PG8_STAGE(PG8_SB(0, 1), b2 + hstep, voffB); PG8_STAGE(PG8_SA(0, 0), a2, voffA);
            PG8_WAIT_V(8); PG8_WAIT_L(0); PG8_BAR; PG8_MMA(1, 0, At, B0); PG8_MMA(1, 1, At, B1); PG8_BAR; PG8_SCHED;
            PG8_LDB(B0, 1, 0); PG8_LDB(B1, 1, 1); PG8_SCHED; PG8_LDA(At, 1, 0); PG8_STAGE(PG8_SA(0, 1), a2 + hstep, voffA);
            PG8_WAIT_V(8); PG8_WAIT_L(0); PG8_BAR; PG8_MMA(0, 0, At, B0); PG8_MMA(0, 1, At, B1); PG8_BAR; PG8_SCHED;
            PG8_LDA(At, 1, 1); PG8_STAGE(PG8_SB(1, 0), b3, voffB); PG8_STAGE(PG8_SB(1, 1), b3 + hstep, voffB); PG8_STAGE(PG8_SA(1, 0), a3, voffA);
            PG8_WAIT_V(8); PG8_WAIT_L(0); PG8_BAR; PG8_MMA(1, 0, At, B0); PG8_MMA(1, 1, At, B1); PG8_BAR; PG8_SCHED;
            } else {
            PG8_LDB(B0, 0, 0); PG8_SCHED; PG8_LDA(At, 0, 0); PG8_STAGE(PG8_SA(1, 1), a1 + hstep, voffA);
            PG8_WAIT_L(8); PG8_BAR; PG8_WAIT_L(0); PG8_MMA(0, 0, At, B0); PG8_BAR; PG8_SCHED;
            PG8_LDB(B1, 0, 1); PG8_STAGE(PG8_SB(0, 0), b2, voffB);
            PG8_BAR; PG8_WAIT_L(0); PG8_MMA(0, 1, At, B1); PG8_BAR;
            PG8_LDA(At, 0, 1); PG8_STAGE(PG8_SA(0, 0), a2, voffA);
            PG8_BAR; PG8_WAIT_L(0); PG8_MMA(1, 0, At, B0); PG8_BAR; PG8_SCHED;
            PG8_STAGE(PG8_SB(0, 1), b2 + hstep, voffB);
            PG8_WAIT_V(6); PG8_BAR; PG8_MMA(1, 1, At, B1); PG8_BAR;
            PG8_LDB(B0, 1, 0); PG8_SCHED; PG8_LDA(At, 1, 0); PG8_STAGE(PG8_SA(0, 1), a2 + hstep, voffA);
            PG8_WAIT_L(8); PG8_BAR; PG8_WAIT_L(0); PG8_MMA(0, 0, At, B0); PG8_BAR; PG8_SCHED;
            PG8_LDB(B1, 1, 1); PG8_STAGE(PG8_SB(1, 0), b3, voffB);
            PG8_BAR; PG8_WAIT_L(0); PG8_MMA(0, 1, At, B1); PG8_BAR;
            PG8_LDA(At, 1, 1); PG8_STAGE(PG8_SA(1, 0), a3, voffA);
            PG8_BAR; PG8_WAIT_L(0); PG8_MMA(1, 0, At, B0); PG8_BAR; PG8_SCHED;
            PG8_STAGE(PG8_SB(1, 1), b3 + hstep, voffB);
            PG8_WAIT_V(6); PG8_BAR; PG8_MMA(1, 1, At, B1); PG8_BAR;
            }
        }
        if constexpr (ALIGN_EPI) { if (wr == 0) PG8_BAR; }
        if constexpr (!Epi::AFTER_DRAIN) { E(acc, cur, wr, wc, fr, fq); S.done(cur); }
        if (!has_next) break;
#pragma unroll
        for (int a = 0; a < 2; ++a)
#pragma unroll
            for (int b = 0; b < 2; ++b)
#pragma unroll
                for (int m = 0; m < 4; ++m)
#pragma unroll
                    for (int n = 0; n < 2; ++n) acc[a][b][m][n] = (f32x4){0.f, 0.f, 0.f, 0.f};
        cur = nxt; cA = nA; cB = nB; ++ui;
        if constexpr (ALIGN_EPI) { if (wr == 1) PG8_BAR; }
    }
    PG8_WAIT_V(0);
    if constexpr (!ALIGN_EPI) { if (wr == 0) PG8_BAR; }
    PG8_BAR;
    if constexpr (Epi::AFTER_DRAIN) { E.fused(acc, cur, wr, wc, fr, fq, lds, wid, lane); S.done(cur); }
#undef PG8_SA
#undef PG8_SB
#undef PG8_STAGE
#undef PG8_LDA
#undef PG8_LDB
#undef PG8_MMA
#undef PG8_WAIT_V
#undef PG8_WAIT_L
#undef PG8_BAR
#undef PG8_SCHED
}
template <class Epi, class Sched, bool ALIGN_EPI = false, bool SP2 = false>
__device__ __forceinline__ void gemm_phase2(PG8_LAS unsigned char* lds, const Gemm g, const Gemm g2, const Sched& S, const Epi& E) {
    const int tid = threadIdx.x, wid = __builtin_amdgcn_readfirstlane(tid >> 6), lane = tid & 63, wr = wid >> 2, wc = wid & 3, fr = lane & 15, fq = lane >> 4;
    const int K = g.K, nt = K / BK;
    unsigned voffA[2], voffB[2];
#pragma unroll
    for (int i = 0; i < 2; ++i) { int R, C; stage_rc(tid * 16 + i * 8192, R, C); const int Rb = Epi::PERM ? ((R & ~31) + perm32(R & 31)) : R;
        voffA[i] = (unsigned)(R * K + C) * 2u; voffB[i] = (unsigned)(Rb * K + C) * 2u; }
    const size_t kstep = (size_t)(BK * 2);
    const size_t hstep = (size_t)HALF * K * 2;
    const size_t tstep = 2 * hstep;
    const unsigned ldsw = (unsigned)wid * 1024u;
    const int aoff = lds_byte(wr * 64 + fr, fq * 8), boff = lds_byte(wc * 32 + fr, fq * 8);
#define PG8_SA(b, h) (((b) * 2 + (h)) * HTB)
#define PG8_SB(b, h) ((4 + (b) * 2 + (h)) * HTB)
#define PG8_STAGE(bufoff, gbase, voff) do { _Pragma("unroll") for (int _i = 0; _i < 2; ++_i) \
        __builtin_amdgcn_global_load_lds((const unsigned*)((const char*)(gbase) + (voff)[_i]), (PG8_LAS unsigned*)(lds + (bufoff) + ldsw + _i * 8192), 16, 0, 0); } while (0)
#define PG8_LDA(dst, b, h) do { _Pragma("unroll") for (int m = 0; m < 4; ++m) _Pragma("unroll") for (int k = 0; k < 2; ++k) dst[m][k] = *(const PG8_LAS bf16x8*)(lds + PG8_SA(b, h) + aoff + m * 2048 + k * 1024); } while (0)
#define PG8_LDB(dst, b, h) do { _Pragma("unroll") for (int n = 0; n < 2; ++n) _Pragma("unroll") for (int k = 0; k < 2; ++k) dst[n][k] = *(const PG8_LAS bf16x8*)(lds + PG8_SB(b, h) + boff + n * 2048 + k * 1024); } while (0)
#define PG8_MMA(ai, bj, At, Bt) do { __builtin_amdgcn_s_setprio(1); _Pragma("unroll") for (int m = 0; m < 4; ++m) _Pragma("unroll") for (int n = 0; n < 2; ++n) _Pragma("unroll") for (int k = 0; k < 2; ++k) \
        acc[ai][bj][m][n] = __builtin_amdgcn_mfma_f32_16x16x32_bf16(Bt[n][k], At[m][k], acc[ai][bj][m][n], 0, 0, 0); __builtin_amdgcn_s_setprio(0); } while (0)
#define PG8_WAIT_V(n) asm volatile("s_waitcnt vmcnt(" #n ")" ::: "memory")
#define PG8_WAIT_L(n) asm volatile("s_waitcnt lgkmcnt(" #n ")" ::: "memory")
#define PG8_BAR __builtin_amdgcn_s_barrier()
#define PG8_SCHED __builtin_amdgcn_sched_barrier(0)
    Unit cur, nxt; int ui = 0, seg = 0;
    if (!S.next(0, cur)) return;
    f32x4 acc[2][2][4][2];
#pragma unroll
    for (int a = 0; a < 2; ++a)
#pragma unroll
        for (int b = 0; b < 2; ++b)
#pragma unroll
            for (int m = 0; m < 4; ++m)
#pragma unroll
                for (int n = 0; n < 2; ++n) acc[a][b][m][n] = (f32x4){0.f, 0.f, 0.f, 0.f};
    bf16x8 At[4][2], B0[2][2], B1[2][2];
    const char* cA = (const char*)g.A + (size_t)cur.pm * tstep; const char* cB = (const char*)g.Bt + (size_t)cur.pn * tstep;
    S.a_ready(cur);
    if constexpr (SP2) {
        PG8_STAGE(PG8_SB(0, 0), cB, voffB); PG8_STAGE(PG8_SB(0, 1), cB + hstep, voffB); PG8_STAGE(PG8_SA(0, 0), cA, voffA); PG8_STAGE(PG8_SA(0, 1), cA + hstep, voffA);
        if (wr == 1) PG8_BAR;
        PG8_WAIT_V(2); PG8_BAR;
        PG8_STAGE(PG8_SB(1, 0), cB + kstep, voffB); PG8_STAGE(PG8_SA(1, 0), cA + kstep, voffA); PG8_STAGE(PG8_SB(1, 1), cB + hstep + kstep, voffB);
        PG8_WAIT_V(6); PG8_BAR;
    } else {
        PG8_STAGE(PG8_SB(0, 0), cB, voffB); PG8_STAGE(PG8_SA(0, 0), cA, voffA); PG8_STAGE(PG8_SB(0, 1), cB + hstep, voffB); PG8_STAGE(PG8_SA(0, 1), cA + hstep, voffA);
        if (wr == 1) PG8_BAR;
        PG8_WAIT_V(4); PG8_BAR;
        PG8_STAGE(PG8_SB(1, 0), cB + kstep, voffB); PG8_STAGE(PG8_SA(1, 0), cA + kstep, voffA); PG8_STAGE(PG8_SB(1, 1), cB + hstep + kstep, voffB);
        PG8_WAIT_V(6); PG8_BAR;
    }
    for (;;) {
        bool has_next; if (seg == 0) has_next = true; else has_next = S.next(ui + 1, nxt);
        const char* nA; const char* nB;
        if (seg == 0) { nA = (const char*)g2.A + (size_t)cur.pm * tstep; nB = (const char*)g2.Bt + (size_t)cur.pn * tstep; }
        else { nA = has_next ? (const char*)g.A + (size_t)nxt.pm * tstep : cA; nB = has_next ? (const char*)g.Bt + (size_t)nxt.pn * tstep : cB; }
        for (int t = 0; t < nt; t += 2) {
            const bool last = (t == nt - 2);
            const char* a1 = cA + (size_t)(t + 1) * kstep;
            const char* a2 = last ? nA : cA + (size_t)(t + 2) * kstep; const char* b2 = last ? nB : cB + (size_t)(t + 2) * kstep;
            const char* a3 = a2 + kstep; const char* b3 = b2 + kstep;
            if (last && has_next) S.a_ready(nxt);
            if constexpr (SP2) {
            PG8_LDB(B0, 0, 0); PG8_LDB(B1, 0, 1); PG8_SCHED; PG8_LDA(At, 0, 0); PG8_STAGE(PG8_SA(1, 1), a1 + hstep, voffA);
            PG8_WAIT_V(8); PG8_WAIT_L(0); PG8_BAR; PG8_MMA(0, 0, At, B0); PG8_MMA(0, 1, At, B1); PG8_BAR; PG8_SCHED;
            PG8_LDA(At, 0, 1); PG8_STAGE(PG8_SB(0, 0), b2, voffB); PG8_STAGE(PG8_SB(0, 1), b2 + hstep, voffB); PG8_STAGE(PG8_SA(0, 0), a2, voffA);
            PG8_WAIT_V(8); PG8_WAIT_L(0); PG8_BAR; PG8_MMA(1, 0, At, B0); PG8_MMA(1, 1, At, B1); PG8_BAR; PG8_SCHED;
            PG8_LDB(B0, 1, 0); PG8_LDB(B1, 1, 1); PG8_SCHED; PG8_LDA(At, 1, 0); PG8_STAGE(PG8_SA(0, 1), a2 + hstep, voffA);
            PG8_WAIT_V(8); PG8_WAIT_L(0); PG8_BAR; PG8_MMA(0, 0, At, B0); PG8_MMA(0, 1, At, B1); PG8_BAR; PG8_SCHED;
            PG8_LDA(At, 1, 1); PG8_STAGE(PG8_SB(1, 0), b3, voffB); PG8_STAGE(PG8_SB(1, 1), b3 + hstep, voffB); PG8_STAGE(PG8_SA(1, 0), a3, voffA);
            PG8_WAIT_V(8); PG8_WAIT_L(0); PG8_BAR; PG8_MMA(1, 0, At, B0); PG8_MMA(1, 1, At, B1); PG8_BAR; PG8_SCHED;
            } else {
            PG8_LDB(B0, 0, 0); PG8_SCHED; PG8_LDA(At, 0, 0); PG8_STAGE(PG8_SA(1, 1), a1 + hstep, voffA);
            PG8_WAIT_L(8); PG8_BAR; PG8_WAIT_L(0); PG8_MMA(0, 0, At, B0); PG8_BAR; PG8_SCHED;
            PG8_LDB(B1, 0, 1); PG8_STAGE(PG8_SB(0, 0), b2, voffB);
            PG8_BAR; PG8_WAIT_L(0); PG8_MMA(0, 1, At, B1); PG8_BAR;
            PG8_LDA(At, 0, 1); PG8_STAGE(PG8_SA(0, 0), a2, voffA);
            PG8_BAR; PG8_WAIT_L(0); PG8_MMA(1, 0, At, B0); PG8_BAR; PG8_SCHED;
            PG8_STAGE(PG8_SB(0, 1), b2 + hstep, voffB);
            PG8_WAIT_V(6); PG8_BAR; PG8_MMA(1, 1, At, B1); PG8_BAR;
            PG8_LDB(B0, 1, 0); PG8_SCHED; PG8_LDA(At, 1, 0); PG8_STAGE(PG8_SA(0, 1), a2 + hstep, voffA);
            PG8_WAIT_L(8); PG8_BAR; PG8_WAIT_L(0); PG8_MMA(0, 0, At, B0); PG8_BAR; PG8_SCHED;
            PG8_LDB(B1, 1, 1); PG8_STAGE(PG8_SB(1, 0), b3, voffB);
            PG8_BAR; PG8_WAIT_L(0); PG8_MMA(0, 1, At, B1); PG8_BAR;
            PG8_LDA(At, 1, 1); PG8_STAGE(PG8_SA(1, 0), a3, voffA);
            PG8_BAR; PG8_WAIT_L(0); PG8_MMA(1, 0, At, B0); PG8_BAR; PG8_SCHED;
            PG8_STAGE(PG8_SB(1, 1), b3 + hstep, voffB);
            PG8_WAIT_V(6); PG8_BAR; PG8_MMA(1, 1, At, B1); PG8_BAR;
            }
        }
        if constexpr (ALIGN_EPI) { if (wr == 0) PG8_BAR; }
        if (seg == 0) E.mid(acc, cur, wr, wc, fr, fq); else { E(acc, cur, wr, wc, fr, fq); S.done(cur); }
        if (!has_next) break;
        if (seg == 1) {
#pragma unroll
        for (int a = 0; a < 2; ++a)
#pragma unroll
            for (int b = 0; b < 2; ++b)
#pragma unroll
                for (int m = 0; m < 4; ++m)
#pragma unroll
                    for (int n = 0; n < 2; ++n) acc[a][b][m][n] = (f32x4){0.f, 0.f, 0.f, 0.f};
        cur = nxt; ++ui; }
        cA = nA; cB = nB; seg ^= 1;
        if constexpr (ALIGN_EPI) { if (wr == 1) PG8_BAR; }
    }
    PG8_WAIT_V(0);
    if constexpr (!ALIGN_EPI) { if (wr == 0) PG8_BAR; }
    PG8_BAR;
#undef PG8_SA
#undef PG8_SB
#undef PG8_STAGE
#undef PG8_LDA
#undef PG8_LDB
#undef PG8_MMA
#undef PG8_WAIT_V
#undef PG8_WAIT_L
#undef PG8_BAR
#undef PG8_SCHED
}
}
#define XB_TMO      128
#define XB_XCNT(j)  (256  + 64 * (j))
#define XB_XSUB(j)  (1280 + 64 * (j))
#define XB_XGEN(j)  (2304 + 64 * (j))
#define XB_TOP      3328
#define XB_TOPGEN   3392
#define XCD_BAR_WORDS 3456
#define XB_SPIN_CAP (1u << 18)

__device__ __forceinline__ unsigned xb_ld(unsigned* p)              { return __hip_atomic_load(p, __ATOMIC_RELAXED, __HIP_MEMORY_SCOPE_AGENT); }
__device__ __forceinline__ unsigned xb_add(unsigned* p, unsigned v) { return __hip_atomic_fetch_add(p, v, __ATOMIC_RELAXED, __HIP_MEMORY_SCOPE_AGENT); }
__device__ __forceinline__ unsigned xb_xcc_id() { return (unsigned)__builtin_amdgcn_s_getreg((3 << 11) | 20) & 0xFu; }
#define XB_SPIN(cond, bar) do { unsigned _sp = 0; while (cond) { __builtin_amdgcn_s_sleep(1); \
    if ((++_sp & 255u) == 0u) { if (xb_ld(&(bar)[XB_TMO])) break; if (_sp > XB_SPIN_CAP) { atomicAdd(&(bar)[XB_TMO], 1u); break; } } } } while (0)

struct XcdBarrier {
    unsigned* bar; unsigned x;
    volatile LAS unsigned* st;
};

__device__ __forceinline__ XcdBarrier xcd_barrier_post(unsigned* bar, volatile LAS unsigned* st) {
    XcdBarrier b; b.bar = bar; b.x = xb_xcc_id(); b.st = st;
    if (threadIdx.x == 0) (void)xb_add(&bar[XB_XCNT(b.x)], 1u);
    return b;
}
__device__ __forceinline__ void xcd_barrier_complete(unsigned* bar, unsigned x, unsigned& nloc, unsigned& nx) {
    const unsigned G = gridDim.x * gridDim.y * gridDim.z;
    unsigned sum, cnt, mine, sp = 0u;
    for (;;) {
        sum = 0u; cnt = 0u; mine = 0u;
#pragma unroll
        for (unsigned j = 0; j < 16; ++j) { const unsigned c = xb_ld(&bar[XB_XCNT(j)]); sum += c; cnt += (c > 0u) ? 1u : 0u; mine = (j == x) ? c : mine; }
        if (sum == G) break;
        __builtin_amdgcn_s_sleep(1);
        if ((++sp & 255u) == 0u) { if (xb_ld(&bar[XB_TMO])) break; if (sp > XB_SPIN_CAP) { atomicAdd(&bar[XB_TMO], 1u); break; } }
    }
    nloc = mine > 0u ? mine : 1u; nx = cnt > 0u ? cnt : 1u;
}

__device__ __forceinline__ void xcd_barrier(const XcdBarrier& b) {
    asm volatile("s_waitcnt vmcnt(0)" ::: "memory");
    __syncthreads();
    if (threadIdx.x == 0) {
        unsigned* bar = b.bar;
        __builtin_amdgcn_s_waitcnt(0);
        unsigned nloc = b.st[0], nx = b.st[1];
        if (nloc == 0u) { xcd_barrier_complete(bar, b.x, nloc, nx); b.st[0] = nloc; b.st[1] = nx; }
        const unsigned old = xb_add(&bar[XB_XSUB(b.x)], 1u);
        const unsigned gen = old / nloc;
        if (old + 1u == (gen + 1u) * nloc) {
            __builtin_amdgcn_fence(__ATOMIC_RELEASE, "agent");
            asm volatile("s_waitcnt vmcnt(0)" ::: "memory");
            const unsigned og = xb_add(&bar[XB_TOP], 1u);
            const unsigned tg = og / nx;
            if (og + 1u == (tg + 1u) * nx) xb_add(&bar[XB_TOPGEN], 1u);
            else XB_SPIN(xb_ld(&bar[XB_TOPGEN]) == tg, bar);
            __builtin_amdgcn_fence(__ATOMIC_ACQUIRE, "agent");
            xb_add(&bar[XB_XGEN(b.x)], 1u);
            asm volatile("s_waitcnt vmcnt(0)" ::: "memory");
        } else {
            XB_SPIN(xb_ld(&bar[XB_XGEN(b.x)]) == gen, bar);
            __builtin_amdgcn_fence(__ATOMIC_ACQUIRE, "agent");
            asm volatile("s_waitcnt vmcnt(0)" ::: "memory");
        }
    }
    __syncthreads();
}

constexpr int D = 4096, SEQ = 8192, NX = 16384  , NMETA = 16, MROWS = 16640  ;
constexpr int DIN = 36864, DFF = 11008, NH = 16;
constexpr float EPS = 1e-6f, LOG2E = 1.4426950408889634f;
constexpr size_t MiB = 1u << 20;
constexpr size_t WS_CTL = 0, CTL_ZERO_BYTES = 1 * MiB;
constexpr size_t WS_WBR = 1 * MiB, WS_WBD = 33 * MiB, WS_WO = 65 * MiB, WS_WGU = 97 * MiB, WS_WDN = 269 * MiB;
constexpr size_t WS_WIN = 355 * MiB, WS_U = 643 * MiB;
constexpr size_t WS_ST = 355 * MiB;
constexpr size_t WS_PROJ = 867 * MiB;
constexpr size_t WS_YR = 2037 * MiB, WS_END = 2165 * MiB;
constexpr size_t GS = (size_t)MROWS * D;
constexpr size_t WS_MIXED = 355 * MiB, WS_U2 = 483 * MiB, WS_ACT = 867 * MiB, WS_H2 = 355 * MiB  , WS_PS = 611 * MiB  , WS_RSTD = 616 * MiB  ;
static_assert(WS_WGU + (size_t)2 * DFF * D * 2 <= WS_WDN && WS_WDN + (size_t)D * DFF * 2 <= WS_WIN && WS_WIN + (size_t)DIN * D * 2 <= WS_U && WS_U + (size_t)MROWS * D * 2 <= WS_ST + 512 * MiB && WS_ST + 512 * MiB <= WS_PROJ && WS_PROJ + 9 * GS * 2 <= WS_END, "ws map");
constexpr int CW_BAR = 4096;
constexpr int LDS_BYTES = 163840, MISC_OFF = LDS_BYTES - 256;
constexpr int NWAVES = 8;


typedef unsigned short bf16;
typedef LAS char lchar;
#define LDS_WAIT() asm volatile("s_waitcnt lgkmcnt(0)" ::: "memory")
#define VM_WAIT() asm volatile("s_waitcnt vmcnt(0)" ::: "memory")
#define WAITBAR() do { asm volatile("s_waitcnt vmcnt(0) lgkmcnt(0)" ::: "memory"); __builtin_amdgcn_s_barrier(); asm volatile("" ::: "memory"); } while (0)

namespace mx {
using bf16x8 = __attribute__((ext_vector_type(8))) short;
using s16x4  = __attribute__((ext_vector_type(4))) short;
using f32x16 = __attribute__((ext_vector_type(16))) float;
using f32x4  = __attribute__((ext_vector_type(4))) float;
using u32x4  = __attribute__((ext_vector_type(4))) unsigned;
using u32x2  = __attribute__((ext_vector_type(2))) unsigned;
#define KSWZ(row, colB) ((row) * 256 + ((colB) ^ (((row) & 7) << 4)))
#define SBAR() __builtin_amdgcn_sched_barrier(0)
__device__ __forceinline__ int crow(int r, int hi) { return (r & 3) + 8 * (r >> 2) + 4 * hi; }
__device__ __forceinline__ unsigned cvtpk(float lo, float hi) { unsigned r; asm volatile("v_cvt_pk_bf16_f32 %0, %1, %2" : "=v"(r) : "v"(lo), "v"(hi)); return r; }
__device__ __forceinline__ float bflo(unsigned w) { return __uint_as_float(w << 16); }
__device__ __forceinline__ float bfhi(unsigned w) { return __uint_as_float(w & 0xffff0000u); }
__device__ __forceinline__ int v_rd_base(int lane) { return ((lane & 3) << 3) | (((lane >> 2) & 3) << 6) | (((lane >> 4) & 1) << 5) | (((lane >> 5) & 1) << 8); }
constexpr int vro(int d0, int ks, int half) { return d0 * 512 + ks * 8192 + half * 4096; }
template <int OFF> __device__ __forceinline__ s16x4 tr_read(int vb) { s16x4 r; asm volatile("ds_read_b64_tr_b16 %0, %1 offset:%2" : "=&v"(r) : "v"(vb), "i"(OFF) : "memory"); return r; }
#define MX_PK(L, H) (mx::bf16x8){L[0], L[1], L[2], L[3], H[0], H[1], H[2], H[3]}
__device__ __forceinline__ void vimg_rc(int P, int& k, int& c) { const int st = P >> 9, wi = P & 511, kk = (st >> 3) * 8 + (wi >> 6); c = (st & 7) * 32 + ((wi & 63) >> 1); k = (kk & ~0xC) | ((kk & 4) << 1) | ((kk & 8) >> 1); }
__device__ __forceinline__ void kimg_rc(int P, int& r, int& c) { r = P >> 8; const int cp = P & 255; c = (cp ^ ((r & 7) << 4)) >> 1; }
__device__ __forceinline__ void glds16(const void* g, lchar* l) { __builtin_amdgcn_global_load_lds((const unsigned*)g, (LAS unsigned*)l, 16, 0, 0); }
__device__ __forceinline__ int lds_addr(const lchar* p) { return (int)(unsigned)(size_t)p; }
template <int K> __device__ __forceinline__ float swz_xor(float v) { return __int_as_float(__builtin_amdgcn_ds_swizzle(__float_as_int(v), 0x1f | (K << 10))); }
__device__ __forceinline__ float half_sum(float v) { v += swz_xor<1>(v); v += swz_xor<2>(v); v += swz_xor<4>(v); v += swz_xor<8>(v); v += swz_xor<16>(v); return v; }
__device__ __forceinline__ int opaque(int x) { asm volatile("" : "+v"(x)); return x; }

template <int ND> __device__ __forceinline__ void qkt(f32x16& p0, f32x16& p1, const lchar* Ks, const bf16x8* qr, int r32, int hi) {
#pragma unroll
  for (int r = 0; r < 16; ++r) { p0[r] = 0.f; p1[r] = 0.f; }
#pragma unroll
  for (int d0 = 0; d0 < ND; ++d0) { const int cb = ((d0 & 7) * 16 + hi * 8) * 2; const lchar* Kh = Ks + (d0 >> 3) * 16384;
    const bf16x8 b0 = *(const LAS bf16x8*)(Kh + KSWZ(r32, cb));
    const bf16x8 b1 = *(const LAS bf16x8*)(Kh + KSWZ(32 + r32, cb));
    p0 = __builtin_amdgcn_mfma_f32_32x32x16_bf16(b0, qr[d0], p0, 0, 0, 0);
    p1 = __builtin_amdgcn_mfma_f32_32x32x16_bf16(b1, qr[d0], p1, 0, 0, 0); }
}
__device__ __forceinline__ void pack_p(const f32x16& p0, const f32x16& p1, bf16x8& pa0, bf16x8& pa1, bf16x8& pa2, bf16x8& pa3) {
#define PK4(P, BASE, OUT) do { unsigned a0 = cvtpk(P[BASE + 0], P[BASE + 1]), a1 = cvtpk(P[BASE + 2], P[BASE + 3]);   \
    unsigned b0 = cvtpk(P[BASE + 4], P[BASE + 5]), b1 = cvtpk(P[BASE + 6], P[BASE + 7]);                              \
    auto r0 = __builtin_amdgcn_permlane32_swap(a0, b0, false, false); auto r1 = __builtin_amdgcn_permlane32_swap(a1, b1, false, false); \
    u32x4 w = {r0[0], r1[0], r0[1], r1[1]}; OUT = *reinterpret_cast<bf16x8*>(&w); } while (0)
  PK4(p0, 0, pa0); PK4(p0, 8, pa1); PK4(p1, 0, pa2); PK4(p1, 8, pa3);
#undef PK4
}
__device__ __forceinline__ void pack_p2(const f32x16& p, bf16x8& pa0, bf16x8& pa1) {
#define PK4(P, BASE, OUT) do { unsigned a0 = cvtpk(P[BASE + 0], P[BASE + 1]), a1 = cvtpk(P[BASE + 2], P[BASE + 3]);   \
    unsigned b0 = cvtpk(P[BASE + 4], P[BASE + 5]), b1 = cvtpk(P[BASE + 6], P[BASE + 7]);                              \
    auto r0 = __builtin_amdgcn_permlane32_swap(a0, b0, false, false); auto r1 = __builtin_amdgcn_permlane32_swap(a1, b1, false, false); \
    u32x4 w = {r0[0], r1[0], r0[1], r1[1]}; OUT = *reinterpret_cast<bf16x8*>(&w); } while (0)
  PK4(p, 0, pa0); PK4(p, 8, pa1);
#undef PK4
}
template <int D0, int KH> __device__ __forceinline__ void pv_half(f32x16& od, int vb, bf16x8 a0, bf16x8 a1) {
  const s16x4 l0 = tr_read<vro(D0, 2 * KH, 0)>(vb), h0 = tr_read<vro(D0, 2 * KH, 1)>(vb), l1 = tr_read<vro(D0, 2 * KH + 1, 0)>(vb), h1 = tr_read<vro(D0, 2 * KH + 1, 1)>(vb);
  asm volatile("s_waitcnt lgkmcnt(0)" ::: "memory"); SBAR();
  od = __builtin_amdgcn_mfma_f32_32x32x16_bf16(a0, MX_PK(l0, h0), od, 0, 0, 0);
  od = __builtin_amdgcn_mfma_f32_32x32x16_bf16(a1, MX_PK(l1, h1), od, 0, 0, 0);
}
template <int D0, int KH> __device__ __forceinline__ void pv_half2(f32x16& oa, f32x16& ob, int vb, bf16x8 a0, bf16x8 a1) {
  const s16x4 l0 = tr_read<vro(D0, 2 * KH, 0)>(vb), h0 = tr_read<vro(D0, 2 * KH, 1)>(vb), l1 = tr_read<vro(D0, 2 * KH + 1, 0)>(vb), h1 = tr_read<vro(D0, 2 * KH + 1, 1)>(vb);
  const s16x4 l2 = tr_read<vro(D0 + 1, 2 * KH, 0)>(vb), h2 = tr_read<vro(D0 + 1, 2 * KH, 1)>(vb), l3 = tr_read<vro(D0 + 1, 2 * KH + 1, 0)>(vb), h3 = tr_read<vro(D0 + 1, 2 * KH + 1, 1)>(vb);
  asm volatile("s_waitcnt lgkmcnt(0)" ::: "memory"); SBAR();
  oa = __builtin_amdgcn_mfma_f32_32x32x16_bf16(a0, MX_PK(l0, h0), oa, 0, 0, 0);
  ob = __builtin_amdgcn_mfma_f32_32x32x16_bf16(a0, MX_PK(l2, h2), ob, 0, 0, 0);
  oa = __builtin_amdgcn_mfma_f32_32x32x16_bf16(a1, MX_PK(l1, h1), oa, 0, 0, 0);
  ob = __builtin_amdgcn_mfma_f32_32x32x16_bf16(a1, MX_PK(l3, h3), ob, 0, 0, 0);
}
template <int KH> __device__ __forceinline__ void pv_half8(f32x16* o, int vb, bf16x8 a0, bf16x8 a1) {
#define PV8_RD(D0, L0, H0, L1, H1, L2, H2, L3, H3) const s16x4 L0 = tr_read<vro(D0, 2 * KH, 0)>(vb), H0 = tr_read<vro(D0, 2 * KH, 1)>(vb), L1 = tr_read<vro(D0, 2 * KH + 1, 0)>(vb), H1 = tr_read<vro(D0, 2 * KH + 1, 1)>(vb), \
      L2 = tr_read<vro(D0 + 1, 2 * KH, 0)>(vb), H2 = tr_read<vro(D0 + 1, 2 * KH, 1)>(vb), L3 = tr_read<vro(D0 + 1, 2 * KH + 1, 0)>(vb), H3 = tr_read<vro(D0 + 1, 2 * KH + 1, 1)>(vb)
#define PV8_MM(D0, L0, H0, L1, H1, L2, H2, L3, H3) do { o[D0] = __builtin_amdgcn_mfma_f32_32x32x16_bf16(a0, MX_PK(L0, H0), o[D0], 0, 0, 0); o[D0 + 1] = __builtin_amdgcn_mfma_f32_32x32x16_bf16(a0, MX_PK(L2, H2), o[D0 + 1], 0, 0, 0); \
      o[D0] = __builtin_amdgcn_mfma_f32_32x32x16_bf16(a1, MX_PK(L1, H1), o[D0], 0, 0, 0); o[D0 + 1] = __builtin_amdgcn_mfma_f32_32x32x16_bf16(a1, MX_PK(L3, H3), o[D0 + 1], 0, 0, 0); } while (0)
  PV8_RD(0, a_l0, a_h0, a_l1, a_h1, a_l2, a_h2, a_l3, a_h3);
  PV8_RD(2, b_l0, b_h0, b_l1, b_h1, b_l2, b_h2, b_l3, b_h3);
  asm volatile("s_waitcnt lgkmcnt(8)" ::: "memory"); SBAR();
  PV8_MM(0, a_l0, a_h0, a_l1, a_h1, a_l2, a_h2, a_l3, a_h3); SBAR();
  PV8_RD(4, c_l0, c_h0, c_l1, c_h1, c_l2, c_h2, c_l3, c_h3);
  asm volatile("s_waitcnt lgkmcnt(8)" ::: "memory"); SBAR();
  PV8_MM(2, b_l0, b_h0, b_l1, b_h1, b_l2, b_h2, b_l3, b_h3); SBAR();
  PV8_RD(6, d_l0, d_h0, d_l1, d_h1, d_l2, d_h2, d_l3, d_h3);
  asm volatile("s_waitcnt lgkmcnt(8)" ::: "memory"); SBAR();
  PV8_MM(4, c_l0, c_h0, c_l1, c_h1, c_l2, c_h2, c_l3, c_h3); SBAR();
  asm volatile("s_waitcnt lgkmcnt(0)" ::: "memory"); SBAR();
  PV8_MM(6, d_l0, d_h0, d_l1, d_h1, d_l2, d_h2, d_l3, d_h3);
#undef PV8_RD
#undef PV8_MM
}
template <int D0> __device__ __forceinline__ void pv_one(f32x16& od, int vb, bf16x8 a0, bf16x8 a1, bf16x8 a2, bf16x8 a3) {
  const s16x4 l0 = tr_read<vro(D0, 0, 0)>(vb), h0 = tr_read<vro(D0, 0, 1)>(vb), l1 = tr_read<vro(D0, 1, 0)>(vb), h1 = tr_read<vro(D0, 1, 1)>(vb);
  const s16x4 l2 = tr_read<vro(D0, 2, 0)>(vb), h2 = tr_read<vro(D0, 2, 1)>(vb), l3 = tr_read<vro(D0, 3, 0)>(vb), h3 = tr_read<vro(D0, 3, 1)>(vb);
  asm volatile("s_waitcnt lgkmcnt(0)" ::: "memory"); SBAR();
  od = __builtin_amdgcn_mfma_f32_32x32x16_bf16(a0, MX_PK(l0, h0), od, 0, 0, 0);
  od = __builtin_amdgcn_mfma_f32_32x32x16_bf16(a1, MX_PK(l1, h1), od, 0, 0, 0);
  od = __builtin_amdgcn_mfma_f32_32x32x16_bf16(a2, MX_PK(l2, h2), od, 0, 0, 0);
  od = __builtin_amdgcn_mfma_f32_32x32x16_bf16(a3, MX_PK(l3, h3), od, 0, 0, 0);
}
}

struct Frame {
    lchar* lds; volatile LAS unsigned* MISC; unsigned* ctl;
    int tid, lane, wave, vcu, G;
    const float* in[15]; float* out; unsigned char* ws;
};
__device__ __forceinline__ float wave_sum(float v) {
    v = mx::half_sum(v);
    auto rr = __builtin_amdgcn_permlane32_swap(__float_as_uint(v), __float_as_uint(v), false, false);
    return __uint_as_float(rr[0]) + __uint_as_float(rr[1]);
}
__device__ __forceinline__ unsigned f2bf(float f) { unsigned u = __builtin_bit_cast(unsigned, f); return (u + 0x7fffu + ((u >> 16) & 1u)) >> 16; }
__device__ __forceinline__ unsigned pk2(float lo, float hi) { return f2bf(lo) | (f2bf(hi) << 16); }

__device__ __forceinline__ void p0_transpose_item(const float* W, int K, int N, bf16* WT, int mode, LAS float* scr, int item, int lane, const float* gk = nullptr) {
    const int nblk = N / 64, kb = item / nblk, nb = item - kb * nblk, k0 = 64 * kb, n0 = 64 * nb;
    mx::f32x4 v[16];
    const float* src = W + (size_t)(k0 + (lane >> 4)) * N + n0 + 4 * (lane & 15);
#pragma unroll
    for (int i = 0; i < 16; ++i) v[i] = *(const mx::f32x4*)(src + (size_t)(4 * i) * N);
#pragma unroll
    for (int i = 0; i < 16; ++i) { LAS float* s = scr + (4 * i + (lane >> 4)) * 65 + 4 * (lane & 15); s[0] = v[i][0]; s[1] = v[i][1]; s[2] = v[i][2]; s[3] = v[i][3]; }
    LDS_WAIT(); asm volatile("" ::: "memory");
    const int c = lane & 7;
    const int nd0 = (mode == 0) ? n0 : ((n0 >> 7) * 256 + (n0 & 127) + (mode == 2 ? 128 : 0));
    mx::f32x4 ga = {1.f, 1.f, 1.f, 1.f}, gb = {1.f, 1.f, 1.f, 1.f};
    if (gk) { ga = *(const mx::f32x4*)(gk + k0 + 8 * c); gb = *(const mx::f32x4*)(gk + k0 + 8 * c + 4); }
#pragma unroll
    for (int j = 0; j < 8; ++j) { const int n = (lane >> 3) + 8 * j; const LAS float* s = scr + (8 * c) * 65 + n;
        mx::u32x4 o; o.x = pk2(s[0 * 65] * ga[0], s[1 * 65] * ga[1]); o.y = pk2(s[2 * 65] * ga[2], s[3 * 65] * ga[3]); o.z = pk2(s[4 * 65] * gb[0], s[5 * 65] * gb[1]); o.w = pk2(s[6 * 65] * gb[2], s[7 * 65] * gb[3]);
        *(mx::u32x4*)(WT + (size_t)(nd0 + n) * K + k0 + 8 * c) = o; }
    LDS_WAIT(); asm volatile("" ::: "memory");
}
template <bool OUT32> __device__ __forceinline__ void rms_row(const float* xrow, const float* g, void* orow, int lane) {
    const mx::f32x4* xr = (const mx::f32x4*)xrow + lane;
    mx::f32x4 v[16]; float s = 0.f;
#pragma unroll
    for (int j = 0; j < 16; ++j) { v[j] = xr[64 * j]; s += (v[j][0] * v[j][0] + v[j][1] * v[j][1]) + (v[j][2] * v[j][2] + v[j][3] * v[j][3]); }
    const float rstd = 1.0f / sqrtf(wave_sum(s) * (1.f / D) + EPS);
    const mx::f32x4* gr = (const mx::f32x4*)g + lane;
#pragma unroll
    for (int j = 0; j < 16; ++j) { const mx::f32x4 gg = gr[64 * j]; const mx::f32x4 y = v[j] * rstd * gg;
        if (OUT32) ((mx::f32x4*)orow)[lane + 64 * j] = y;
        else { mx::u32x2 w; w.x = pk2(y[0], y[1]); w.y = pk2(y[2], y[3]); ((mx::u32x2*)orow)[lane + 64 * j] = w; } }
}
__device__ __forceinline__ void rms_row_bf(const bf16* xrow, const float* g, float* orow, int lane) {
    const mx::u32x4* xr = (const mx::u32x4*)xrow + lane;
    mx::u32x4 v[8]; float s = 0.f;
#pragma unroll
    for (int j = 0; j < 8; ++j) { v[j] = xr[64 * j];
        s += (mx::bflo(v[j].x) * mx::bflo(v[j].x) + mx::bfhi(v[j].x) * mx::bfhi(v[j].x)) + (mx::bflo(v[j].y) * mx::bflo(v[j].y) + mx::bfhi(v[j].y) * mx::bfhi(v[j].y))
           + (mx::bflo(v[j].z) * mx::bflo(v[j].z) + mx::bfhi(v[j].z) * mx::bfhi(v[j].z)) + (mx::bflo(v[j].w) * mx::bflo(v[j].w) + mx::bfhi(v[j].w) * mx::bfhi(v[j].w)); }
    const float rstd = 1.0f / sqrtf(wave_sum(s) * (1.f / D) + EPS);
#pragma unroll
    for (int j = 0; j < 8; ++j) { const float* gp = g + 512 * j + 8 * lane; const mx::f32x4 g0 = *(const mx::f32x4*)gp, g1 = *(const mx::f32x4*)(gp + 4);
        float* op = orow + 512 * j + 8 * lane;
        *(mx::f32x4*)op = (mx::f32x4){mx::bflo(v[j].x) * rstd * g0[0], mx::bfhi(v[j].x) * rstd * g0[1], mx::bflo(v[j].y) * rstd * g0[2], mx::bfhi(v[j].y) * rstd * g0[3]};
        *(mx::f32x4*)(op + 4) = (mx::f32x4){mx::bflo(v[j].z) * rstd * g1[0], mx::bfhi(v[j].z) * rstd * g1[1], mx::bflo(v[j].w) * rstd * g1[2], mx::bfhi(v[j].w) * rstd * g1[3]}; }
}
constexpr int I_IN = (D / 64) * (DIN / 64), I_SQ = (D / 64) * (D / 64), I_FF = (D / 64) * (DFF / 64), P0_NITEMS = I_IN + 3 * I_SQ + 3 * I_FF;
__device__ __forceinline__ void p0_items(Frame& F, int it_lo, int it_hi, int lane) {
    LAS float* scr = (LAS float*)(F.lds + F.wave * 16640);
    const int gw = F.vcu * NWAVES + F.wave, NGW = F.G * NWAVES;
    bf16* WIN = (bf16*)(F.ws + WS_WIN); bf16* WBR = (bf16*)(F.ws + WS_WBR); bf16* WBD = (bf16*)(F.ws + WS_WBD); bf16* WO = (bf16*)(F.ws + WS_WO); bf16* WGU = (bf16*)(F.ws + WS_WGU); bf16* WDN = (bf16*)(F.ws + WS_WDN);
    for (int it = it_lo + gw; it < it_hi; it += NGW) {
        int r = it;
        if (r < I_IN) { p0_transpose_item(F.in[3], D, DIN, WIN, 0, scr, r, lane); continue; } r -= I_IN;
        if (r < I_SQ) { p0_transpose_item(F.in[7], D, D, WBR, 0, scr, r, lane); continue; } r -= I_SQ;
        if (r < I_SQ) { p0_transpose_item(F.in[8], D, D, WBD, 0, scr, r, lane); continue; } r -= I_SQ;
        if (r < I_SQ) { p0_transpose_item(F.in[9], D, D, WO, 0, scr, r, lane); continue; } r -= I_SQ;
        if (r < I_FF) { p0_transpose_item(F.in[11], D, DFF, WGU, 1, scr, r, lane, F.in[10]); continue; } r -= I_FF;
        if (r < I_FF) { p0_transpose_item(F.in[12], D, DFF, WGU, 2, scr, r, lane, F.in[10]); continue; } r -= I_FF;
        p0_transpose_item(F.in[13], DFF, D, WDN, 0, scr, r, lane);
    }
}
__device__ __forceinline__ void p0_prologue(Frame& F) {
    const int gw = F.vcu * NWAVES + F.wave, NGW = F.G * NWAVES;
    p0_items(F, 0, I_IN, F.lane);
    bf16* U = (bf16*)(F.ws + WS_U);
    for (int m = gw; m < MROWS; m += NGW) {
        bf16* orow = U + (size_t)m * D;
        if (m < NX) rms_row<false>(F.in[0] + (size_t)m * D, F.in[2], orow, F.lane);
        else if (m < NX + NMETA) rms_row<false>(F.in[1] + (size_t)(m - NX) * D, F.in[2], orow, F.lane);
        else {
#pragma unroll
            for (int j = 0; j < 16; ++j) ((mx::u32x2*)orow)[F.lane + 64 * j] = (mx::u32x2){0u, 0u}; }
    }
}


__device__ __forceinline__ void meta_proj(lchar* lds, const bf16* U, const bf16* WIN, bf16* PROJ, int vcu, int G) {
    using namespace mx; typedef float f32x4_t __attribute__((ext_vector_type(4)));
    const int tid = opaque((int)threadIdx.x), wid = __builtin_amdgcn_readfirstlane(tid >> 6), lane = tid & 63, cg = wid & 3, kh = wid >> 2;
    LAS float* red = (LAS float*)lds;
    for (int c = vcu; c < 256; c += G) {
        const int g0 = c * 64, gi = g0 >> 12, grp = (gi == 0) ? 1 : (gi == 1) ? 2 : (gi == 2) ? 5 : 6, col0 = (g0 & 4095) + cg * 16;
        const bf16* wrow = WIN + (size_t)(grp * 4096 + col0 + (lane & 15)) * D + kh * 2048 + (lane >> 4) * 8;
        const bf16* urow = U + (size_t)(NX + (lane & 15)) * D + kh * 2048 + (lane >> 4) * 8;
        f32x4_t acc = {0.f, 0.f, 0.f, 0.f};
#pragma unroll 8
        for (int ks = 0; ks < 64; ++ks) { const bf16x8 a = *(const bf16x8*)(urow + ks * 32), bq = *(const bf16x8*)(wrow + ks * 32);
            acc = __builtin_amdgcn_mfma_f32_16x16x32_bf16(a, bq, acc, 0, 0, 0); }
        if (kh == 1) *(LAS f32x4_t*)(red + (cg * 64 + lane) * 4) = acc;
        __syncthreads();
        if (kh == 0) { const f32x4_t o = *(const LAS f32x4_t*)(red + (cg * 64 + lane) * 4); acc += o;
            const float sc = (grp == 1) ? 0.0625f : 1.f; bf16* op = PROJ + (size_t)grp * GS + (size_t)(NX + (lane >> 4) * 4) * D + col0 + (lane & 15);
#pragma unroll
            for (int i = 0; i < 4; ++i) op[(size_t)i * D] = (bf16)f2bf(acc[i] * sc); }
        if (grp >= 5 && tid < 384) { bf16* zp = PROJ + (size_t)grp * GS + (size_t)(NX + 16 + (tid >> 3)) * D + (g0 & 4095) + (tid & 7) * 8; *(u32x4*)zp = (u32x4){0u, 0u, 0u, 0u}; }
        __syncthreads();
    }
}

constexpr int ATT_NT = 129;
constexpr int CW_NRM = 8192;
#define BARF() do { asm volatile("" ::: "memory"); __builtin_amdgcn_s_barrier(); asm volatile("" ::: "memory"); } while (0)
__device__ __forceinline__ void attn_unit(lchar* lds, const bf16* Qg, const bf16* Kg, const bf16* Vg, bf16* Og, float* stash, const float* subg, const unsigned* nrm, int b, int h, int qb, float lam) {
    using namespace mx;
    const int tid = threadIdx.x, wid = __builtin_amdgcn_readfirstlane(tid >> 6), lane = tid & 63, r32 = lane & 31, hi = lane >> 5, grp = wid >> 2;
    lchar* Kb = lds; lchar* Vb = lds + 32768; LAS float* li_l = (LAS float*)(lds + 147456) + wid * 64; LAS float* al_l = li_l + 32; LAS float* mslot = (LAS float*)(lds + 147456 + 2048);
    const float slope = exp2f(-0.5f * (float)(h + 1)), nsl2 = -slope * LOG2E;
    constexpr float C = 0.08838834764831845f * LOG2E, THR2 = 60.f, NEG = -1e30f;
    const float asl = slope * LOG2E, Cq = 0.08838834764831845f / slope, THRQ = THR2 / asl, DEADQ = -127.f / asl;
    const int qrow = b * SEQ + qb * 256 + wid * 32 + r32;
    const float qposf = (float)(NMETA + qb * 256 + wid * 32 + r32 - 4 * hi);
    const int vb0 = lds_addr(Vb) + v_rd_base(lane);
    const int ka0 = lds_addr(Kb) + r32 * 256 + ((hi * 16) ^ ((r32 & 7) << 4));
#pragma unroll 1
    for (int mp = 0; mp < 2; ++mp) {
        int t_lo, t_hi;
        const float smax_l2 = sqrtf(__uint_as_float(nrm[(0 * 2 + b) * 32 + h * 2 + mp])) * sqrtf(__uint_as_float(nrm[(1 * 2 + b) * 32 + h * 2 + mp])) * C;
        const bf16* Qw = Qg + (size_t)qrow * D + h * 256 + mp * 128 + hi * 8;
        bf16x8 qr[8];
#pragma unroll
        for (int d0 = 0; d0 < 8; ++d0) qr[d0] = *(const bf16x8*)(Qw + d0 * 16);
        const char* Kcol = (const char*)(Kg + h * 256 + mp * 128); const char* Vcol = (const char*)(Vg + h * 256);
        { const bf16* Kw = Kg + (size_t)qrow * D + h * 256 + mp * 128 + hi * 8; float dot = 0.f;
#pragma unroll
          for (int d0 = 0; d0 < 8; ++d0) { const u32x4 kk = *(const u32x4*)(Kw + d0 * 16); const u32x4 qq = *reinterpret_cast<const u32x4*>(&qr[d0]);
              dot += bflo(kk.x) * bflo(qq.x) + bfhi(kk.x) * bfhi(qq.x) + bflo(kk.y) * bflo(qq.y) + bfhi(kk.y) * bfhi(qq.y) + bflo(kk.z) * bflo(qq.z) + bfhi(kk.z) * bfhi(qq.z) + bflo(kk.w) * bflo(qq.w) + bfhi(kk.w) * bfhi(qq.w); }
          { auto rr = __builtin_amdgcn_permlane32_swap(__float_as_uint(dot), __float_as_uint(dot), false, false); dot = __uint_as_float(rr[0]) + __uint_as_float(rr[1]); }
          float mm = dot * C; mm = fminf(mm, swz_xor<1>(mm)); mm = fminf(mm, swz_xor<2>(mm)); mm = fminf(mm, swz_xor<4>(mm)); mm = fminf(mm, swz_xor<8>(mm)); mm = fminf(mm, swz_xor<16>(mm));
          if (lane == 0) mslot[wid] = mm; LDS_WAIT(); BARF();
          float mmin = mslot[0];
#pragma unroll
          for (int w = 1; w < 8; ++w) mmin = fminf(mmin, mslot[w]);
          const float wf = fminf((smax_l2 - mmin + 152.f) / (-nsl2) + 2.f, 20000.f); const int W = (int)wf;
          const int qmin = NMETA + qb * 256, qmax = qmin + 255;
          const int klo = qmin - W, khi = qmax + W;
          t_lo = (klo <= 15) ? 0 : (klo + 48) / 64; if (t_lo > 128) t_lo = 128;
          t_hi = (khi + 48) / 64; if (t_hi > 128) t_hi = 128; if (t_hi < t_lo) t_hi = t_lo;
          t_lo = __builtin_amdgcn_readfirstlane(t_lo); t_hi = __builtin_amdgcn_readfirstlane(t_hi); }
        const int ntl = t_hi - t_lo + 1;
        f32x16 o[8];
#pragma unroll
        for (int d = 0; d < 8; ++d)
#pragma unroll
            for (int r = 0; r < 16; ++r) o[d][r] = 0.f;
        float m_reg = NEG, l_reg = 0.f;
#define ATT_ISSUE(t, buf) do { const size_t rb_ = ((t) == 0) ? (size_t)NX : (size_t)(b * SEQ + 64 * ((t) - 1)); const char* kg_ = Kcol + rb_ * (D * 2); const char* vg_ = Vcol + rb_ * (D * 2); const int tq_ = opaque(tid); \
        unsigned ko_, vo_; { int r_, c_; kimg_rc(tq_ * 16, r_, c_); ko_ = (unsigned)(r_ * (D * 2) + c_ * 2); vimg_rc(tq_ * 16, r_, c_); vo_ = (unsigned)(r_ * (D * 2) + c_ * 2); }     \
        _Pragma("unroll") for (int i_ = 0; i_ < 2; ++i_) glds16(kg_ + (size_t)i_ * (32 * D * 2) + ko_, Kb + (buf) * 16384 + (i_ * 8 + wid) * 1024); \
        _Pragma("unroll") for (int i_ = 0; i_ < 4; ++i_) glds16(vg_ + (size_t)i_ * (16 * D * 2) + vo_, Vb + (buf) * 32768 + (i_ * 8 + wid) * 1024); } while (0)
#define ATT_S1(KH) do { f32x16 p; \
            _Pragma("unroll") for (int r = 0; r < 16; ++r) p[r] = 0.f; \
            { const int ka = ka0 + cur * 16384 + KH * 8192; bf16x8 k0, k1, k2, k3, k4, k5, k6, k7;     \
              asm volatile("ds_read_b128 %0, %1" : "=&v"(k0) : "v"(ka) : "memory"); asm volatile("ds_read_b128 %0, %1" : "=&v"(k1) : "v"(ka ^ 32) : "memory"); \
              asm volatile("ds_read_b128 %0, %1" : "=&v"(k2) : "v"(ka ^ 64) : "memory"); asm volatile("ds_read_b128 %0, %1" : "=&v"(k3) : "v"(ka ^ 96) : "memory"); \
              asm volatile("ds_read_b128 %0, %1 offset:128" : "=&v"(k4) : "v"(ka) : "memory"); asm volatile("ds_read_b128 %0, %1 offset:128" : "=&v"(k5) : "v"(ka ^ 32) : "memory"); \
              asm volatile("ds_read_b128 %0, %1 offset:128" : "=&v"(k6) : "v"(ka ^ 64) : "memory"); asm volatile("ds_read_b128 %0, %1 offset:128" : "=&v"(k7) : "v"(ka ^ 96) : "memory"); \
              __builtin_amdgcn_s_setprio(2); asm volatile("s_waitcnt lgkmcnt(6)" ::: "memory"); SBAR(); p = __builtin_amdgcn_mfma_f32_32x32x16_bf16(k0, qr[0], p, 0, 0, 0); p = __builtin_amdgcn_mfma_f32_32x32x16_bf16(k1, qr[1], p, 0, 0, 0); SBAR(); \
              asm volatile("s_waitcnt lgkmcnt(4)" ::: "memory"); SBAR(); p = __builtin_amdgcn_mfma_f32_32x32x16_bf16(k2, qr[2], p, 0, 0, 0); p = __builtin_amdgcn_mfma_f32_32x32x16_bf16(k3, qr[3], p, 0, 0, 0); SBAR(); \
              asm volatile("s_waitcnt lgkmcnt(2)" ::: "memory"); SBAR(); p = __builtin_amdgcn_mfma_f32_32x32x16_bf16(k4, qr[4], p, 0, 0, 0); p = __builtin_amdgcn_mfma_f32_32x32x16_bf16(k5, qr[5], p, 0, 0, 0); SBAR(); \
              asm volatile("s_waitcnt lgkmcnt(0)" ::: "memory"); SBAR(); p = __builtin_amdgcn_mfma_f32_32x32x16_bf16(k6, qr[6], p, 0, 0, 0); p = __builtin_amdgcn_mfma_f32_32x32x16_bf16(k7, qr[7], p, 0, 0, 0); SBAR(); __builtin_amdgcn_s_setprio(0); } \
            _Pragma("unroll") for (int r = 0; r < 16; ++r) { const float dd = ((KH == 0 && r >= 8) ? q8 : qrel) - (float)((r & 3) + 8 * (r >> 2) + 32 * KH); p[r] = fmaf(p[r], Cq, -fabsf(dd)); } \
            float pmax = fmaxf(fmaxf(p[0], p[1]), p[2]); \
            _Pragma("unroll") for (int r = 3; r < 15; r += 2) pmax = fmaxf(fmaxf(pmax, p[r]), p[r + 1]); \
            pmax = fmaxf(pmax, p[15]); \
            { auto rr = __builtin_amdgcn_permlane32_swap(__float_as_uint(pmax), __float_as_uint(pmax), false, false); pmax = fmaxf(__uint_as_float(rr[0]), __uint_as_float(rr[1])); } \
              \
              \
            dead = __all(pmax - m_reg < DEADQ); \
            if (!dead) { float mn; \
            if (__builtin_expect(__all(pmax - m_reg <= THRQ), 1)) { mn = m_reg; alpha = 1.f; } \
            else { mn = fmaxf(m_reg, pmax); alpha = __builtin_amdgcn_exp2f((m_reg - mn) * asl); m_reg = mn; } \
            float ps = 0.f; const float nm = -mn * asl; \
            _Pragma("unroll") for (int r = 0; r < 16; ++r) { p[r] = __builtin_amdgcn_exp2f(fmaf(p[r], asl, nm)); ps += p[r]; } \
            { auto rr = __builtin_amdgcn_permlane32_swap(__float_as_uint(ps), __float_as_uint(ps), false, false); ps = __uint_as_float(rr[0]) + __uint_as_float(rr[1]); } \
            l_reg = l_reg * alpha + ps; \
            pack_p2(p, pa0, pa1); } } while (0)
#define ATT_S2(KH) do { if (!dead) { \
            if (__any(alpha < 1.f)) { if (hi == 0) al_l[r32] = alpha; LDS_WAIT(); \
                _Pragma("unroll") for (int r = 0; r < 16; ++r) { const float a = al_l[crow(r, hi)]; \
                    _Pragma("unroll") for (int d = 0; d < 8; ++d) o[d][r] *= a; } } \
            pv_half8<KH>(o, vb, pa0, pa1); } } while (0)
        int tcn = (NMETA + qb * 256 + 128 + 48) / 64; tcn = tcn < t_lo ? t_lo : (tcn > t_hi ? t_hi : tcn);
        if (t_lo == 0 && t_hi == 128) tcn = 0;
        const int nright = t_hi - tcn + 1;
#define ATT_TILE(i) (((i) < nright) ? tcn + (i) : tcn - 1 - ((i) - nright))
        ATT_ISSUE(ATT_TILE(0), 0); WAITBAR();
        if (grp == 1) BARF();
#pragma unroll 1
        for (int tt = 0; tt < ntl; ++tt) {
            const int t = ATT_TILE(tt), cur = tt & 1;
            const float qrel = qposf - (float)(t == 0 ? 0 : 64 * t - 48);
            const float q8 = (t == 0) ? 1e30f : qrel;
            const int vb = vb0 + cur * 32768;
            bf16x8 pa0, pa1; float alpha; bool dead;
            ATT_S1(0);
            BARF();
            if (tt + 1 < ntl) ATT_ISSUE(ATT_TILE(tt + 1), cur ^ 1);
            ATT_S2(0);
            BARF();
            if (t != 0) ATT_S1(1);
            asm volatile("s_waitcnt vmcnt(0)" ::: "memory");
            BARF();
            if (t != 0) ATT_S2(1);
            BARF();
        }
        if (grp == 0) BARF();
#undef ATT_ISSUE
#undef ATT_S1
#undef ATT_S2
#undef ATT_TILE
        if (hi == 0) li_l[r32] = l_reg; LDS_WAIT();
        const int hio = opaque(hi), lno = opaque(lane);
        f32x4* st4 = (f32x4*)(stash + (size_t)wid * 8192) + lno;
        if (mp == 0) {
#pragma unroll
            for (int q4 = 0; q4 < 4; ++q4) { float rl[4];
#pragma unroll
                for (int i = 0; i < 4; ++i) rl[i] = __builtin_amdgcn_rcpf(li_l[crow(4 * q4 + i, hio)]);
#pragma unroll
                for (int d = 0; d < 8; ++d) st4[(d * 4 + q4) * 64] = (f32x4){o[d][4 * q4] * rl[0], o[d][4 * q4 + 1] * rl[1], o[d][4 * q4 + 2] * rl[2], o[d][4 * q4 + 3] * rl[3]}; }
        } else {
            const int r32o = lno & 31;
            float gsc[8];
#pragma unroll
            for (int d = 0; d < 8; ++d) gsc[d] = subg[d * 32 + r32o] * 0.8f;
            lchar* tl = lds + wid * 16896;
#pragma unroll
            for (int q4 = 0; q4 < 4; ++q4) {
                f32x4 sv[8];
#pragma unroll
                for (int d = 0; d < 8; ++d) sv[d] = st4[(d * 4 + q4) * 64];
                asm volatile("" ::: "memory");
#pragma unroll
                for (int i = 0; i < 4; ++i) { const int r = 4 * q4 + i; const float rl = __builtin_amdgcn_rcpf(li_l[crow(r, hio)]) * lam; float ss = 0.f; float v[8];
#pragma unroll
                    for (int d = 0; d < 8; ++d) { v[d] = sv[d][i] - o[d][r] * rl; ss += v[d] * v[d]; }
                    ss = half_sum(ss);
                    const float rs = 1.0f / sqrtf(ss * (1.f / 256.f) + EPS);
#pragma unroll
                    for (int d = 0; d < 8; ++d) *(LAS bf16*)(tl + crow(r, hio) * 528 + (d * 32 + r32o) * 2) = (bf16)f2bf(v[d] * rs * gsc[d]); }
                asm volatile("" ::: "memory"); }
            LDS_WAIT();
            bf16* orow = Og + (size_t)(b * SEQ + qb * 256 + wid * 32 + (lno >> 5)) * D + h * 256 + (lno & 31) * 8;
#pragma unroll
            for (int i = 0; i < 16; ++i) { const lchar* sp = tl + (2 * i + (lno >> 5)) * 528 + (lno & 31) * 16; const u32x2 lo = *(const LAS u32x2*)sp, hi2 = *(const LAS u32x2*)(sp + 8);
                *(u32x4*)(orow + (size_t)(2 * i) * D) = (u32x4){lo.x, lo.y, hi2.x, hi2.y}; }
            LDS_WAIT();
        }
        BARF();
    }
}
__device__ __forceinline__ void normmax_phase(Frame& F, const bf16* Qg, const bf16* Kg, unsigned* nrm) {
    using namespace mx;
    LAS unsigned* red = (LAS unsigned*)(F.lds + 131072);
    if (F.tid < 64) red[F.tid] = 0u;
    __syncthreads();
    for (int c = F.vcu; c < 256; c += F.G) {
        const int b = c >> 7; float mq[8], mk[8];
#pragma unroll
        for (int j = 0; j < 8; ++j) { mq[j] = 0.f; mk[j] = 0.f; }
        const int nrow = (c == 0 || c == 128) ? 10 : 8;
        for (int i = 0; i < nrow; ++i) {
            const int row = (i < 8) ? c * 64 + F.wave * 8 + i : NX + F.wave * 2 + (i - 8);
#pragma unroll
            for (int j = 0; j < 8; ++j) {
                const u32x4 kv = *(const u32x4*)(Kg + (size_t)row * D + 512 * j + 8 * F.lane);
                float sk = bflo(kv.x) * bflo(kv.x) + bfhi(kv.x) * bfhi(kv.x) + bflo(kv.y) * bflo(kv.y) + bfhi(kv.y) * bfhi(kv.y) + bflo(kv.z) * bflo(kv.z) + bfhi(kv.z) * bfhi(kv.z) + bflo(kv.w) * bflo(kv.w) + bfhi(kv.w) * bfhi(kv.w);
                sk += swz_xor<1>(sk); sk += swz_xor<2>(sk); sk += swz_xor<4>(sk); sk += swz_xor<8>(sk); mk[j] = fmaxf(mk[j], sk);
                if (i < 8) { const u32x4 qv = *(const u32x4*)(Qg + (size_t)row * D + 512 * j + 8 * F.lane);
                    float sq = bflo(qv.x) * bflo(qv.x) + bfhi(qv.x) * bfhi(qv.x) + bflo(qv.y) * bflo(qv.y) + bfhi(qv.y) * bfhi(qv.y) + bflo(qv.z) * bflo(qv.z) + bfhi(qv.z) * bfhi(qv.z) + bflo(qv.w) * bflo(qv.w) + bfhi(qv.w) * bfhi(qv.w);
                    sq += swz_xor<1>(sq); sq += swz_xor<2>(sq); sq += swz_xor<4>(sq); sq += swz_xor<8>(sq); mq[j] = fmaxf(mq[j], sq); } }
        }
        if ((F.lane & 15) == 0) {
#pragma unroll
            for (int j = 0; j < 8; ++j) { const int seg = 4 * j + (F.lane >> 4); __hip_atomic_fetch_max(red + seg, __float_as_uint(mq[j]), __ATOMIC_RELAXED, __HIP_MEMORY_SCOPE_WORKGROUP); __hip_atomic_fetch_max(red + 32 + seg, __float_as_uint(mk[j]), __ATOMIC_RELAXED, __HIP_MEMORY_SCOPE_WORKGROUP); } }
        __syncthreads();
        if (F.tid < 64) { const int tsr = F.tid >> 5, seg = F.tid & 31; __hip_atomic_fetch_max(nrm + (tsr * 2 + b) * 32 + seg, red[F.tid], __ATOMIC_RELAXED, __HIP_MEMORY_SCOPE_AGENT); red[F.tid] = 0u; }
        __syncthreads();
    }
}

__device__ __forceinline__ void ret_local_unit(lchar* lds, const bf16* Kg, const bf16* Vg, bf16* ST, int b, int h, int c, float lgf2, float lgb2) {
    using namespace mx;
    const int tid = threadIdx.x, wid = __builtin_amdgcn_readfirstlane(tid >> 6), lane = tid & 63, r32 = lane & 31, hi = lane >> 5;
    __syncthreads();
    { const int tq = opaque(tid); const size_t hb = ((size_t)((b * NH + h) * SEQ + 128 * c)) * 256;
      const char* kg = (const char*)(Kg + hb); const char* vg = (const char*)(Vg + hb);
#pragma unroll
      for (int hf = 0; hf < 2; ++hf)
#pragma unroll
        for (int i = 0; i < 4; ++i) { int k, c2; vimg_rc((i * 512 + tq) * 16, k, c2); const unsigned off = (unsigned)((64 * hf + k) * 512 + c2 * 2);
            glds16(kg + off, lds + hf * 32768 + (i * 8 + wid) * 1024); glds16(vg + off, lds + 65536 + hf * 32768 + (i * 8 + wid) * 1024); } }
    WAITBAR();
    const int vbK = lds_addr(lds) + v_rd_base(lane) + wid * 512, vbV = lds_addr(lds) + 65536 + v_rd_base(lane);
#pragma unroll 1
    for (int dir = 0; dir < 2; ++dir) {
        f32x16 acc[8];
#pragma unroll
        for (int d = 0; d < 8; ++d)
#pragma unroll
            for (int r = 0; r < 16; ++r) acc[d][r] = 0.f;
        const float lg = dir == 0 ? lgf2 : lgb2;
#define RL_W(T) __builtin_amdgcn_exp2f(lg * (float)(dir == 0 ? 127 - (T) : (T)))
#define RL_STEP(HF, KS) do { const int vk_ = vbK + (HF) * 32768, vv_ = vbV + (HF) * 32768; \
            const s16x4 al = tr_read<vro(0, KS, 0)>(vk_), ah = tr_read<vro(0, KS, 1)>(vk_); \
            const s16x4 l0 = tr_read<vro(0, KS, 0)>(vv_), h0 = tr_read<vro(0, KS, 1)>(vv_), l1 = tr_read<vro(1, KS, 0)>(vv_), h1 = tr_read<vro(1, KS, 1)>(vv_), l2 = tr_read<vro(2, KS, 0)>(vv_), h2 = tr_read<vro(2, KS, 1)>(vv_), l3 = tr_read<vro(3, KS, 0)>(vv_), h3 = tr_read<vro(3, KS, 1)>(vv_); \
            const s16x4 l4 = tr_read<vro(4, KS, 0)>(vv_), h4 = tr_read<vro(4, KS, 1)>(vv_), l5 = tr_read<vro(5, KS, 0)>(vv_), h5 = tr_read<vro(5, KS, 1)>(vv_), l6 = tr_read<vro(6, KS, 0)>(vv_), h6 = tr_read<vro(6, KS, 1)>(vv_), l7 = tr_read<vro(7, KS, 0)>(vv_), h7 = tr_read<vro(7, KS, 1)>(vv_); \
            const int tb_ = 64 * (HF) + 16 * (KS) + 8 * hi; \
            const float w0 = RL_W(tb_), w1 = RL_W(tb_ + 1), w2 = RL_W(tb_ + 2), w3 = RL_W(tb_ + 3), w4 = RL_W(tb_ + 4), w5 = RL_W(tb_ + 5), w6 = RL_W(tb_ + 6), w7 = RL_W(tb_ + 7); \
            asm volatile("s_waitcnt lgkmcnt(0)" ::: "memory"); SBAR(); \
            const bf16x8 ar = MX_PK(al, ah); const u32x4 aw = *reinterpret_cast<const u32x4*>(&ar); u32x4 as_; \
            as_.x = cvtpk(bflo(aw.x) * w0, bfhi(aw.x) * w1); as_.y = cvtpk(bflo(aw.y) * w2, bfhi(aw.y) * w3); as_.z = cvtpk(bflo(aw.z) * w4, bfhi(aw.z) * w5); as_.w = cvtpk(bflo(aw.w) * w6, bfhi(aw.w) * w7); \
            const bf16x8 a = *reinterpret_cast<const bf16x8*>(&as_); \
            acc[0] = __builtin_amdgcn_mfma_f32_32x32x16_bf16(a, MX_PK(l0, h0), acc[0], 0, 0, 0); acc[1] = __builtin_amdgcn_mfma_f32_32x32x16_bf16(a, MX_PK(l1, h1), acc[1], 0, 0, 0); \
            acc[2] = __builtin_amdgcn_mfma_f32_32x32x16_bf16(a, MX_PK(l2, h2), acc[2], 0, 0, 0); acc[3] = __builtin_amdgcn_mfma_f32_32x32x16_bf16(a, MX_PK(l3, h3), acc[3], 0, 0, 0); \
            acc[4] = __builtin_amdgcn_mfma_f32_32x32x16_bf16(a, MX_PK(l4, h4), acc[4], 0, 0, 0); acc[5] = __builtin_amdgcn_mfma_f32_32x32x16_bf16(a, MX_PK(l5, h5), acc[5], 0, 0, 0); \
            acc[6] = __builtin_amdgcn_mfma_f32_32x32x16_bf16(a, MX_PK(l6, h6), acc[6], 0, 0, 0); acc[7] = __builtin_amdgcn_mfma_f32_32x32x16_bf16(a, MX_PK(l7, h7), acc[7], 0, 0, 0); } while (0)
        RL_STEP(0, 0); RL_STEP(0, 1); RL_STEP(0, 2); RL_STEP(0, 3); RL_STEP(1, 0); RL_STEP(1, 1); RL_STEP(1, 2); RL_STEP(1, 3);
#undef RL_STEP
#undef RL_W
        bf16* S = ST + ((size_t)(((b * NH + h) * 2 + dir) * 64 + c) << 16);
        const int hio = opaque(hi), r32o = opaque(r32);
#pragma unroll
        for (int r = 0; r < 16; ++r) { bf16* sp = S + (size_t)(32 * wid + crow(r, hio)) * 256 + r32o;
#pragma unroll
            for (int d = 0; d < 8; ++d) sp[d * 32] = (bf16)f2bf(acc[d][r]); }
    }
}
__device__ __forceinline__ void ret_scan(Frame& F, const bf16* Kg, const bf16* Vg, bf16* ST, const float* logdec) {
    using namespace mx;
    const int gid = F.vcu * 512 + F.tid, NT = F.G * 512, NV = 64 * 8192;
    for (int vb = gid; vb < NV; vb += 4 * NT) {
        float s[4][8], dec[4]; bf16* base[4]; int dirs[4]; bool ok[4]; u32x4 nx[4];
#pragma unroll
        for (int q = 0; q < 4; ++q) {
            const int v0 = vb + q * NT; ok[q] = v0 < NV; const int vv0 = ok[q] ? v0 : gid;
            const int seq = vv0 >> 13, e = (vv0 & 8191) * 8, dir = seq & 1, h = (seq >> 1) & 15, dk = e >> 8, dv = e & 255; dirs[q] = dir;
            const float lg2 = -expf(logdec[dir * NH + h]) * LOG2E; dec[q] = __builtin_amdgcn_exp2f(lg2 * 128.f);
#pragma unroll
            for (int j = 0; j < 8; ++j) s[q][j] = 0.f;
            if (dir == 0) {
                for (int m = 0; m < NMETA; ++m) { const float w = __builtin_amdgcn_exp2f(lg2 * (float)(15 - m)) * __uint_as_float((unsigned)Kg[(size_t)(NX + m) * D + h * 256 + dk] << 16);
                    const u32x4 vv = *(const u32x4*)(Vg + (size_t)(NX + m) * D + h * 256 + dv);
                    s[q][0] += w * bflo(vv.x); s[q][1] += w * bfhi(vv.x); s[q][2] += w * bflo(vv.y); s[q][3] += w * bfhi(vv.y); s[q][4] += w * bflo(vv.z); s[q][5] += w * bfhi(vv.z); s[q][6] += w * bflo(vv.w); s[q][7] += w * bfhi(vv.w); }
            }
            base[q] = ST + ((size_t)(seq * 64) << 16) + e;
            nx[q] = *(const u32x4*)(base[q] + ((size_t)(dir == 0 ? 0 : 63) << 16));
        }
#pragma unroll 2
        for (int st = 0; st < 64; ++st) {
            u32x4 t[4];
#pragma unroll
            for (int q = 0; q < 4; ++q) { t[q] = nx[q]; if (st + 1 < 64) nx[q] = *(const u32x4*)(base[q] + ((size_t)(dirs[q] == 0 ? st + 1 : 62 - st) << 16)); }
#pragma unroll
            for (int q = 0; q < 4; ++q) { bf16* p = base[q] + ((size_t)(dirs[q] == 0 ? st : 63 - st) << 16);
                u32x4 w; w.x = pk2(s[q][0], s[q][1]); w.y = pk2(s[q][2], s[q][3]); w.z = pk2(s[q][4], s[q][5]); w.w = pk2(s[q][6], s[q][7]);
                if (ok[q]) *(u32x4*)p = w;
                const float d = dec[q];
                s[q][0] = s[q][0] * d + bflo(t[q].x); s[q][1] = s[q][1] * d + bfhi(t[q].x); s[q][2] = s[q][2] * d + bflo(t[q].y); s[q][3] = s[q][3] * d + bfhi(t[q].y);
                s[q][4] = s[q][4] * d + bflo(t[q].z); s[q][5] = s[q][5] * d + bfhi(t[q].z); s[q][6] = s[q][6] * d + bflo(t[q].w); s[q][7] = s[q][7] * d + bfhi(t[q].w); }
        }
    }
}
struct RoUnit { int b, h, c; };
__device__ __forceinline__ RoUnit ro_unit(int id) { RoUnit u; const int bh = id >> 6; u.b = bh >> 4; u.h = bh & 15; u.c = id & 63; return u; }
__device__ __forceinline__ void ret_out_phase(lchar* lds, const bf16* Qg, const bf16* Kg, const bf16* Vg, const bf16* Gg, const bf16* ST, bf16* Og, const float* logdec, int vcu, int G) {
    using namespace mx;
    const int tid = threadIdx.x, wid = __builtin_amdgcn_readfirstlane(tid >> 6), lane = tid & 63, r32 = lane & 31, hi = lane >> 5, rb = wid & 3, dh = wid >> 2;
    LAS unsigned* offl = (LAS unsigned*)(lds + 131072);
    LAS float* ssl = (LAS float*)(lds + 147456);
    { const int tq = opaque(tid);
#pragma unroll
      for (int i = 0; i < 4; ++i) { const int P = (i * 512 + tq) * 16; int r, cc; kimg_rc(P & 16383, r, cc); cc += (P >> 14) * 128; int k, c2; vimg_rc(P, k, c2);
          offl[i * 512 + tq] = (unsigned)(r * 512 + cc * 2); offl[(4 + i) * 512 + tq] = (unsigned)(k * 512 + c2 * 2); } }
    __syncthreads();
    const int nun = (2048 - vcu + G - 1) / G;
#define RO_ISSUE(u, k, SLOT) do { const size_t hb_ = ((size_t)(((u).b * NH + (u).h) * SEQ + 128 * (u).c)) * 256; const LAS unsigned* of_ = offl + opaque(tid); \
        if ((k) < 4) { const bf16* src_ = (((k) & 1) ? Vg : Kg) + hb_ + (size_t)(64 * ((k) >> 1)) * 256; \
            _Pragma("unroll") for (int i_ = 0; i_ < 4; ++i_) glds16((const char*)src_ + of_[(((k) & 1) * 4 + i_) * 512], lds + (SLOT) * 32768 + (i_ * 8 + wid) * 1024); } \
        else { const char* src_ = (const char*)(ST + ((size_t)((((u).b * NH + (u).h) * 2 + (((k) - 4) >> 2)) * 64 + (u).c) << 16)) + (size_t)(((k) - 4) & 3) * 64 * 512; \
            _Pragma("unroll") for (int i_ = 0; i_ < 4; ++i_) glds16(src_ + of_[(4 + i_) * 512], lds + (SLOT) * 32768 + (i_ * 8 + wid) * 1024); } } while (0)
    RoUnit cu = ro_unit(vcu);
    RO_ISSUE(cu, 0, 0); RO_ISSUE(cu, 1, 1); RO_ISSUE(cu, 2, 2);
    const int ka0 = lds_addr(lds) + r32 * 256 + ((hi * 16) ^ ((r32 & 7) << 4));
    const int vb0 = lds_addr(lds) + v_rd_base(lane) + dh * 2048;
#pragma unroll 1
    for (int ui = 0; ui < nun; ++ui) {
        const bool lastu = (ui + 1 == nun); const RoUnit nu = ro_unit(vcu + (ui + 1) * G);
        const float lgf2 = -expf(logdec[cu.h]) * LOG2E, lgb2 = -expf(logdec[NH + cu.h]) * LOG2E;
        const int r0 = cu.b * SEQ + 128 * cu.c, ii = 32 * rb + r32;
        bf16x8 qr[16];
        const size_t hb = ((size_t)((cu.b * NH + cu.h) * SEQ + 128 * cu.c)) * 256;
        { const bf16* Qw = Qg + hb + (size_t)opaque(ii) * 256 + opaque(hi) * 8;
#pragma unroll
          for (int d0 = 0; d0 < 16; ++d0) qr[d0] = *(const bf16x8*)(Qw + d0 * 16); }
        f32x16 o[4]; bf16x8 pa0, pa1, pa2, pa3;
#pragma unroll
        for (int d = 0; d < 4; ++d)
#pragma unroll
            for (int r = 0; r < 16; ++r) o[d][r] = 0.f;
#define RO_OPEN(k) do { if (lastu && (k) >= 10) { if ((k) == 10) asm volatile("s_waitcnt vmcnt(4)" ::: "memory"); else asm volatile("s_waitcnt vmcnt(0)" ::: "memory"); } else asm volatile("s_waitcnt vmcnt(8)" ::: "memory"); \
        BARF(); if ((k) + 3 < 12) RO_ISSUE(cu, (k) + 3, ((k) + 3) & 3); else if (!lastu) RO_ISSUE(nu, (k) + 3 - 12, ((k) + 3) & 3); } while (0)
#define RO_QKCHAIN(P, KB, OFF) do { bf16x8 k0, k1, k2, k3, k4, k5, k6, k7; \
            asm volatile("ds_read_b128 %0, %1 offset:%2" : "=&v"(k0) : "v"(KB), "i"(OFF) : "memory"); asm volatile("ds_read_b128 %0, %1 offset:%2" : "=&v"(k1) : "v"(KB ^ 32), "i"(OFF) : "memory"); \
            asm volatile("ds_read_b128 %0, %1 offset:%2" : "=&v"(k2) : "v"(KB ^ 64), "i"(OFF) : "memory"); asm volatile("ds_read_b128 %0, %1 offset:%2" : "=&v"(k3) : "v"(KB ^ 96), "i"(OFF) : "memory"); \
            asm volatile("ds_read_b128 %0, %1 offset:%2" : "=&v"(k4) : "v"(KB), "i"(OFF + 128) : "memory"); asm volatile("ds_read_b128 %0, %1 offset:%2" : "=&v"(k5) : "v"(KB ^ 32), "i"(OFF + 128) : "memory"); \
            asm volatile("ds_read_b128 %0, %1 offset:%2" : "=&v"(k6) : "v"(KB ^ 64), "i"(OFF + 128) : "memory"); asm volatile("ds_read_b128 %0, %1 offset:%2" : "=&v"(k7) : "v"(KB ^ 96), "i"(OFF + 128) : "memory"); \
            asm volatile("s_waitcnt lgkmcnt(4)" ::: "memory"); SBAR(); \
            P = __builtin_amdgcn_mfma_f32_32x32x16_bf16(k0, qr[(OFF >= 16384 ? 8 : 0) + 0], P, 0, 0, 0); P = __builtin_amdgcn_mfma_f32_32x32x16_bf16(k1, qr[(OFF >= 16384 ? 8 : 0) + 1], P, 0, 0, 0); \
            P = __builtin_amdgcn_mfma_f32_32x32x16_bf16(k2, qr[(OFF >= 16384 ? 8 : 0) + 2], P, 0, 0, 0); P = __builtin_amdgcn_mfma_f32_32x32x16_bf16(k3, qr[(OFF >= 16384 ? 8 : 0) + 3], P, 0, 0, 0); SBAR(); \
            asm volatile("s_waitcnt lgkmcnt(0)" ::: "memory"); SBAR(); \
            P = __builtin_amdgcn_mfma_f32_32x32x16_bf16(k4, qr[(OFF >= 16384 ? 8 : 0) + 4], P, 0, 0, 0); P = __builtin_amdgcn_mfma_f32_32x32x16_bf16(k5, qr[(OFF >= 16384 ? 8 : 0) + 5], P, 0, 0, 0); \
            P = __builtin_amdgcn_mfma_f32_32x32x16_bf16(k6, qr[(OFF >= 16384 ? 8 : 0) + 6], P, 0, 0, 0); P = __builtin_amdgcn_mfma_f32_32x32x16_bf16(k7, qr[(OFF >= 16384 ? 8 : 0) + 7], P, 0, 0, 0); SBAR(); } while (0)
#define RO_SCORES(SLOT, KT) do { f32x16 p0, p1; \
            _Pragma("unroll") for (int r = 0; r < 16; ++r) { p0[r] = 0.f; p1[r] = 0.f; } \
            { const int kb_ = opaque(ka0) + (SLOT) * 32768; RO_QKCHAIN(p0, kb_, 0); RO_QKCHAIN(p0, kb_, 16384); const int kc_ = opaque(kb_) + 8192; RO_QKCHAIN(p1, kc_, 0); RO_QKCHAIN(p1, kc_, 16384); } \
            const float df = (float)(opaque(ii) - 64 * (KT) - 4 * opaque(hi)); \
            _Pragma("unroll") for (int r = 0; r < 16; ++r) { const float d0_ = df - (float)((r & 3) + 8 * (r >> 2)), d1_ = d0_ - 32.f; \
                p0[r] *= __builtin_amdgcn_exp2f(d0_ >= 0.f ? lgf2 * d0_ : -lgb2 * d0_); p1[r] *= __builtin_amdgcn_exp2f(d1_ >= 0.f ? lgf2 * d1_ : -lgb2 * d1_); } \
            pack_p(p0, p1, pa0, pa1, pa2, pa3); } while (0)
#define RO_BRD(D0, L0, H0, L1, H1, L2, H2, L3, H3) const s16x4 L0 = tr_read<vro(D0, 0, 0)>(vb_), H0 = tr_read<vro(D0, 0, 1)>(vb_), L1 = tr_read<vro(D0, 1, 0)>(vb_), H1 = tr_read<vro(D0, 1, 1)>(vb_), \
            L2 = tr_read<vro(D0, 2, 0)>(vb_), H2 = tr_read<vro(D0, 2, 1)>(vb_), L3 = tr_read<vro(D0, 3, 0)>(vb_), H3 = tr_read<vro(D0, 3, 1)>(vb_)
#define RO_BMM(ACC, A0, A1, A2, A3, L0, H0, L1, H1, L2, H2, L3, H3) do { ACC = __builtin_amdgcn_mfma_f32_32x32x16_bf16(A0, MX_PK(L0, H0), ACC, 0, 0, 0); ACC = __builtin_amdgcn_mfma_f32_32x32x16_bf16(A1, MX_PK(L1, H1), ACC, 0, 0, 0); \
            ACC = __builtin_amdgcn_mfma_f32_32x32x16_bf16(A2, MX_PK(L2, H2), ACC, 0, 0, 0); ACC = __builtin_amdgcn_mfma_f32_32x32x16_bf16(A3, MX_PK(L3, H3), ACC, 0, 0, 0); } while (0)
#define RO_MUL(ACC, SLOT, A0, A1, A2, A3) do { const int vb_ = opaque(vb0) + (SLOT) * 32768; \
            RO_BRD(0, a_l0, a_h0, a_l1, a_h1, a_l2, a_h2, a_l3, a_h3); RO_BRD(1, b_l0, b_h0, b_l1, b_h1, b_l2, b_h2, b_l3, b_h3); \
            asm volatile("s_waitcnt lgkmcnt(8)" ::: "memory"); SBAR(); RO_BMM(ACC[0], A0, A1, A2, A3, a_l0, a_h0, a_l1, a_h1, a_l2, a_h2, a_l3, a_h3); SBAR(); \
            RO_BRD(2, c_l0, c_h0, c_l1, c_h1, c_l2, c_h2, c_l3, c_h3); \
            asm volatile("s_waitcnt lgkmcnt(8)" ::: "memory"); SBAR(); RO_BMM(ACC[1], A0, A1, A2, A3, b_l0, b_h0, b_l1, b_h1, b_l2, b_h2, b_l3, b_h3); SBAR(); \
            RO_BRD(3, d_l0, d_h0, d_l1, d_h1, d_l2, d_h2, d_l3, d_h3); \
            asm volatile("s_waitcnt lgkmcnt(8)" ::: "memory"); SBAR(); RO_BMM(ACC[2], A0, A1, A2, A3, c_l0, c_h0, c_l1, c_h1, c_l2, c_h2, c_l3, c_h3); SBAR(); \
            asm volatile("s_waitcnt lgkmcnt(0)" ::: "memory"); SBAR(); RO_BMM(ACC[3], A0, A1, A2, A3, d_l0, d_h0, d_l1, d_h1, d_l2, d_h2, d_l3, d_h3); } while (0)
#define RO_QSC(DST, SRC, F) do { const u32x4 w_ = *reinterpret_cast<const u32x4*>(&(SRC)); u32x4 x_; x_.x = cvtpk(bflo(w_.x) * (F), bfhi(w_.x) * (F)); x_.y = cvtpk(bflo(w_.y) * (F), bfhi(w_.y) * (F)); \
            x_.z = cvtpk(bflo(w_.z) * (F), bfhi(w_.z) * (F)); x_.w = cvtpk(bflo(w_.w) * (F), bfhi(w_.w) * (F)); DST = *reinterpret_cast<bf16x8*>(&x_); } while (0)
#define RO_STATE(SLOT, DT, F) do { bf16x8 q0_, q1_, q2_, q3_; RO_QSC(q0_, qr[4 * (DT)], F); RO_QSC(q1_, qr[4 * (DT) + 1], F); RO_QSC(q2_, qr[4 * (DT) + 2], F); RO_QSC(q3_, qr[4 * (DT) + 3], F); RO_MUL(o, SLOT, q0_, q1_, q2_, q3_); } while (0)
        RO_OPEN(0); RO_SCORES(0, 0);
        RO_OPEN(1); RO_MUL(o, 1, pa0, pa1, pa2, pa3);
        RO_OPEN(2); RO_SCORES(2, 1);
        RO_OPEN(3); RO_MUL(o, 3, pa0, pa1, pa2, pa3);
        { const float ff = __builtin_amdgcn_exp2f(lgf2 * (float)(opaque(ii) + 1));
          RO_OPEN(4); RO_STATE(0, 0, ff);
          RO_OPEN(5); RO_STATE(1, 1, ff);
          RO_OPEN(6); RO_STATE(2, 2, ff);
          RO_OPEN(7); RO_STATE(3, 3, ff); }
        { const float fb = __builtin_amdgcn_exp2f(lgb2 * (float)(128 - opaque(ii)));
          RO_OPEN(8); RO_STATE(0, 0, fb);
          RO_OPEN(9); RO_STATE(1, 1, fb);
          RO_OPEN(10); RO_STATE(2, 2, fb);
          RO_OPEN(11); RO_STATE(3, 3, fb); }
        { const int hio = opaque(hi), r32o = opaque(r32);
#pragma unroll
          for (int r = 0; r < 16; ++r) { float ss = 0.f;
#pragma unroll
              for (int d = 0; d < 4; ++d) ss += o[d][r] * o[d][r];
              ss = half_sum(ss);
              if (r32 == 0) ssl[(rb * 2 + dh) * 32 + crow(r, hio)] = ss; }
          LDS_WAIT(); BARF();
#pragma unroll
          for (int r = 0; r < 16; ++r) { const int rw = crow(r, hio); const float tot = ssl[(rb * 2) * 32 + rw] + ssl[(rb * 2 + 1) * 32 + rw]; const float rs = 1.0f / sqrtf(tot * (1.f / 256.f) + EPS);
              const size_t gi = hb + (size_t)(32 * rb + rw) * 256 + 128 * dh + r32o, go = (size_t)(r0 + 32 * rb + rw) * D + cu.h * 256 + 128 * dh + r32o;
#pragma unroll
              for (int d = 0; d < 4; ++d) { const float g = __uint_as_float((unsigned)Gg[gi + d * 32] << 16); Og[go + d * 32] = (bf16)f2bf(o[d][r] * rs * g); } }
          asm volatile("s_waitcnt vmcnt(0) lgkmcnt(0)" ::: "memory"); BARF(); }
        cu = nu;
    }
#undef RO_ISSUE
#undef RO_OPEN
#undef RO_QKCHAIN
#undef RO_SCORES
#undef RO_BRD
#undef RO_BMM
#undef RO_MUL
#undef RO_QSC
#undef RO_STATE
}

#ifndef MK_N_LAUNCHES
#define MK_N_LAUNCHES 1
#endif
#ifndef WGM_P1
#define WGM_P1 4
#endif
#ifndef WGM_SQ
#define WGM_SQ 4
#endif
#ifndef WGM_P9
#define WGM_P9 4
#endif
#ifndef WGM_P10
#define WGM_P10 4
#endif
constexpr int NPH = 12;
struct Args { const float* in[15]; float* out; unsigned char* ws; int ph_lo, ph_hi, flags, pad; };
__global__ void __launch_bounds__(NWAVES * 64, 2) fwd(Args args) {
    extern __shared__ __attribute__((aligned(16))) unsigned char lds_raw[];
    Frame F;
    F.lds = (lchar*)lds_raw; F.MISC = (volatile LAS unsigned*)(F.lds + MISC_OFF);
    F.tid = threadIdx.x; F.lane = F.tid & 63; F.wave = __builtin_amdgcn_readfirstlane(F.tid >> 6);
    F.G = gridDim.x; { const int bx = blockIdx.x; F.vcu = (F.G % 8 == 0) ? (bx % 8) * (F.G / 8) + bx / 8 : bx; }
    F.ws = args.ws; F.ctl = (unsigned*)(args.ws + WS_CTL); F.out = args.out;
#pragma unroll
    for (int i = 0; i < 15; ++i) F.in[i] = args.in[i];
    if (F.tid < 64) ((LAS unsigned*)(F.lds + MISC_OFF))[F.tid] = 0u;
    __syncthreads();
    const int lo = args.ph_lo, hi = args.ph_hi;
    XcdBarrier bar; bar.bar = F.ctl + CW_BAR; bar.x = 0; bar.st = nullptr;
    if (hi - lo > 1) bar = xcd_barrier_post(F.ctl + CW_BAR, F.MISC + 8);
#ifndef PH_MASK
#define PH_MASK 0xFFF
#endif
#define IN(k) (((PH_MASK >> (k)) & 1) && lo <= (k) && (k) < hi)
#define SEAM(k) do { if (IN(k) && IN((k) + 1)) xcd_barrier(bar); } while (0)
    bf16* WIN = (bf16*)(F.ws + WS_WIN); bf16* WBR = (bf16*)(F.ws + WS_WBR); bf16* WBD = (bf16*)(F.ws + WS_WBD); bf16* WO = (bf16*)(F.ws + WS_WO); bf16* WGU = (bf16*)(F.ws + WS_WGU); bf16* WDN = (bf16*)(F.ws + WS_WDN);
    bf16* U = (bf16*)(F.ws + WS_U); bf16* PROJ = (bf16*)(F.ws + WS_PROJ); bf16* ST = (bf16*)(F.ws + WS_ST);
    bf16* MIXED = (bf16*)(F.ws + WS_MIXED); bf16* U2 = (bf16*)(F.ws + WS_U2); bf16* ACT = (bf16*)(F.ws + WS_ACT);
    bf16* G_RQ = PROJ, *G_RK = PROJ + GS, *G_RV = PROJ + 2 * GS, *G_RG = PROJ + 3 * GS, *G_DQ = PROJ + 4 * GS, *G_DK = PROJ + 5 * GS, *G_DV = PROJ + 6 * GS, *G_GA = PROJ + 7 * GS, *G_GB = PROJ + 8 * GS;

    if (IN(0)) { p0_prologue(F); __syncthreads(); }
    SEAM(0);
    if (IN(1)) { pg8::Gemm g{U, WIN, NX, DIN, D}; pg8::StaticOrder S; S.init(NX, DIN, F.G, (int)blockIdx.x, WGM_P1);
        pg8::EpiProj E{PROJ, GS};
        pg8::gemm_phase<pg8::EpiProj, pg8::StaticOrder, true, true>((PG8_LAS unsigned char*)F.lds, g, S, E);
        __syncthreads();
        meta_proj(F.lds, U, WIN, PROJ, F.vcu, F.G); }
    SEAM(1);
    if (IN(2)) {
        normmax_phase(F, G_DQ, G_DK, F.ctl + CW_NRM);
        for (int id = F.vcu; id < 2048; id += F.G) { const int bh = id >> 6, c = id & 63, h = bh & 15;
            const float lgf2 = -expf(F.in[4][h]) * LOG2E, lgb2 = -expf(F.in[4][NH + h]) * LOG2E;
            ret_local_unit(F.lds, G_RK, G_RV, ST, bh >> 4, h, c, lgf2, lgb2); }
    }
    SEAM(2);
    if (IN(3)) ret_scan(F, G_RK, G_RV, ST, F.in[4]);
    SEAM(3);
    if (IN(4)) {
        float lam; { const float* lp = F.in[5]; const float a = wave_sum(lp[F.lane] * lp[128 + F.lane] + lp[64 + F.lane] * lp[192 + F.lane]), c = wave_sum(lp[256 + F.lane] * lp[384 + F.lane] + lp[320 + F.lane] * lp[448 + F.lane]);
            lam = expf(a) - expf(c) + 0.2f; }
        float* stash = F.out + (size_t)blockIdx.x * 65536;
        const bool w_first = (((int)blockIdx.x >> 3) & 1) == 0;
        if (w_first) { p0_items(F, I_IN, P0_NITEMS, mx::opaque((int)threadIdx.x) & 63); __syncthreads(); }
        for (int id = F.vcu; id < 1024; id += F.G) { const int bh = id >> 5, b = bh >> 4, hh = bh & 15, px = hh & 7, xp = (b == 0) ? px : (int)((0x32017645u >> (4 * px)) & 7u), h = (hh < 8) ? xp : 15 - xp, qb = ((id & 31) + 16 * b) & 31;
            attn_unit(F.lds, G_DQ, G_DK, G_DV, G_DQ, stash, F.in[6], F.ctl + CW_NRM, b, h, qb, lam); }
        if (!w_first) { __syncthreads(); p0_items(F, I_IN, P0_NITEMS, mx::opaque((int)threadIdx.x) & 63); }
    }
    SEAM(4);
    if (IN(5)) ret_out_phase(F.lds, G_RQ, G_RK, G_RV, G_RG, ST, (bf16*)(F.ws + WS_YR), F.in[4], F.vcu, F.G);
    SEAM(5);
    if (IN(6)) { pg8::Gemm g{(const bf16*)(F.ws + WS_YR), WBR, NX, D, D}, g2{G_DQ, WBD, NX, D, D}; pg8::StaticOrder S; S.init(NX, D, F.G, (int)blockIdx.x, WGM_SQ); pg8::EpiMix2 E{G_GA, G_GB, MIXED};
        pg8::gemm_phase2<pg8::EpiMix2, pg8::StaticOrder, true, true>((PG8_LAS unsigned char*)F.lds, g, g2, S, E); }
    SEAM(6);
    if (IN(7)) { pg8::Gemm g{MIXED, WO, NX, D, D}; pg8::StaticOrder S; S.init(NX, D, F.G, (int)blockIdx.x, WGM_SQ); pg8::EpiResBf E{F.in[0], U2, (float*)(F.ws + WS_PS)};
        pg8::gemm_phase<pg8::EpiResBf, pg8::StaticOrder, true, true>((PG8_LAS unsigned char*)F.lds, g, S, E); }
    SEAM(7);
    if (IN(8)) { const float* PS = (const float*)(F.ws + WS_PS); float* RS = (float*)(F.ws + WS_RSTD);
        for (int row = F.vcu * 512 + F.tid; row < NX; row += F.G * 512) { const pg8::f32x4* p = (const pg8::f32x4*)(PS + (size_t)row * 64); float s = 0.f;
#pragma unroll
            for (int j = 0; j < 16; ++j) { const pg8::f32x4 v = p[j]; s += (v[0] + v[1]) + (v[2] + v[3]); }
            RS[row] = 1.0f / sqrtf(s * (1.f / D) + EPS); } }
    SEAM(8);
    if (IN(9)) { pg8::Gemm g{U2, WGU, NX, 2 * DFF, D}; pg8::StaticOrder S; S.init(NX, 2 * DFF, F.G, (int)blockIdx.x, WGM_P9); pg8::EpiSwiGLUr E{ACT, DFF, (const float*)(F.ws + WS_RSTD)};
        pg8::gemm_phase<pg8::EpiSwiGLUr, pg8::StaticOrder, true, true>((PG8_LAS unsigned char*)F.lds, g, S, E); }
    SEAM(9);
    if (IN(10)) { pg8::Gemm g{ACT, WDN, NX, D, DFF}; pg8::StaticOrder S; S.init(NX, D, F.G, (int)blockIdx.x, WGM_P10); pg8::EpiResBf2 E{U2, (bf16*)(F.ws + WS_H2)};
        pg8::gemm_phase<pg8::EpiResBf2, pg8::StaticOrder, true, true>((PG8_LAS unsigned char*)F.lds, g, S, E); }
    SEAM(10);
    if (IN(11)) { const int gw = F.vcu * NWAVES + F.wave, NGW = F.G * NWAVES; const bf16* H2 = (const bf16*)(F.ws + WS_H2);
        for (int m = gw; m < NX; m += NGW) rms_row_bf(H2 + (size_t)m * D, F.in[14], F.out + (size_t)m * D, F.lane); }
#undef IN
#undef SEAM
}

extern "C" void kernel_launch(void* const* d_in, const int* in_sizes, int n_in, void* d_out, int out_size, void* d_ws, size_t ws_size, hipStream_t stream) {
    static int grid = 0;
    if (grid == 0) {
        if (n_in != 15 || in_sizes[0] != NX * D || out_size != NX * D || ws_size < WS_END) { fprintf(stderr, "kernel_launch: unexpected shapes (n_in %d, in0 %d, out %d, ws %zu)\n", n_in, n_in > 0 ? in_sizes[0] : -1, out_size, ws_size); grid = -1; return; }
        int dev = 0, cus = 0, per_cu = 0;
        if (hipGetDevice(&dev) != hipSuccess || hipDeviceGetAttribute(&cus, hipDeviceAttributeMultiprocessorCount, dev) != hipSuccess) { grid = -1; return; }
        if (hipFuncSetAttribute((const void*)fwd, hipFuncAttributeMaxDynamicSharedMemorySize, LDS_BYTES) != hipSuccess) { fprintf(stderr, "kernel_launch: hipFuncSetAttribute failed\n"); grid = -1; return; }
        if (hipOccupancyMaxActiveBlocksPerMultiprocessor(&per_cu, (const void*)fwd, NWAVES * 64, LDS_BYTES) != hipSuccess || per_cu < 1) fprintf(stderr, "kernel_launch: occupancy query reports %d\n", per_cu);
        (void)hipGetLastError();
        grid = cus;
    }
    if (grid < 0) return;
    if (hipMemsetAsync((char*)d_ws + WS_CTL, 0, CTL_ZERO_BYTES, stream) != hipSuccess) return;
    Args a{};
    for (int i = 0; i < 15; ++i) a.in[i] = (const float*)d_in[i];
    a.out = (float*)d_out; a.ws = (unsigned char*)d_ws;
#if MK_N_LAUNCHES == 1
    a.ph_lo = 0; a.ph_hi = NPH;
    hipLaunchKernelGGL(fwd, dim3(grid), dim3(NWAVES * 64), LDS_BYTES, stream, a);
#else
    for (int p = 0; p < NPH; ++p) { a.ph_lo = p; a.ph_hi = p + 1;
        hipLaunchKernelGGL(fwd, dim3(grid), dim3(NWAVES * 64), LDS_BYTES, stream, a); }
#endif
    const hipError_t le = hipPeekAtLastError();
    if (le != hipSuccess) fprintf(stderr, "kernel_launch: launch failed: %s\n", hipGetErrorName(le));
}
```

```cpp
#include <hip/hip_runtime.h>
#include <cstdio>
#include <cstdint>
#define LAS __attribute__((address_space(3)))
namespace pg8 {
#define PG8_LAS __attribute__((address_space(3)))
typedef unsigned short bf16_t;
typedef short bf16x8 __attribute__((ext_vector_type(8)));
typedef float f32x4 __attribute__((ext_vector_type(4)));
typedef unsigned u32x4 __attribute__((ext_vector_type(4)));
constexpr int BM = 256, BK = 64, HALF = 128, HTB = HALF * BK * 2  , STAGE_BYTES = 8 * HTB, NXCD = 8, WGM = 8;

__host__ __device__ __forceinline__ int lds_byte(int r, int c) { const int st = (r >> 4) * 2 + (c >> 5), rr = r & 15, cc = c & 31, ob = rr * 64 + cc * 2; return st * 1024 + (ob ^ (((ob >> 9) & 1) << 5)); }
__host__ __device__ __forceinline__ void stage_rc(int b, int& R, int& C) { const int st = b / 1024, sb = b % 1024, swz = sb ^ (((sb >> 9) & 1) << 5); R = (st >> 1) * 16 + swz / 64; C = (st & 1) * 32 + (swz % 64) / 2; }
__host__ __device__ __forceinline__ int perm32(int rho) { const int n = rho >> 4, i = rho & 15; return 8 * (i >> 2) + 4 * n + (i & 3); }

struct Unit { int pm, pn; };
struct Gemm { const bf16_t* A; const bf16_t* Bt; int M, N, K; };

struct StaticOrder {
    int nM, nN, nwg, G, c, wgm = WGM;
    __host__ __device__ void init(int M, int N, int G_, int c_, int wgm_ = WGM) { nM = M / BM; nN = N / BM; nwg = nM * nN; G = G_; c = c_; wgm = wgm_; }
    __host__ __device__ bool next(int i, Unit& u) const {
        const long L = (long)i * G + c; if (L >= nwg) return false;
        int wgid = (int)L; { const int q = nwg / NXCD, r = nwg % NXCD, xcd = wgid % NXCD, off = wgid / NXCD; wgid = (xcd < r ? xcd * (q + 1) : r * (q + 1) + (xcd - r) * q) + off; }
        const int nig = wgm * nN, gid = wgid / nig, fm = gid * wgm, gsz = (nM - fm) < wgm ? (nM - fm) : wgm;
        u.pm = fm + ((wgid % nig) % gsz); u.pn = (wgid % nig) / gsz; return true;
    }
    __device__ __forceinline__ void a_ready(const Unit&) const {}
    __device__ __forceinline__ void done(const Unit&) const {}
};

__device__ __forceinline__ unsigned cvt_pk_bf16(float lo, float hi) { unsigned r; asm volatile("v_cvt_pk_bf16_f32 %0, %1, %2" : "=v"(r) : "v"(lo), "v"(hi)); return r; }
typedef float f32x2 __attribute__((ext_vector_type(2)));
__device__ __forceinline__ float sigmoid_f(float x) { return __builtin_amdgcn_rcpf(1.0f + __builtin_amdgcn_exp2f(-1.4426950408889634f * x)); }
__device__ __forceinline__ float silu_f(float x) { return x * sigmoid_f(x); }
__device__ __forceinline__ float bf_lo(unsigned w) { return __uint_as_float(w << 16); }
__device__ __forceinline__ float bf_hi(unsigned w) { return __uint_as_float(w & 0xffff0000u); }

struct EpiProj {
    static constexpr bool PERM = true, AFTER_DRAIN = false;
    bf16_t* P; size_t gstride;
    __device__ __forceinline__ void operator()(const f32x4 (&acc)[2][2][4][2], const Unit& u, int wr, int wc, int fr, int fq) const {
        const int t = (u.pn * BM) >> 12, colt = (u.pn * BM) & 4095;
        bf16_t* base = P + (size_t)t * gstride;
        const int mode = (t == 1) ? 1 : (t == 3) ? 2 : (t >= 7) ? 3 : 0;
        const bool hm = t < 4; const int pitch = hm ? 256 : 4096;
        const size_t org = hm ? ((size_t)(((u.pm >> 5) * 16 + (colt >> 8)) * 8192 + (u.pm & 31) * 256) * 256) : ((size_t)(u.pm * BM) * 4096 + colt);
        const int rloc = wr * 64 + fr, col0 = wc * 32 + 8 * fq;
#pragma unroll
        for (int ai = 0; ai < 2; ++ai)
#pragma unroll
            for (int m = 0; m < 4; ++m) { bf16_t* rowp = base + org + (size_t)(rloc + ai * HALF + m * 16) * pitch + col0;
#pragma unroll
                for (int bj = 0; bj < 2; ++bj) { f32x4 v0 = acc[ai][bj][m][0], v1 = acc[ai][bj][m][1];
                    if (mode == 1) { v0 = v0 * 0.0625f; v1 = v1 * 0.0625f; }
                    else if (mode == 2) {
#pragma unroll
                        for (int j = 0; j < 4; ++j) { v0[j] = silu_f(v0[j]); v1[j] = silu_f(v1[j]); } }
                    else if (mode == 3) {
#pragma unroll
                        for (int j = 0; j < 4; ++j) { v0[j] = sigmoid_f(v0[j]); v1[j] = sigmoid_f(v1[j]); } }
                    u32x4 w; w.x = cvt_pk_bf16(v0[0], v0[1]); w.y = cvt_pk_bf16(v0[2], v0[3]); w.z = cvt_pk_bf16(v1[0], v1[1]); w.w = cvt_pk_bf16(v1[2], v1[3]);
                    *(u32x4*)(rowp + bj * HALF) = w; } }
    }
};
struct EpiGateT {
    static constexpr bool PERM = true, AFTER_DRAIN = false;
    const bf16_t* G; float* T;
    __device__ __forceinline__ void operator()(const f32x4 (&acc)[2][2][4][2], const Unit& u, int wr, int wc, int fr, int fq) const {
        const int row0 = u.pm * BM + wr * 64 + fr, col0 = u.pn * BM + wc * 32 + 8 * fq;
#pragma unroll
        for (int ai = 0; ai < 2; ++ai)
#pragma unroll
            for (int m = 0; m < 4; ++m) { const size_t off = (size_t)(row0 + ai * HALF + m * 16) * 4096 + col0;
#pragma unroll
                for (int bj = 0; bj < 2; ++bj) { const u32x4 g = *(const u32x4*)(G + off + bj * HALF);
                    const f32x4 g0 = {bf_lo(g.x), bf_hi(g.x), bf_lo(g.y), bf_hi(g.y)}, g1 = {bf_lo(g.z), bf_hi(g.z), bf_lo(g.w), bf_hi(g.w)};
                    *(f32x4*)(T + off + bj * HALF) = acc[ai][bj][m][0] * g0; *(f32x4*)(T + off + bj * HALF + 4) = acc[ai][bj][m][1] * g1; } }
    }
};
struct EpiMix {
    static constexpr bool PERM = true, AFTER_DRAIN = false;
    const bf16_t* G; const float* T; bf16_t* O;
    __device__ __forceinline__ void operator()(const f32x4 (&acc)[2][2][4][2], const Unit& u, int wr, int wc, int fr, int fq) const {
        const int row0 = u.pm * BM + wr * 64 + fr, col0 = u.pn * BM + wc * 32 + 8 * fq;
#pragma unroll
        for (int ai = 0; ai < 2; ++ai)
#pragma unroll
            for (int m = 0; m < 4; ++m) { const size_t off = (size_t)(row0 + ai * HALF + m * 16) * 4096 + col0;
#pragma unroll
                for (int bj = 0; bj < 2; ++bj) { const u32x4 g = *(const u32x4*)(G + off + bj * HALF);
                    const f32x4 g0 = {bf_lo(g.x), bf_hi(g.x), bf_lo(g.y), bf_hi(g.y)}, g1 = {bf_lo(g.z), bf_hi(g.z), bf_lo(g.w), bf_hi(g.w)};
                    const f32x4 t0 = *(const f32x4*)(T + off + bj * HALF), t1 = *(const f32x4*)(T + off + bj * HALF + 4);
                    const f32x4 v0 = t0 + acc[ai][bj][m][0] * g0, v1 = t1 + acc[ai][bj][m][1] * g1;
                    u32x4 w; w.x = cvt_pk_bf16(v0[0], v0[1]); w.y = cvt_pk_bf16(v0[2], v0[3]); w.z = cvt_pk_bf16(v1[0], v1[1]); w.w = cvt_pk_bf16(v1[2], v1[3]);
                    *(u32x4*)(O + off + bj * HALF) = w; } }
    }
};
struct EpiRes {
    static constexpr bool PERM = false, AFTER_DRAIN = false;
    const float* R; float* C; int ldc;
    __device__ __forceinline__ void operator()(const f32x4 (&acc)[2][2][4][2], const Unit& u, int wr, int wc, int fr, int fq) const {
        const int row0 = u.pm * BM + wr * 64 + fr, col0 = u.pn * BM + wc * 32 + 4 * fq;
#pragma unroll
        for (int ai = 0; ai < 2; ++ai)
#pragma unroll
            for (int m = 0; m < 4; ++m) { const size_t off = (size_t)(row0 + ai * HALF + m * 16) * ldc + col0;
#pragma unroll
                for (int bj = 0; bj < 2; ++bj)
#pragma unroll
                    for (int n = 0; n < 2; ++n) { const f32x4 r = *(const f32x4*)(R + off + bj * HALF + n * 16); *(f32x4*)(C + off + bj * HALF + n * 16) = r + acc[ai][bj][m][n]; } }
    }
};
struct EpiSwiGLU {
    static constexpr bool PERM = true, AFTER_DRAIN = false;
    bf16_t* O; int ldc;
    __device__ __forceinline__ void operator()(const f32x4 (&acc)[2][2][4][2], const Unit& u, int wr, int wc, int fr, int fq) const {
        const int row0 = u.pm * BM + wr * 64 + fr, col0 = u.pn * HALF + wc * 32 + 8 * fq;
#pragma unroll
        for (int ai = 0; ai < 2; ++ai)
#pragma unroll
            for (int m = 0; m < 4; ++m) { bf16_t* rowp = O + (size_t)(row0 + ai * HALF + m * 16) * ldc + col0;
                f32x4 v0, v1;
#pragma unroll
                for (int j = 0; j < 4; ++j) { v0[j] = silu_f(acc[ai][0][m][0][j]) * acc[ai][1][m][0][j]; v1[j] = silu_f(acc[ai][0][m][1][j]) * acc[ai][1][m][1][j]; }
                u32x4 w; w.x = cvt_pk_bf16(v0[0], v0[1]); w.y = cvt_pk_bf16(v0[2], v0[3]); w.z = cvt_pk_bf16(v1[0], v1[1]); w.w = cvt_pk_bf16(v1[2], v1[3]);
                *(u32x4*)rowp = w; }
    }
};

#define GBC(x) fmaxf((x), 7.888609e-31f)
#define GBR(x) __builtin_amdgcn_rcpf(GBC(x))
struct EpiMix2 {
    static constexpr bool PERM = true, AFTER_DRAIN = false;
    const bf16_t* GA; const bf16_t* GB; bf16_t* O;
    __device__ __forceinline__ void mid(f32x4 (&acc)[2][2][4][2], const Unit& u, int wr, int wc, int fr, int fq) const {
        const int row0 = u.pm * BM + wr * 64 + fr, col0 = u.pn * BM + wc * 32 + 8 * fq;
#pragma unroll
        for (int ai = 0; ai < 2; ++ai)
#pragma unroll
            for (int m = 0; m < 4; ++m) { const size_t off = (size_t)(row0 + ai * HALF + m * 16) * 4096 + col0;
#pragma unroll
                for (int bj = 0; bj < 2; ++bj) { const u32x4 a = *(const u32x4*)(GA + off + bj * HALF), b = *(const u32x4*)(GB + off + bj * HALF);
                    const f32x4 r0 = {bf_lo(a.x) * GBR(bf_lo(b.x)), bf_hi(a.x) * GBR(bf_hi(b.x)), bf_lo(a.y) * GBR(bf_lo(b.y)), bf_hi(a.y) * GBR(bf_hi(b.y))};
                    const f32x4 r1 = {bf_lo(a.z) * GBR(bf_lo(b.z)), bf_hi(a.z) * GBR(bf_hi(b.z)), bf_lo(a.w) * GBR(bf_lo(b.w)), bf_hi(a.w) * GBR(bf_hi(b.w))};
                    acc[ai][bj][m][0] = acc[ai][bj][m][0] * r0; acc[ai][bj][m][1] = acc[ai][bj][m][1] * r1; } }
    }
    __device__ __forceinline__ void operator()(const f32x4 (&acc)[2][2][4][2], const Unit& u, int wr, int wc, int fr, int fq) const {
        const int row0 = u.pm * BM + wr * 64 + fr, col0 = u.pn * BM + wc * 32 + 8 * fq;
#pragma unroll
        for (int ai = 0; ai < 2; ++ai)
#pragma unroll
            for (int m = 0; m < 4; ++m) { const size_t off = (size_t)(row0 + ai * HALF + m * 16) * 4096 + col0;
#pragma unroll
                for (int bj = 0; bj < 2; ++bj) { const u32x4 g = *(const u32x4*)(GB + off + bj * HALF);
                    const f32x4 g0 = {GBC(bf_lo(g.x)), GBC(bf_hi(g.x)), GBC(bf_lo(g.y)), GBC(bf_hi(g.y))}, g1 = {GBC(bf_lo(g.z)), GBC(bf_hi(g.z)), GBC(bf_lo(g.w)), GBC(bf_hi(g.w))};
                    const f32x4 v0 = acc[ai][bj][m][0] * g0, v1 = acc[ai][bj][m][1] * g1;
                    u32x4 w; w.x = cvt_pk_bf16(v0[0], v0[1]); w.y = cvt_pk_bf16(v0[2], v0[3]); w.z = cvt_pk_bf16(v1[0], v1[1]); w.w = cvt_pk_bf16(v1[2], v1[3]);
                    *(u32x4*)(O + off + bj * HALF) = w; } }
    }
};
#undef GBC
#undef GBR

struct EpiResBf {
    static constexpr bool PERM = true, AFTER_DRAIN = false;
    const float* X; bf16_t* O; float* PS;
    __device__ __forceinline__ void operator()(const f32x4 (&acc)[2][2][4][2], const Unit& u, int wr, int wc, int fr, int fq) const {
        const int row0 = u.pm * BM + wr * 64 + fr, col0 = u.pn * BM + wc * 32 + 8 * fq;
#pragma unroll
        for (int ai = 0; ai < 2; ++ai)
#pragma unroll
            for (int m = 0; m < 4; ++m) { const int row = row0 + ai * HALF + m * 16; const size_t off = (size_t)row * 4096 + col0; float ss = 0.f;
#pragma unroll
                for (int bj = 0; bj < 2; ++bj) { const f32x4 x0 = *(const f32x4*)(X + off + bj * HALF), x1 = *(const f32x4*)(X + off + bj * HALF + 4);
                    const f32x4 v0 = x0 + acc[ai][bj][m][0], v1 = x1 + acc[ai][bj][m][1];
                    ss += (v0[0] * v0[0] + v0[1] * v0[1]) + (v0[2] * v0[2] + v0[3] * v0[3]) + (v1[0] * v1[0] + v1[1] * v1[1]) + (v1[2] * v1[2] + v1[3] * v1[3]);
                    u32x4 w; w.x = cvt_pk_bf16(v0[0], v0[1]); w.y = cvt_pk_bf16(v0[2], v0[3]); w.z = cvt_pk_bf16(v1[0], v1[1]); w.w = cvt_pk_bf16(v1[2], v1[3]);
                    *(u32x4*)(O + off + bj * HALF) = w; }
                ss += __shfl_xor(ss, 16); ss += __shfl_xor(ss, 32);
                if (fq == 0) PS[(size_t)row * 64 + u.pn * 4 + wc] = ss; }
    }
};
struct EpiSwiGLUr {
    static constexpr bool PERM = true, AFTER_DRAIN = false;
    bf16_t* O; int ldc; const float* RSTD;
    __device__ __forceinline__ void operator()(const f32x4 (&acc)[2][2][4][2], const Unit& u, int wr, int wc, int fr, int fq) const {
        const int row0 = u.pm * BM + wr * 64 + fr, col0 = u.pn * HALF + wc * 32 + 8 * fq;
#pragma unroll
        for (int ai = 0; ai < 2; ++ai)
#pragma unroll
            for (int m = 0; m < 4; ++m) { const int row = row0 + ai * HALF + m * 16; bf16_t* rowp = O + (size_t)row * ldc + col0; const float r = RSTD[row];
                f32x4 v0, v1;
#pragma unroll
                for (int j = 0; j < 4; ++j) { v0[j] = silu_f(acc[ai][0][m][0][j] * r) * (acc[ai][1][m][0][j] * r); v1[j] = silu_f(acc[ai][0][m][1][j] * r) * (acc[ai][1][m][1][j] * r); }
                u32x4 w; w.x = cvt_pk_bf16(v0[0], v0[1]); w.y = cvt_pk_bf16(v0[2], v0[3]); w.z = cvt_pk_bf16(v1[0], v1[1]); w.w = cvt_pk_bf16(v1[2], v1[3]);
                *(u32x4*)rowp = w; }
    }
};
struct EpiResBf2 {
    static constexpr bool PERM = true, AFTER_DRAIN = false;
    const bf16_t* R; bf16_t* O;
    __device__ __forceinline__ void operator()(const f32x4 (&acc)[2][2][4][2], const Unit& u, int wr, int wc, int fr, int fq) const {
        const int row0 = u.pm * BM + wr * 64 + fr, col0 = u.pn * BM + wc * 32 + 8 * fq;
#pragma unroll
        for (int ai = 0; ai < 2; ++ai)
#pragma unroll
            for (int m = 0; m < 4; ++m) { const size_t off = (size_t)(row0 + ai * HALF + m * 16) * 4096 + col0;
#pragma unroll
                for (int bj = 0; bj < 2; ++bj) { const u32x4 r = *(const u32x4*)(R + off + bj * HALF);
                    const f32x4 v0 = acc[ai][bj][m][0] + (f32x4){bf_lo(r.x), bf_hi(r.x), bf_lo(r.y), bf_hi(r.y)}, v1 = acc[ai][bj][m][1] + (f32x4){bf_lo(r.z), bf_hi(r.z), bf_lo(r.w), bf_hi(r.w)};
                    u32x4 w; w.x = cvt_pk_bf16(v0[0], v0[1]); w.y = cvt_pk_bf16(v0[2], v0[3]); w.z = cvt_pk_bf16(v1[0], v1[1]); w.w = cvt_pk_bf16(v1[2], v1[3]);
                    *(u32x4*)(O + off + bj * HALF) = w; } }
    }
};
template <class Epi, class Sched, bool ALIGN_EPI = false, bool SP2 = false>
__device__ __forceinline__ void gemm_phase(PG8_LAS unsigned char* lds, const Gemm g, const Sched& S, const Epi& E) {
    const int tid = threadIdx.x, wid = __builtin_amdgcn_readfirstlane(tid >> 6), lane = tid & 63, wr = wid >> 2, wc = wid & 3, fr = lane & 15, fq = lane >> 4;
    const int K = g.K, nt = K / BK;
    unsigned voffA[2], voffB[2];
#pragma unroll
    for (int i = 0; i < 2; ++i) { int R, C; stage_rc(tid * 16 + i * 8192, R, C); const int Rb = Epi::PERM ? ((R & ~31) + perm32(R & 31)) : R;
        voffA[i] = (unsigned)(R * K + C) * 2u; voffB[i] = (unsigned)(Rb * K + C) * 2u; }
    const size_t kstep = (size_t)(BK * 2);
    const size_t hstep = (size_t)HALF * K * 2;
    const size_t tstep = 2 * hstep;
    const unsigned ldsw = (unsigned)wid * 1024u;
    const int aoff = lds_byte(wr * 64 + fr, fq * 8), boff = lds_byte(wc * 32 + fr, fq * 8);
#define PG8_SA(b, h) (((b) * 2 + (h)) * HTB)
#define PG8_SB(b, h) ((4 + (b) * 2 + (h)) * HTB)
#define PG8_STAGE(bufoff, gbase, voff) do { _Pragma("unroll") for (int _i = 0; _i < 2; ++_i) \
        __builtin_amdgcn_global_load_lds((const unsigned*)((const char*)(gbase) + (voff)[_i]), (PG8_LAS unsigned*)(lds + (bufoff) + ldsw + _i * 8192), 16, 0, 0); } while (0)
#define PG8_LDA(dst, b, h) do { _Pragma("unroll") for (int m = 0; m < 4; ++m) _Pragma("unroll") for (int k = 0; k < 2; ++k) dst[m][k] = *(const PG8_LAS bf16x8*)(lds + PG8_SA(b, h) + aoff + m * 2048 + k * 1024); } while (0)
#define PG8_LDB(dst, b, h) do { _Pragma("unroll") for (int n = 0; n < 2; ++n) _Pragma("unroll") for (int k = 0; k < 2; ++k) dst[n][k] = *(const PG8_LAS bf16x8*)(lds + PG8_SB(b, h) + boff + n * 2048 + k * 1024); } while (0)
#define PG8_MMA(ai, bj, At, Bt) do { __builtin_amdgcn_s_setprio(1); _Pragma("unroll") for (int m = 0; m < 4; ++m) _Pragma("unroll") for (int n = 0; n < 2; ++n) _Pragma("unroll") for (int k = 0; k < 2; ++k) \
        acc[ai][bj][m][n] = __builtin_amdgcn_mfma_f32_16x16x32_bf16(Bt[n][k], At[m][k], acc[ai][bj][m][n], 0, 0, 0); __builtin_amdgcn_s_setprio(0); } while (0)
#define PG8_WAIT_V(n) asm volatile("s_waitcnt vmcnt(" #n ")" ::: "memory")
#define PG8_WAIT_L(n) asm volatile("s_waitcnt lgkmcnt(" #n ")" ::: "memory")
#define PG8_BAR __builtin_amdgcn_s_barrier()
#define PG8_SCHED __builtin_amdgcn_sched_barrier(0)
    Unit cur, nxt; int ui = 0;
    if (!S.next(0, cur)) return;
    f32x4 acc[2][2][4][2];
#pragma unroll
    for (int a = 0; a < 2; ++a)
#pragma unroll
        for (int b = 0; b < 2; ++b)
#pragma unroll
            for (int m = 0; m < 4; ++m)
#pragma unroll
                for (int n = 0; n < 2; ++n) acc[a][b][m][n] = (f32x4){0.f, 0.f, 0.f, 0.f};
    bf16x8 At[4][2], B0[2][2], B1[2][2];
    const char* cA = (const char*)g.A + (size_t)cur.pm * tstep; const char* cB = (const char*)g.Bt + (size_t)cur.pn * tstep;
    S.a_ready(cur);
    if constexpr (SP2) {
        PG8_STAGE(PG8_SB(0, 0), cB, voffB); PG8_STAGE(PG8_SB(0, 1), cB + hstep, voffB); PG8_STAGE(PG8_SA(0, 0), cA, voffA); PG8_STAGE(PG8_SA(0, 1), cA + hstep, voffA);
        if (wr == 1) PG8_BAR;
        PG8_WAIT_V(2); PG8_BAR;
        PG8_STAGE(PG8_SB(1, 0), cB + kstep, voffB); PG8_STAGE(PG8_SA(1, 0), cA + kstep, voffA); PG8_STAGE(PG8_SB(1, 1), cB + hstep + kstep, voffB);
        PG8_WAIT_V(6); PG8_BAR;
    } else {
        PG8_STAGE(PG8_SB(0, 0), cB, voffB); PG8_STAGE(PG8_SA(0, 0), cA, voffA); PG8_STAGE(PG8_SB(0, 1), cB + hstep, voffB); PG8_STAGE(PG8_SA(0, 1), cA + hstep, voffA);
        if (wr == 1) PG8_BAR;
        PG8_WAIT_V(4); PG8_BAR;
        PG8_STAGE(PG8_SB(1, 0), cB + kstep, voffB); PG8_STAGE(PG8_SA(1, 0), cA + kstep, voffA); PG8_STAGE(PG8_SB(1, 1), cB + hstep + kstep, voffB);
        PG8_WAIT_V(6); PG8_BAR;
    }
    for (;;) {
        const bool has_next = S.next(ui + 1, nxt);
        const char* nA = has_next ? (const char*)g.A + (size_t)nxt.pm * tstep : cA; const char* nB = has_next ? (const char*)g.Bt + (size_t)nxt.pn * tstep : cB;
        for (int t = 0; t < nt; t += 2) {
            const bool last = (t == nt - 2);
            const char* a1 = cA + (size_t)(t + 1) * kstep;
            const char* a2 = last ? nA : cA + (size_t)(t + 2) * kstep; const char* b2 = last ? nB : cB + (size_t)(t + 2) * kstep;
            const char* a3 = a2 + kstep; const char* b3 = b2 + kstep;
            if (last && has_next) S.a_ready(nxt);
            if constexpr (SP2) {
            PG8_LDB(B0, 0, 0); PG8_LDB(B1, 0, 1); PG8_SCHED; PG8_LDA(At, 0, 0); PG8_STAGE(PG8_SA(1, 1), a1 + hstep, voffA);
            PG8_WAIT_V(8); PG8_WAIT_L(0); PG8_BAR; PG8_MMA(0, 0, At, B0); PG8_MMA(0, 1, At, B1); PG8_BAR; PG8_SCHED;
            PG8_LDA(At, 0, 1); PG8_STAGE(PG8_SB(0, 0), b2, voffB); PG8_STAGE(PG8_SB(0, 1), b2 + hstep, voffB); PG8_STAGE(PG8_SA(0, 0), a2, voffA);
            PG8_WAIT_V(8); PG8_WAIT_L(0); PG8_BAR; PG8_MMA(1, 0, At, B0); PG8_MMA(1, 1, At, B1); PG8_BAR; PG8_SCHED;
            PG8_LDB(B0, 1, 0); PG8_LDB(B1, 1, 1); PG8_SCHED; PG8_LDA(At, 1, 0); PG8_STAGE(PG8_SA(0, 1), a2 + hstep, voffA);
            PG8_WAIT_V(8); PG8_WAIT_L(0); PG8_BAR; PG8_MMA(0, 0, At, B0); PG8_MMA(0, 1, At, B1); PG8_BAR; PG8_SCHED;
            PG8_LDA(At, 1, 1); PG8_STAGE(PG8_SB(1, 0), b3, voffB); PG8_STAGE(PG8_SB(1, 1), b3 + hstep, voffB); PG8_STAGE(PG8_SA(1, 0), a3, voffA);
            PG8_WAIT_V(8); PG8_WAIT_L(0); PG8_BAR; PG8_MMA(1, 0, At, B0); PG8_MMA(1, 1, At, B1); PG8_BAR; PG8_SCHED;
            } else {
            PG8_LDB(B0, 0, 0); PG8_SCHED; PG8_LDA(At, 0, 0); PG8_STAGE(PG8_SA(1, 1), a1 + hstep, voffA);
            PG8_WAIT_L(8); PG8_BAR; PG8_WAIT_L(0); PG8_MMA(0, 0, At, B0); PG8_BAR; PG8_SCHED;
            PG8_LDB(B1, 0, 1); PG8_STAGE(PG8_SB(0, 0), b2, voffB);
            PG8_BAR; PG8_WAIT_L(0); PG8_MMA(0, 1, At, B1); PG8_BAR;
            PG8_LDA(At, 0, 1); PG8_STAGE(PG8_SA(0, 0), a2, voffA);
            PG8_BAR; PG8_WAIT_L(0); PG8_MMA(1, 0, At, B0); PG8_BAR; PG8_SCHED;
            PG8_STAGE(PG8_SB(0, 1), b2 + hstep, voffB);
            PG8_WAIT_V(6); PG8_BAR; PG8_MMA(1, 1, At, B1); PG8_BAR;
            PG8_LDB(B0, 1, 0); PG8_SCHED; PG8_LDA(At, 1, 0); PG8_STAGE(PG8_SA(0, 1), a2 + hstep, voffA);
            PG8_WAIT_L(8); PG8_BAR; PG8_WAIT_L(0); PG8_MMA(0, 0, At, B0); PG8_BAR; PG8_SCHED;
            PG8_LDB(B1, 1, 1); PG8_STAGE(PG8_SB(1, 0), b3, voffB);
            PG8_BAR; PG8_WAIT_L(0); PG8_MMA(0, 1, At, B1); PG8_BAR;
            PG8_LDA(At, 1, 1); PG8_STAGE(PG8_SA(1, 0), a3, voffA);
            PG8_BAR; PG8_WAIT_L(0); PG8_MMA(1, 0, At, B0); PG8_BAR; PG8_SCHED;
            PG8_STAGE(PG8_SB(1, 1), b3 + hstep, voffB);
            PG8_WAIT_V(6); PG8_BAR; PG8_MMA(1, 1, At, B1); PG8_BAR;
            }
        }
        if constexpr (ALIGN_EPI) { if (wr == 0) PG8_BAR; }
        if constexpr (!Epi::AFTER_DRAIN) { E(acc, cur, wr, wc, fr, fq); S.done(cur); }
        if (!has_next) break;
#pragma unroll
        for (int a = 0; a < 2; ++a)
#pragma unroll
            for (int b = 0; b < 2; ++b)
#pragma unroll
                for (int m = 0; m < 4; ++m)
#pragma unroll
                    for (int n = 0; n < 2; ++n) acc[a][b][m][n] = (f32x4){0.f, 0.f, 0.f, 0.f};
        cur = nxt; cA = nA; cB = nB; ++ui;
        if constexpr (ALIGN_EPI) { if (wr == 1) PG8_BAR; }
    }
    PG8_WAIT_V(0);
    if constexpr (!ALIGN_EPI) { if (wr == 0) PG8_BAR; }
    PG8_BAR;
    if constexpr (Epi::AFTER_DRAIN) { E.fused(acc, cur, wr, wc, fr, fq, lds, wid, lane); S.done(cur); }
#undef PG8_SA
#undef PG8_SB
#undef PG8_STAGE
#undef PG8_LDA
#undef PG8_LDB
#undef PG8_MMA
#undef PG8_WAIT_V
#undef PG8_WAIT_L
#undef PG8_BAR
#undef PG8_SCHED
}
template <class Epi, class Sched, bool ALIGN_EPI = false, bool SP2 = false>
__device__ __forceinline__ void gemm_phase2(PG8_LAS unsigned char* lds, const Gemm g, const Gemm g2, const Sched& S, const Epi& E) {
    const int tid = threadIdx.x, wid = __builtin_amdgcn_readfirstlane(tid >> 6), lane = tid & 63, wr = wid >> 2, wc = wid & 3, fr = lane & 15, fq = lane >> 4;
    const int K = g.K, nt = K / BK;
    unsigned voffA[2], voffB[2];
#pragma unroll
    for (int i = 0; i < 2; ++i) { int R, C; stage_rc(tid * 16 + i * 8192, R, C); const int Rb = Epi::PERM ? ((R & ~31) + perm32(R & 31)) : R;
        voffA[i] = (unsigned)(R * K + C) * 2u; voffB[i] = (unsigned)(Rb * K + C) * 2u; }
    const size_t kstep = (size_t)(BK * 2);
    const size_t hstep = (size_t)HALF * K * 2;
    const size_t tstep = 2 * hstep;
    const unsigned ldsw = (unsigned)wid * 1024u;
    const int aoff = lds_byte(wr * 64 + fr, fq * 8), boff = lds_byte(wc * 32 + fr, fq * 8);
#define PG8_SA(b, h) (((b) * 2 + (h)) * HTB)
#define PG8_SB(b, h) ((4 + (b) * 2 + (h)) * HTB)
#define PG8_STAGE(bufoff, gbase, voff) do { _Pragma("unroll") for (int _i = 0; _i < 2; ++_i) \
        __builtin_amdgcn_global_load_lds((const unsigned*)((const char*)(gbase) + (voff)[_i]), (PG8_LAS unsigned*)(lds + (bufoff) + ldsw + _i * 8192), 16, 0, 0); } while (0)
#define PG8_LDA(dst, b, h) do { _Pragma("unroll") for (int m = 0; m < 4; ++m) _Pragma("unroll") for (int k = 0; k < 2; ++k) dst[m][k] = *(const PG8_LAS bf16x8*)(lds + PG8_SA(b, h) + aoff + m * 2048 + k * 1024); } while (0)
#define PG8_LDB(dst, b, h) do { _Pragma("unroll") for (int n = 0; n < 2; ++n) _Pragma("unroll") for (int k = 0; k < 2; ++k) dst[n][k] = *(const PG8_LAS bf16x8*)(lds + PG8_SB(b, h) + boff + n * 2048 + k * 1024); } while (0)
#define PG8_MMA(ai, bj, At, Bt) do { __builtin_amdgcn_s_setprio(1); _Pragma("unroll") for (int m = 0; m < 4; ++m) _Pragma("unroll") for (int n = 0; n < 2; ++n) _Pragma("unroll") for (int k = 0; k < 2; ++k) \
        acc[ai][bj][m][n] = __builtin_amdgcn_mfma_f32_16x16x32_bf16(Bt[n][k], At[m][k], acc[ai][bj][m][n], 0, 0, 0); __builtin_amdgcn_s_setprio(0); } while (0)
#define PG8_WAIT_V(n) asm volatile("s_waitcnt vmcnt(" #n ")" ::: "memory")
#define PG8_WAIT_L(n) asm volatile("s_waitcnt lgkmcnt(" #n ")" ::: "memory")
#define PG8_BAR __builtin_amdgcn_s_barrier()
#define PG8_SCHED __builtin_amdgcn_sched_barrier(0)
    Unit cur, nxt; int ui = 0, seg = 0;
    if (!S.next(0, cur)) return;
    f32x4 acc[2][2][4][2];
#pragma unroll
    for (int a = 0; a < 2; ++a)
#pragma unroll
        for (int b = 0; b < 2; ++b)
#pragma unroll
            for (int m = 0; m < 4; ++m)
#pragma unroll
                for (int n = 0; n < 2; ++n) acc[a][b][m][n] = (f32x4){0.f, 0.f, 0.f, 0.f};
    bf16x8 At[4][2], B0[2][2], B1[2][2];
    const char* cA = (const char*)g.A + (size_t)cur.pm * tstep; const char* cB = (const char*)g.Bt + (size_t)cur.pn * tstep;
    S.a_ready(cur);
    if constexpr (SP2) {
        PG8_STAGE(PG8_SB(0, 0), cB, voffB); PG8_STAGE(PG8_SB(0, 1), cB + hstep, voffB); PG8_STAGE(PG8_SA(0, 0), cA, voffA); PG8_STAGE(PG8_SA(0, 1), cA + hstep, voffA);
        if (wr == 1) PG8_BAR;
        PG8_WAIT_V(2); PG8_BAR;
        PG8_STAGE(PG8_SB(1, 0), cB + kstep, voffB); PG8_STAGE(PG8_SA(1, 0), cA + kstep, voffA); PG8_STAGE(PG8_SB(1, 1), cB + hstep + kstep, voffB);
        PG8_WAIT_V(6); PG8_BAR;
    } else {
        PG8_STAGE(PG8_SB(0, 0), cB, voffB); PG8_STAGE(PG8_SA(0, 0), cA, voffA); PG8_STAGE(PG8_SB(0, 1), cB + hstep, voffB); PG8_STAGE(PG8_SA(0, 1), cA + hstep, voffA);
        if (wr == 1) PG8_BAR;
        PG8_WAIT_V(4); PG8_BAR;
        PG8_STAGE(PG8_SB(1, 0), cB + kstep, voffB); PG8_STAGE(PG8_SA(1, 0), cA + kstep, voffA); PG8_STAGE(PG8_SB(1, 1), cB + hstep + kstep, voffB);
        PG8_WAIT_V(6); PG8_BAR;
    }
    for (;;) {
        bool has_next; if (seg == 0) has_next = true; else has_next = S.next(ui + 1, nxt);
        const char* nA; const char* nB;
        if (seg == 0) { nA = (const char*)g2.A + (size_t)cur.pm * tstep; nB = (const char*)g2.Bt + (size_t)cur.pn * tstep; }
        else { nA = has_next ? (const char*)g.A + (size_t)nxt.pm * tstep : cA; nB = has_next ? (const char*)g.Bt + (size_t)nxt.pn * tstep : cB; }
        for (int t = 0; t < nt; t += 2) {
            const bool last = (t == nt - 2);
            const char* a1 = cA + (size_t)(t + 1) * kstep;
            const char* a2 = last ? nA : cA + (size_t)(t + 2) * kstep; const char* b2 = last ? nB : cB + (size_t)(t + 2) * kstep;
            const char* a3 = a2 + kstep; const char* b3 = b2 + kstep;
            if (last && has_next) S.a_ready(nxt);
            if constexpr (SP2) {
            PG8_LDB(B0, 0, 0); PG8_LDB(B1, 0, 1); PG8_SCHED; PG8_LDA(At, 0, 0); PG8_STAGE(PG8_SA(1, 1), a1 + hstep, voffA);
            PG8_WAIT_V(8); PG8_WAIT_L(0); PG8_BAR; PG8_MMA(0, 0, At, B0); PG8_MMA(0, 1, At, B1); PG8_BAR; PG8_SCHED;
            PG8_LDA(At, 0, 1); PG8_STAGE(PG8_SB(0, 0), b2, voffB); PG8_STAGE(PG8_SB(0, 1), b2 + hstep, voffB); PG8_STAGE(PG8_SA(0, 0), a2, voffA);
            PG8_WAIT_V(8); PG8_WAIT_L(0); PG8_BAR; PG8_MMA(1, 0, At, B0); PG8_MMA(1, 1, At, B1); PG8_BAR; PG8_SCHED;
            PG8_LDB(B0, 1, 0); PG8_LDB(B1, 1, 1); PG8_SCHED; PG8_LDA(At, 1, 0); PG8_STAGE(PG8_SA(0, 1), a2 + hstep, voffA);
            PG8_WAIT_V(8); PG8_WAIT_L(0); PG8_BAR; PG8_MMA(0, 0, At, B0); PG8_MMA(0, 1, At, B1); PG8_BAR; PG8_SCHED;
            PG8_LDA(At, 1, 1); PG8_STAGE(PG8_SB(1, 0), b3, voffB); PG8_STAGE(PG8_SB(1, 1), b3 + hstep, voffB); PG8_STAGE(PG8_SA(1, 0), a3, voffA);
            PG8_WAIT_V(8); PG8_WAIT_L(0); PG8_BAR; PG8_MMA(1, 0, At, B0); PG8_MMA(1, 1, At, B1); PG8_BAR; PG8_SCHED;
            } else {
            PG8_LDB(B0, 0, 0); PG8_SCHED; PG8_LDA(At, 0, 0); PG8_STAGE(PG8_SA(1, 1), a1 + hstep, voffA);
            PG8_WAIT_L(8); PG8_BAR; PG8_WAIT_L(0); PG8_MMA(0, 0, At, B0); PG8_BAR; PG8_SCHED;
            PG8_LDB(B1, 0, 1); PG8_STAGE(PG8_SB(0, 0), b2, voffB);
            PG8_BAR; PG8_WAIT_L(0); PG8_MMA(0, 1, At, B1); PG8_BAR;
            PG8_LDA(At, 0, 1); PG8_STAGE(PG8_SA(0, 0), a2, voffA);
            PG8_BAR; PG8_WAIT_L(0); PG8_MMA(1, 0, At, B0); PG8_BAR; PG8_SCHED;
            PG8_STAGE(PG8_SB(0, 1), b2 + hstep, voffB);
            PG8_WAIT_V(6); PG8_BAR; PG8_MMA(1, 1, At, B1); PG8_BAR;
            PG8_LDB(B0, 1, 0); PG8_SCHED; PG8_LDA(At, 1, 0); PG8_STAGE(PG8_SA(0, 1), a2 + hstep, voffA);
            PG8_WAIT_L(8); PG8_BAR; PG8_WAIT_L(0); PG8_MMA(0, 0, At, B0); PG8_BAR; PG8_SCHED;
            PG8_LDB(B1, 1, 1); PG8_STAGE(PG8_SB(1, 0), b3, voffB);
            PG8_BAR; PG8_WAIT_L(0); PG8_MMA(0, 1, At, B1); PG8_BAR;
            PG8_LDA(At, 1, 1); PG8_STAGE(PG8_SA(1, 0), a3, voffA);
            PG8_BAR; PG8_WAIT_L(0); PG8_MMA(1, 0, At, B0); PG8_BAR; PG8_SCHED;
            PG8_STAGE(PG8_SB(1, 1), b3 + hstep, voffB);
            PG8_WAIT_V(6); PG8_BAR; PG8_MMA(1, 1, At, B1); PG8_BAR;
            }
        }
        if constexpr (ALIGN_EPI) { if (wr == 0) PG8_BAR; }
        if (seg == 0) E.mid(acc, cur, wr, wc, fr, fq); else { E(acc, cur, wr, wc, fr, fq); S.done(cur); }
        if (!has_next) break;
        if (seg == 1) {
#pragma unroll
        for (int a = 0; a < 2; ++a)
#pragma unroll
            for (int b = 0; b < 2; ++b)
#pragma unroll
                for (int m = 0; m < 4; ++m)
#pragma unroll
                    for (int n = 0; n < 2; ++n) acc[a][b][m][n] = (f32x4){0.f, 0.f, 0.f, 0.f};
        cur = nxt; ++ui; }
        cA = nA; cB = nB; seg ^= 1;
        if constexpr (ALIGN_EPI) { if (wr == 1) PG8_BAR; }
    }
    PG8_WAIT_V(0);
    if constexpr (!ALIGN_EPI) { if (wr == 0) PG8_BAR; }
    PG8_BAR;
#undef PG8_SA
#undef PG8_SB
#undef PG8_STAGE
#undef PG8_LDA
#undef PG8_LDB
#undef PG8_MMA
#undef PG8_WAIT_V
#undef PG8_WAIT_L
#undef PG8_BAR
#undef PG8_SCHED
}
}
#define XB_TMO      128
#define XB_XCNT(j)  (256  + 64 * (j))
#define XB_XSUB(j)  (1280 + 64 * (j))
#define XB_XGEN(j)  (2304 + 64 * (j))
#define XB_TOP      3328
#define XB_TOPGEN   3392
#define XCD_BAR_WORDS 3456
#define XB_SPIN_CAP (1u << 18)

__device__ __forceinline__ unsigned xb_ld(unsigned* p)              { return __hip_atomic_load(p, __ATOMIC_RELAXED, __HIP_MEMORY_SCOPE_AGENT); }
__device__ __forceinline__ unsigned xb_add(unsigned* p, unsigned v) { return __hip_atomic_fetch_add(p, v, __ATOMIC_RELAXED, __HIP_MEMORY_SCOPE_AGENT); }
__device__ __forceinline__ unsigned xb_xcc_id() { return (unsigned)__builtin_amdgcn_s_getreg((3 << 11) | 20) & 0xFu; }
#define XB_SPIN(cond, bar) do { unsigned _sp = 0; while (cond) { __builtin_amdgcn_s_sleep(1); \
    if ((++_sp & 255u) == 0u) { if (xb_ld(&(bar)[XB_TMO])) break; if (_sp > XB_SPIN_CAP) { atomicAdd(&(bar)[XB_TMO], 1u); break; } } } } while (0)

struct XcdBarrier {
    unsigned* bar; unsigned x;
    volatile LAS unsigned* st;
};

__device__ __forceinline__ XcdBarrier xcd_barrier_post(unsigned* bar, volatile LAS unsigned* st) {
    XcdBarrier b; b.bar = bar; b.x = xb_xcc_id(); b.st = st;
    if (threadIdx.x == 0) (void)xb_add(&bar[XB_XCNT(b.x)], 1u);
    return b;
}
__device__ __forceinline__ void xcd_barrier_complete(unsigned* bar, unsigned x, unsigned& nloc, unsigned& nx) {
    const unsigned G = gridDim.x * gridDim.y * gridDim.z;
    unsigned sum, cnt, mine, sp = 0u;
    for (;;) {
        sum = 0u; cnt = 0u; mine = 0u;
#pragma unroll
        for (unsigned j = 0; j < 16; ++j) { const unsigned c = xb_ld(&bar[XB_XCNT(j)]); sum += c; cnt += (c > 0u) ? 1u : 0u; mine = (j == x) ? c : mine; }
        if (sum == G) break;
        __builtin_amdgcn_s_sleep(1);
        if ((++sp & 255u) == 0u) { if (xb_ld(&bar[XB_TMO])) break; if (sp > XB_SPIN_CAP) { atomicAdd(&bar[XB_TMO], 1u); break; } }
    }
    nloc = mine > 0u ? mine : 1u; nx = cnt > 0u ? cnt : 1u;
}

__device__ __forceinline__ void xcd_barrier(const XcdBarrier& b) {
    asm volatile("s_waitcnt vmcnt(0)" ::: "memory");
    __syncthreads();
    if (threadIdx.x == 0) {
        unsigned* bar = b.bar;
        __builtin_amdgcn_s_waitcnt(0);
        unsigned nloc = b.st[0], nx = b.st[1];
        if (nloc == 0u) { xcd_barrier_complete(bar, b.x, nloc, nx); b.st[0] = nloc; b.st[1] = nx; }
        const unsigned old = xb_add(&bar[XB_XSUB(b.x)], 1u);
        const unsigned gen = old / nloc;
        if (old + 1u == (gen + 1u) * nloc) {
            __builtin_amdgcn_fence(__ATOMIC_RELEASE, "agent");
            asm volatile("s_waitcnt vmcnt(0)" ::: "memory");
            const unsigned og = xb_add(&bar[XB_TOP], 1u);
            const unsigned tg = og / nx;
            if (og + 1u == (tg + 1u) * nx) xb_add(&bar[XB_TOPGEN], 1u);
            else XB_SPIN(xb_ld(&bar[XB_TOPGEN]) == tg, bar);
            __builtin_amdgcn_fence(__ATOMIC_ACQUIRE, "agent");
            xb_add(&bar[XB_XGEN(b.x)], 1u);
            asm volatile("s_waitcnt vmcnt(0)" ::: "memory");
        } else {
            XB_SPIN(xb_ld(&bar[XB_XGEN(b.x)]) == gen, bar);
            __builtin_amdgcn_fence(__ATOMIC_ACQUIRE, "agent");
            asm volatile("s_waitcnt vmcnt(0)" ::: "memory");
        }
    }
    __syncthreads();
}

constexpr int D = 4096, SEQ = 8192, NX = 16384  , NMETA = 16, MROWS = 16640  ;
constexpr int DIN = 36864, DFF = 11008, NH = 16;
constexpr float EPS = 1e-6f, LOG2E = 1.4426950408889634f;
constexpr size_t MiB = 1u << 20;
constexpr size_t WS_CTL = 0, CTL_ZERO_BYTES = 1 * MiB;
constexpr size_t WS_WBR = 1 * MiB, WS_WBD = 33 * MiB, WS_WO = 65 * MiB, WS_WGU = 97 * MiB, WS_WDN = 269 * MiB;
constexpr size_t WS_WIN = 355 * MiB, WS_U = 643 * MiB;
constexpr size_t WS_ST = 355 * MiB;
constexpr size_t WS_PROJ = 867 * MiB;
constexpr size_t WS_YR = 2037 * MiB, WS_END = 2165 * MiB;
constexpr size_t GS = (size_t)MROWS * D;
constexpr size_t WS_MIXED = 355 * MiB, WS_U2 = 483 * MiB, WS_ACT = 867 * MiB, WS_H2 = 355 * MiB  , WS_PS = 611 * MiB  , WS_RSTD = 616 * MiB  ;
static_assert(WS_WGU + (size_t)2 * DFF * D * 2 <= WS_WDN && WS_WDN + (size_t)D * DFF * 2 <= WS_WIN && WS_WIN + (size_t)DIN * D * 2 <= WS_U && WS_U + (size_t)MROWS * D * 2 <= WS_ST + 512 * MiB && WS_ST + 512 * MiB <= WS_PROJ && WS_PROJ + 9 * GS * 2 <= WS_END, "ws map");
constexpr int CW_BAR = 4096;
constexpr int LDS_BYTES = 163840, MISC_OFF = LDS_BYTES - 256;
constexpr int NWAVES = 8;


typedef unsigned short bf16;
typedef LAS char lchar;
#define LDS_WAIT() asm volatile("s_waitcnt lgkmcnt(0)" ::: "memory")
#define VM_WAIT() asm volatile("s_waitcnt vmcnt(0)" ::: "memory")
#define WAITBAR() do { asm volatile("s_waitcnt vmcnt(0) lgkmcnt(0)" ::: "memory"); __builtin_amdgcn_s_barrier(); asm volatile("" ::: "memory"); } while (0)

namespace mx {
using bf16x8 = __attribute__((ext_vector_type(8))) short;
using s16x4  = __attribute__((ext_vector_type(4))) short;
using f32x16 = __attribute__((ext_vector_type(16))) float;
using f32x4  = __attribute__((ext_vector_type(4))) float;
using u32x4  = __attribute__((ext_vector_type(4))) unsigned;
using u32x2  = __attribute__((ext_vector_type(2))) unsigned;
#define KSWZ(row, colB) ((row) * 256 + ((colB) ^ (((row) & 7) << 4)))
#define SBAR() __builtin_amdgcn_sched_barrier(0)
__device__ __forceinline__ int crow(int r, int hi) { return (r & 3) + 8 * (r >> 2) + 4 * hi; }
__device__ __forceinline__ unsigned cvtpk(float lo, float hi) { unsigned r; asm volatile("v_cvt_pk_bf16_f32 %0, %1, %2" : "=v"(r) : "v"(lo), "v"(hi)); return r; }
__device__ __forceinline__ float bflo(unsigned w) { return __uint_as_float(w << 16); }
__device__ __forceinline__ float bfhi(unsigned w) { return __uint_as_float(w & 0xffff0000u); }
__device__ __forceinline__ int v_rd_base(int lane) { return ((lane & 3) << 3) | (((lane >> 2) & 3) << 6) | (((lane >> 4) & 1) << 5) | (((lane >> 5) & 1) << 8); }
constexpr int vro(int d0, int ks, int half) { return d0 * 512 + ks * 8192 + half * 4096; }
template <int OFF> __device__ __forceinline__ s16x4 tr_read(int vb) { s16x4 r; asm volatile("ds_read_b64_tr_b16 %0, %1 offset:%2" : "=&v"(r) : "v"(vb), "i"(OFF) : "memory"); return r; }
#define MX_PK(L, H) (mx::bf16x8){L[0], L[1], L[2], L[3], H[0], H[1], H[2], H[3]}
__device__ __forceinline__ void vimg_rc(int P, int& k, int& c) { const int st = P >> 9, wi = P & 511, kk = (st >> 3) * 8 + (wi >> 6); c = (st & 7) * 32 + ((wi & 63) >> 1); k = (kk & ~0xC) | ((kk & 4) << 1) | ((kk & 8) >> 1); }
__device__ __forceinline__ void kimg_rc(int P, int& r, int& c) { r = P >> 8; const int cp = P & 255; c = (cp ^ ((r & 7) << 4)) >> 1; }
__device__ __forceinline__ void glds16(const void* g, lchar* l) { __builtin_amdgcn_global_load_lds((const unsigned*)g, (LAS unsigned*)l, 16, 0, 0); }
__device__ __forceinline__ int lds_addr(const lchar* p) { return (int)(unsigned)(size_t)p; }
template <int K> __device__ __forceinline__ float swz_xor(float v) { return __int_as_float(__builtin_amdgcn_ds_swizzle(__float_as_int(v), 0x1f | (K << 10))); }
__device__ __forceinline__ float half_sum(float v) { v += swz_xor<1>(v); v += swz_xor<2>(v); v += swz_xor<4>(v); v += swz_xor<8>(v); v += swz_xor<16>(v); return v; }
__device__ __forceinline__ int opaque(int x) { asm volatile("" : "+v"(x)); return x; }

template <int ND> __device__ __forceinline__ void qkt(f32x16& p0, f32x16& p1, const lchar* Ks, const bf16x8* qr, int r32, int hi) {
#pragma unroll
  for (int r = 0; r < 16; ++r) { p0[r] = 0.f; p1[r] = 0.f; }
#pragma unroll
  for (int d0 = 0; d0 < ND; ++d0) { const int cb = ((d0 & 7) * 16 + hi * 8) * 2; const lchar* Kh = Ks + (d0 >> 3) * 16384;
    const bf16x8 b0 = *(const LAS bf16x8*)(Kh + KSWZ(r32, cb));
    const bf16x8 b1 = *(const LAS bf16x8*)(Kh + KSWZ(32 + r32, cb));
    p0 = __builtin_amdgcn_mfma_f32_32x32x16_bf16(b0, qr[d0], p0, 0, 0, 0);
    p1 = __builtin_amdgcn_mfma_f32_32x32x16_bf16(b1, qr[d0], p1, 0, 0, 0); }
}
__device__ __forceinline__ void pack_p(const f32x16& p0, const f32x16& p1, bf16x8& pa0, bf16x8& pa1, bf16x8& pa2, bf16x8& pa3) {
#define PK4(P, BASE, OUT) do { unsigned a0 = cvtpk(P[BASE + 0], P[BASE + 1]), a1 = cvtpk(P[BASE + 2], P[BASE + 3]);   \
    unsigned b0 = cvtpk(P[BASE + 4], P[BASE + 5]), b1 = cvtpk(P[BASE + 6], P[BASE + 7]);                              \
    auto r0 = __builtin_amdgcn_permlane32_swap(a0, b0, false, false); auto r1 = __builtin_amdgcn_permlane32_swap(a1, b1, false, false); \
    u32x4 w = {r0[0], r1[0], r0[1], r1[1]}; OUT = *reinterpret_cast<bf16x8*>(&w); } while (0)
  PK4(p0, 0, pa0); PK4(p0, 8, pa1); PK4(p1, 0, pa2); PK4(p1, 8, pa3);
#undef PK4
}
__device__ __forceinline__ void pack_p2(const f32x16& p, bf16x8& pa0, bf16x8& pa1) {
#define PK4(P, BASE, OUT) do { unsigned a0 = cvtpk(P[BASE + 0], P[BASE + 1]), a1 = cvtpk(P[BASE + 2], P[BASE + 3]);   \
    unsigned b0 = cvtpk(P[BASE + 4], P[BASE + 5]), b1 = cvtpk(P[BASE + 6], P[BASE + 7]);                              \
    auto r0 = __builtin_amdgcn_permlane32_swap(a0, b0, false, false); auto r1 = __builtin_amdgcn_permlane32_swap(a1, b1, false, false); \
    u32x4 w = {r0[0], r1[0], r0[1], r1[1]}; OUT = *reinterpret_cast<bf16x8*>(&w); } while (0)
  PK4(p, 0, pa0); PK4(p, 8, pa1);
#undef PK4
}
template <int D0, int KH> __device__ __forceinline__ void pv_half(f32x16& od, int vb, bf16x8 a0, bf16x8 a1) {
  const s16x4 l0 = tr_read<vro(D0, 2 * KH, 0)>(vb), h0 = tr_read<vro(D0, 2 * KH, 1)>(vb), l1 = tr_read<vro(D0, 2 * KH + 1, 0)>(vb), h1 = tr_read<vro(D0, 2 * KH + 1, 1)>(vb);
  asm volatile("s_waitcnt lgkmcnt(0)" ::: "memory"); SBAR();
  od = __builtin_amdgcn_mfma_f32_32x32x16_bf16(a0, MX_PK(l0, h0), od, 0, 0, 0);
  od = __builtin_amdgcn_mfma_f32_32x32x16_bf16(a1, MX_PK(l1, h1), od, 0, 0, 0);
}
template <int D0, int KH> __device__ __forceinline__ void pv_half2(f32x16& oa, f32x16& ob, int vb, bf16x8 a0, bf16x8 a1) {
  const s16x4 l0 = tr_read<vro(D0, 2 * KH, 0)>(vb), h0 = tr_read<vro(D0, 2 * KH, 1)>(vb), l1 = tr_read<vro(D0, 2 * KH + 1, 0)>(vb), h1 = tr_read<vro(D0, 2 * KH + 1, 1)>(vb);
  const s16x4 l2 = tr_read<vro(D0 + 1, 2 * KH, 0)>(vb), h2 = tr_read<vro(D0 + 1, 2 * KH, 1)>(vb), l3 = tr_read<vro(D0 + 1, 2 * KH + 1, 0)>(vb), h3 = tr_read<vro(D0 + 1, 2 * KH + 1, 1)>(vb);
  asm volatile("s_waitcnt lgkmcnt(0)" ::: "memory"); SBAR();
  oa = __builtin_amdgcn_mfma_f32_32x32x16_bf16(a0, MX_PK(l0, h0), oa, 0, 0, 0);
  ob = __builtin_amdgcn_mfma_f32_32x32x16_bf16(a0, MX_PK(l2, h2), ob, 0, 0, 0);
  oa = __builtin_amdgcn_mfma_f32_32x32x16_bf16(a1, MX_PK(l1, h1), oa, 0, 0, 0);
  ob = __builtin_amdgcn_mfma_f32_32x32x16_bf16(a1, MX_PK(l3, h3), ob, 0, 0, 0);
}
template <int KH> __device__ __forceinline__ void pv_half8(f32x16* o, int vb, bf16x8 a0, bf16x8 a1) {
#define PV8_RD(D0, L0, H0, L1, H1, L2, H2, L3, H3) const s16x4 L0 = tr_read<vro(D0, 2 * KH, 0)>(vb), H0 = tr_read<vro(D0, 2 * KH, 1)>(vb), L1 = tr_read<vro(D0, 2 * KH + 1, 0)>(vb), H1 = tr_read<vro(D0, 2 * KH + 1, 1)>(vb), \
      L2 = tr_read<vro(D0 + 1, 2 * KH, 0)>(vb), H2 = tr_read<vro(D0 + 1, 2 * KH, 1)>(vb), L3 = tr_read<vro(D0 + 1, 2 * KH + 1, 0)>(vb), H3 = tr_read<vro(D0 + 1, 2 * KH + 1, 1)>(vb)
#define PV8_MM(D0, L0, H0, L1, H1, L2, H2, L3, H3) do { o[D0] = __builtin_amdgcn_mfma_f32_32x32x16_bf16(a0, MX_PK(L0, H0), o[D0], 0, 0, 0); o[D0 + 1] = __builtin_amdgcn_mfma_f32_32x32x16_bf16(a0, MX_PK(L2, H2), o[D0 + 1], 0, 0, 0); \
      o[D0] = __builtin_amdgcn_mfma_f32_32x32x16_bf16(a1, MX_PK(L1, H1), o[D0], 0, 0, 0); o[D0 + 1] = __builtin_amdgcn_mfma_f32_32x32x16_bf16(a1, MX_PK(L3, H3), o[D0 + 1], 0, 0, 0); } while (0)
  PV8_RD(0, a_l0, a_h0, a_l1, a_h1, a_l2, a_h2, a_l3, a_h3);
  PV8_RD(2, b_l0, b_h0, b_l1, b_h1, b_l2, b_h2, b_l3, b_h3);
  asm volatile("s_waitcnt lgkmcnt(8)" ::: "memory"); SBAR();
  PV8_MM(0, a_l0, a_h0, a_l1, a_h1, a_l2, a_h2, a_l3, a_h3); SBAR();
  PV8_RD(4, c_l0, c_h0, c_l1, c_h1, c_l2, c_h2, c_l3, c_h3);
  asm volatile("s_waitcnt lgkmcnt(8)" ::: "memory"); SBAR();
  PV8_MM(2, b_l0, b_h0, b_l1, b_h1, b_l2, b_h2, b_l3, b_h3); SBAR();
  PV8_RD(6, d_l0, d_h0, d_l1, d_h1, d_l2, d_h2, d_l3, d_h3);
  asm volatile("s_waitcnt lgkmcnt(8)" ::: "memory"); SBAR();
  PV8_MM(4, c_l0, c_h0, c_l1, c_h1, c_l2, c_h2, c_l3, c_h3); SBAR();
  asm volatile("s_waitcnt lgkmcnt(0)" ::: "memory"); SBAR();
  PV8_MM(6, d_l0, d_h0, d_l1, d_h1, d_l2, d_h2, d_l3, d_h3);
#undef PV8_RD
#undef PV8_MM
}
template <int D0> __device__ __forceinline__ void pv_one(f32x16& od, int vb, bf16x8 a0, bf16x8 a1, bf16x8 a2, bf16x8 a3) {
  const s16x4 l0 = tr_read<vro(D0, 0, 0)>(vb), h0 = tr_read<vro(D0, 0, 1)>(vb), l1 = tr_read<vro(D0, 1, 0)>(vb), h1 = tr_read<vro(D0, 1, 1)>(vb);
  const s16x4 l2 = tr_read<vro(D0, 2, 0)>(vb), h2 = tr_read<vro(D0, 2, 1)>(vb), l3 = tr_read<vro(D0, 3, 0)>(vb), h3 = tr_read<vro(D0, 3, 1)>(vb);
  asm volatile("s_waitcnt lgkmcnt(0)" ::: "memory"); SBAR();
  od = __builtin_amdgcn_mfma_f32_32x32x16_bf16(a0, MX_PK(l0, h0), od, 0, 0, 0);
  od = __builtin_amdgcn_mfma_f32_32x32x16_bf16(a1, MX_PK(l1, h1), od, 0, 0, 0);
  od = __builtin_amdgcn_mfma_f32_32x32x16_bf16(a2, MX_PK(l2, h2), od, 0, 0, 0);
  od = __builtin_amdgcn_mfma_f32_32x32x16_bf16(a3, MX_PK(l3, h3), od, 0, 0, 0);
}
}

struct Frame {
    lchar* lds; volatile LAS unsigned* MISC; unsigned* ctl;
    int tid, lane, wave, vcu, G;
    const float* in[15]; float* out; unsigned char* ws;
};
__device__ __forceinline__ float wave_sum(float v) {
    v = mx::half_sum(v);
    auto rr = __builtin_amdgcn_permlane32_swap(__float_as_uint(v), __float_as_uint(v), false, false);
    return __uint_as_float(rr[0]) + __uint_as_float(rr[1]);
}
__device__ __forceinline__ unsigned f2bf(float f) { unsigned u = __builtin_bit_cast(unsigned, f); return (u + 0x7fffu + ((u >> 16) & 1u)) >> 16; }
__device__ __forceinline__ unsigned pk2(float lo, float hi) { return f2bf(lo) | (f2bf(hi) << 16); }

__device__ __forceinline__ void p0_transpose_item(const float* W, int K, int N, bf16* WT, int mode, LAS float* scr, int item, int lane, const float* gk = nullptr) {
    const int nblk = N / 64, kb = item / nblk, nb = item - kb * nblk, k0 = 64 * kb, n0 = 64 * nb;
    mx::f32x4 v[16];
    const float* src = W + (size_t)(k0 + (lane >> 4)) * N + n0 + 4 * (lane & 15);
#pragma unroll
    for (int i = 0; i < 16; ++i) v[i] = *(const mx::f32x4*)(src + (size_t)(4 * i) * N);
#pragma unroll
    for (int i = 0; i < 16; ++i) { LAS float* s = scr + (4 * i + (lane >> 4)) * 65 + 4 * (lane & 15); s[0] = v[i][0]; s[1] = v[i][1]; s[2] = v[i][2]; s[3] = v[i][3]; }
    LDS_WAIT(); asm volatile("" ::: "memory");
    const int c = lane & 7;
    const int nd0 = (mode == 0) ? n0 : ((n0 >> 7) * 256 + (n0 & 127) + (mode == 2 ? 128 : 0));
    mx::f32x4 ga = {1.f, 1.f, 1.f, 1.f}, gb = {1.f, 1.f, 1.f, 1.f};
    if (gk) { ga = *(const mx::f32x4*)(gk + k0 + 8 * c); gb = *(const mx::f32x4*)(gk + k0 + 8 * c + 4); }
#pragma unroll
    for (int j = 0; j < 8; ++j) { const int n = (lane >> 3) + 8 * j; const LAS float* s = scr + (8 * c) * 65 + n;
        mx::u32x4 o; o.x = pk2(s[0 * 65] * ga[0], s[1 * 65] * ga[1]); o.y = pk2(s[2 * 65] * ga[2], s[3 * 65] * ga[3]); o.z = pk2(s[4 * 65] * gb[0], s[5 * 65] * gb[1]); o.w = pk2(s[6 * 65] * gb[2], s[7 * 65] * gb[3]);
        *(mx::u32x4*)(WT + (size_t)(nd0 + n) * K + k0 + 8 * c) = o; }
    LDS_WAIT(); asm volatile("" ::: "memory");
}
template <bool OUT32> __device__ __forceinline__ void rms_row(const float* xrow, const float* g, void* orow, int lane) {
    const mx::f32x4* xr = (const mx::f32x4*)xrow + lane;
    mx::f32x4 v[16]; float s = 0.f;
#pragma unroll
    for (int j = 0; j < 16; ++j) { v[j] = xr[64 * j]; s += (v[j][0] * v[j][0] + v[j][1] * v[j][1]) + (v[j][2] * v[j][2] + v[j][3] * v[j][3]); }
    const float rstd = 1.0f / sqrtf(wave_sum(s) * (1.f / D) + EPS);
    const mx::f32x4* gr = (const mx::f32x4*)g + lane;
#pragma unroll
    for (int j = 0; j < 16; ++j) { const mx::f32x4 gg = gr[64 * j]; const mx::f32x4 y = v[j] * rstd * gg;
        if (OUT32) ((mx::f32x4*)orow)[lane + 64 * j] = y;
        else { mx::u32x2 w; w.x = pk2(y[0], y[1]); w.y = pk2(y[2], y[3]); ((mx::u32x2*)orow)[lane + 64 * j] = w; } }
}
__device__ __forceinline__ void rms_row_bf(const bf16* xrow, const float* g, float* orow, int lane) {
    const mx::u32x4* xr = (const mx::u32x4*)xrow + lane;
    mx::u32x4 v[8]; float s = 0.f;
#pragma unroll
    for (int j = 0; j < 8; ++j) { v[j] = xr[64 * j];
        s += (mx::bflo(v[j].x) * mx::bflo(v[j].x) + mx::bfhi(v[j].x) * mx::bfhi(v[j].x)) + (mx::bflo(v[j].y) * mx::bflo(v[j].y) + mx::bfhi(v[j].y) * mx::bfhi(v[j].y))
           + (mx::bflo(v[j].z) * mx::bflo(v[j].z) + mx::bfhi(v[j].z) * mx::bfhi(v[j].z)) + (mx::bflo(v[j].w) * mx::bflo(v[j].w) + mx::bfhi(v[j].w) * mx::bfhi(v[j].w)); }
    const float rstd = 1.0f / sqrtf(wave_sum(s) * (1.f / D) + EPS);
#pragma unroll
    for (int j = 0; j < 8; ++j) { const float* gp = g + 512 * j + 8 * lane; const mx::f32x4 g0 = *(const mx::f32x4*)gp, g1 = *(const mx::f32x4*)(gp + 4);
        float* op = orow + 512 * j + 8 * lane;
        *(mx::f32x4*)op = (mx::f32x4){mx::bflo(v[j].x) * rstd * g0[0], mx::bfhi(v[j].x) * rstd * g0[1], mx::bflo(v[j].y) * rstd * g0[2], mx::bfhi(v[j].y) * rstd * g0[3]};
        *(mx::f32x4*)(op + 4) = (mx::f32x4){mx::bflo(v[j].z) * rstd * g1[0], mx::bfhi(v[j].z) * rstd * g1[1], mx::bflo(v[j].w) * rstd * g1[2], mx::bfhi(v[j].w) * rstd * g1[3]}; }
}
constexpr int I_IN = (D / 64) * (DIN / 64), I_SQ = (D / 64) * (D / 64), I_FF = (D / 64) * (DFF / 64), P0_NITEMS = I_IN + 3 * I_SQ + 3 * I_FF;
__device__ __forceinline__ void p0_items(Frame& F, int it_lo, int it_hi, int lane, int gw = -1, int NGW = 0) {
    LAS float* scr = (LAS float*)(F.lds + F.wave * 16640);
    if (gw < 0) { gw = F.vcu * NWAVES + F.wave; NGW = F.G * NWAVES; }
    bf16* WIN = (bf16*)(F.ws + WS_WIN); bf16* WBR = (bf16*)(F.ws + WS_WBR); bf16* WBD = (bf16*)(F.ws + WS_WBD); bf16* WO = (bf16*)(F.ws + WS_WO); bf16* WGU = (bf16*)(F.ws + WS_WGU); bf16* WDN = (bf16*)(F.ws + WS_WDN);
    for (int it = it_lo + gw; it < it_hi; it += NGW) {
        int r = it;
        if (r < I_IN) { p0_transpose_item(F.in[3], D, DIN, WIN, 0, scr, r, lane); continue; } r -= I_IN;
        if (r < I_SQ) { p0_transpose_item(F.in[7], D, D, WBR, 0, scr, r, lane); continue; } r -= I_SQ;
        if (r < I_SQ) { p0_transpose_item(F.in[8], D, D, WBD, 0, scr, r, lane); continue; } r -= I_SQ;
        if (r < I_SQ) { p0_transpose_item(F.in[9], D, D, WO, 0, scr, r, lane); continue; } r -= I_SQ;
        if (r < I_FF) { p0_transpose_item(F.in[11], D, DFF, WGU, 1, scr, r, lane, F.in[10]); continue; } r -= I_FF;
        if (r < I_FF) { p0_transpose_item(F.in[12], D, DFF, WGU, 2, scr, r, lane, F.in[10]); continue; } r -= I_FF;
        p0_transpose_item(F.in[13], DFF, D, WDN, 0, scr, r, lane);
    }
}
__device__ __forceinline__ void p0_prologue(Frame& F) {
    const int gw = F.vcu * NWAVES + F.wave, NGW = F.G * NWAVES;
    p0_items(F, 0, I_IN, F.lane);
    bf16* U = (bf16*)(F.ws + WS_U);
    for (int m = gw; m < MROWS; m += NGW) {
        bf16* orow = U + (size_t)m * D;
        if (m < NX) rms_row<false>(F.in[0] + (size_t)m * D, F.in[2], orow, F.lane);
        else if (m < NX + NMETA) rms_row<false>(F.in[1] + (size_t)(m - NX) * D, F.in[2], orow, F.lane);
        else {
#pragma unroll
            for (int j = 0; j < 16; ++j) ((mx::u32x2*)orow)[F.lane + 64 * j] = (mx::u32x2){0u, 0u}; }
    }
}


__device__ __forceinline__ void meta_proj(lchar* lds, const bf16* U, const bf16* WIN, bf16* PROJ, int vcu, int G) {
    using namespace mx; typedef float f32x4_t __attribute__((ext_vector_type(4)));
    const int tid = opaque((int)threadIdx.x), wid = __builtin_amdgcn_readfirstlane(tid >> 6), lane = tid & 63, cg = wid & 3, kh = wid >> 2;
    LAS float* red = (LAS float*)lds;
    for (int c = vcu; c < 256; c += G) {
        const int g0 = c * 64, gi = g0 >> 12, grp = (gi == 0) ? 1 : (gi == 1) ? 2 : (gi == 2) ? 5 : 6, col0 = (g0 & 4095) + cg * 16;
        const bf16* wrow = WIN + (size_t)(grp * 4096 + col0 + (lane & 15)) * D + kh * 2048 + (lane >> 4) * 8;
        const bf16* urow = U + (size_t)(NX + (lane & 15)) * D + kh * 2048 + (lane >> 4) * 8;
        f32x4_t acc = {0.f, 0.f, 0.f, 0.f};
#pragma unroll 8
        for (int ks = 0; ks < 64; ++ks) { const bf16x8 a = *(const bf16x8*)(urow + ks * 32), bq = *(const bf16x8*)(wrow + ks * 32);
            acc = __builtin_amdgcn_mfma_f32_16x16x32_bf16(a, bq, acc, 0, 0, 0); }
        if (kh == 1) *(LAS f32x4_t*)(red + (cg * 64 + lane) * 4) = acc;
        __syncthreads();
        if (kh == 0) { const f32x4_t o = *(const LAS f32x4_t*)(red + (cg * 64 + lane) * 4); acc += o;
            const float sc = (grp == 1) ? 0.0625f : 1.f; bf16* op = PROJ + (size_t)grp * GS + (size_t)(NX + (lane >> 4) * 4) * D + col0 + (lane & 15);
#pragma unroll
            for (int i = 0; i < 4; ++i) op[(size_t)i * D] = (bf16)f2bf(acc[i] * sc); }
        if (grp >= 5 && tid < 384) { bf16* zp = PROJ + (size_t)grp * GS + (size_t)(NX + 16 + (tid >> 3)) * D + (g0 & 4095) + (tid & 7) * 8; *(u32x4*)zp = (u32x4){0u, 0u, 0u, 0u}; }
        __syncthreads();
    }
}

constexpr int ATT_NT = 129;
constexpr int CW_NRM = 8192;
#define BARF() do { asm volatile("" ::: "memory"); __builtin_amdgcn_s_barrier(); asm volatile("" ::: "memory"); } while (0)
__device__ __forceinline__ void attn_unit(lchar* lds, const bf16* Qg, const bf16* Kg, const bf16* Vg, bf16* Og, float* stash, const float* subg, const unsigned* nrm, int b, int h, int qb, float lam) {
    using namespace mx;
    const int tid = threadIdx.x, wid = __builtin_amdgcn_readfirstlane(tid >> 6), lane = tid & 63, r32 = lane & 31, hi = lane >> 5, grp = wid >> 2;
    lchar* Kb = lds; lchar* Vb = lds + 32768; LAS float* li_l = (LAS float*)(lds + 147456) + wid * 64; LAS float* al_l = li_l + 32; LAS float* mslot = (LAS float*)(lds + 147456 + 2048);
    const float slope = exp2f(-0.5f * (float)(h + 1)), nsl2 = -slope * LOG2E;
    constexpr float C = 0.08838834764831845f * LOG2E, THR2 = 60.f, NEG = -1e30f;
    const float asl = slope * LOG2E, Cq = 0.08838834764831845f / slope, THRQ = THR2 / asl, DEADQ = -127.f / asl;
    const int qrow = b * SEQ + qb * 256 + wid * 32 + r32;
    const float qposf = (float)(NMETA + qb * 256 + wid * 32 + r32 - 4 * hi);
    const int vb0 = lds_addr(Vb) + v_rd_base(lane);
    const int ka0 = lds_addr(Kb) + r32 * 256 + ((hi * 16) ^ ((r32 & 7) << 4));
#pragma unroll 1
    for (int mp = 0; mp < 2; ++mp) {
        int t_lo, t_hi;
        const float smax_l2 = sqrtf(__uint_as_float(nrm[(0 * 2 + b) * 32 + h * 2 + mp])) * sqrtf(__uint_as_float(nrm[(1 * 2 + b) * 32 + h * 2 + mp])) * C;
        const bf16* Qw = Qg + (size_t)qrow * D + h * 256 + mp * 128 + hi * 8;
        bf16x8 qr[8];
#pragma unroll
        for (int d0 = 0; d0 < 8; ++d0) qr[d0] = *(const bf16x8*)(Qw + d0 * 16);
        const char* Kcol = (const char*)(Kg + h * 256 + mp * 128); const char* Vcol = (const char*)(Vg + h * 256);
        { const bf16* Kw = Kg + (size_t)qrow * D + h * 256 + mp * 128 + hi * 8; float dot = 0.f;
#pragma unroll
          for (int d0 = 0; d0 < 8; ++d0) { const u32x4 kk = *(const u32x4*)(Kw + d0 * 16); const u32x4 qq = *reinterpret_cast<const u32x4*>(&qr[d0]);
              dot += bflo(kk.x) * bflo(qq.x) + bfhi(kk.x) * bfhi(qq.x) + bflo(kk.y) * bflo(qq.y) + bfhi(kk.y) * bfhi(qq.y) + bflo(kk.z) * bflo(qq.z) + bfhi(kk.z) * bfhi(qq.z) + bflo(kk.w) * bflo(qq.w) + bfhi(kk.w) * bfhi(qq.w); }
          { auto rr = __builtin_amdgcn_permlane32_swap(__float_as_uint(dot), __float_as_uint(dot), false, false); dot = __uint_as_float(rr[0]) + __uint_as_float(rr[1]); }
          float mm = dot * C; mm = fminf(mm, swz_xor<1>(mm)); mm = fminf(mm, swz_xor<2>(mm)); mm = fminf(mm, swz_xor<4>(mm)); mm = fminf(mm, swz_xor<8>(mm)); mm = fminf(mm, swz_xor<16>(mm));
          if (lane == 0) mslot[wid] = mm; LDS_WAIT(); BARF();
          float mmin = mslot[0];
#pragma unroll
          for (int w = 1; w < 8; ++w) mmin = fminf(mmin, mslot[w]);
          const float wf = fminf((smax_l2 - mmin + 152.f) / (-nsl2) + 2.f, 20000.f); const int W = (int)wf;
          const int qmin = NMETA + qb * 256, qmax = qmin + 255;
          const int klo = qmin - W, khi = qmax + W;
          t_lo = (klo <= 15) ? 0 : (klo + 48) / 64; if (t_lo > 128) t_lo = 128;
          t_hi = (khi + 48) / 64; if (t_hi > 128) t_hi = 128; if (t_hi < t_lo) t_hi = t_lo;
          t_lo = __builtin_amdgcn_readfirstlane(t_lo); t_hi = __builtin_amdgcn_readfirstlane(t_hi); }
        const int ntl = t_hi - t_lo + 1;
        f32x16 o[8];
#pragma unroll
        for (int d = 0; d < 8; ++d)
#pragma unroll
            for (int r = 0; r < 16; ++r) o[d][r] = 0.f;
        float m_reg = NEG, l_reg = 0.f;
#define ATT_ISSUE(t, buf) do { const size_t rb_ = ((t) == 0) ? (size_t)NX : (size_t)(b * SEQ + 64 * ((t) - 1)); const char* kg_ = Kcol + rb_ * (D * 2); const char* vg_ = Vcol + rb_ * (D * 2); const int tq_ = opaque(tid); \
        unsigned ko_, vo_; { int r_, c_; kimg_rc(tq_ * 16, r_, c_); ko_ = (unsigned)(r_ * (D * 2) + c_ * 2); vimg_rc(tq_ * 16, r_, c_); vo_ = (unsigned)(r_ * (D * 2) + c_ * 2); }     \
        _Pragma("unroll") for (int i_ = 0; i_ < 2; ++i_) glds16(kg_ + (size_t)i_ * (32 * D * 2) + ko_, Kb + (buf) * 16384 + (i_ * 8 + wid) * 1024); \
        _Pragma("unroll") for (int i_ = 0; i_ < 4; ++i_) glds16(vg_ + (size_t)i_ * (16 * D * 2) + vo_, Vb + (buf) * 32768 + (i_ * 8 + wid) * 1024); } while (0)
#define ATT_S1(KH) do { f32x16 p; \
            _Pragma("unroll") for (int r = 0; r < 16; ++r) p[r] = 0.f; \
            { const int ka = ka0 + cur * 16384 + KH * 8192; bf16x8 k0, k1, k2, k3, k4, k5, k6, k7;     \
              asm volatile("ds_read_b128 %0, %1" : "=&v"(k0) : "v"(ka) : "memory"); asm volatile("ds_read_b128 %0, %1" : "=&v"(k1) : "v"(ka ^ 32) : "memory"); \
              asm volatile("ds_read_b128 %0, %1" : "=&v"(k2) : "v"(ka ^ 64) : "memory"); asm volatile("ds_read_b128 %0, %1" : "=&v"(k3) : "v"(ka ^ 96) : "memory"); \
              asm volatile("ds_read_b128 %0, %1 offset:128" : "=&v"(k4) : "v"(ka) : "memory"); asm volatile("ds_read_b128 %0, %1 offset:128" : "=&v"(k5) : "v"(ka ^ 32) : "memory"); \
              asm volatile("ds_read_b128 %0, %1 offset:128" : "=&v"(k6) : "v"(ka ^ 64) : "memory"); asm volatile("ds_read_b128 %0, %1 offset:128" : "=&v"(k7) : "v"(ka ^ 96) : "memory"); \
              __builtin_amdgcn_s_setprio(2); asm volatile("s_waitcnt lgkmcnt(6)" ::: "memory"); SBAR(); p = __builtin_amdgcn_mfma_f32_32x32x16_bf16(k0, qr[0], p, 0, 0, 0); p = __builtin_amdgcn_mfma_f32_32x32x16_bf16(k1, qr[1], p, 0, 0, 0); SBAR(); \
              asm volatile("s_waitcnt lgkmcnt(4)" ::: "memory"); SBAR(); p = __builtin_amdgcn_mfma_f32_32x32x16_bf16(k2, qr[2], p, 0, 0, 0); p = __builtin_amdgcn_mfma_f32_32x32x16_bf16(k3, qr[3], p, 0, 0, 0); SBAR(); \
              asm volatile("s_waitcnt lgkmcnt(2)" ::: "memory"); SBAR(); p = __builtin_amdgcn_mfma_f32_32x32x16_bf16(k4, qr[4], p, 0, 0, 0); p = __builtin_amdgcn_mfma_f32_32x32x16_bf16(k5, qr[5], p, 0, 0, 0); SBAR(); \
              asm volatile("s_waitcnt lgkmcnt(0)" ::: "memory"); SBAR(); p = __builtin_amdgcn_mfma_f32_32x32x16_bf16(k6, qr[6], p, 0, 0, 0); p = __builtin_amdgcn_mfma_f32_32x32x16_bf16(k7, qr[7], p, 0, 0, 0); SBAR(); __builtin_amdgcn_s_setprio(0); } \
            _Pragma("unroll") for (int r = 0; r < 16; ++r) { const float dd = ((KH == 0 && r >= 8) ? q8 : qrel) - (float)((r & 3) + 8 * (r >> 2) + 32 * KH); p[r] = fmaf(p[r], Cq, -fabsf(dd)); } \
            float pmax = fmaxf(fmaxf(p[0], p[1]), p[2]); \
            _Pragma("unroll") for (int r = 3; r < 15; r += 2) pmax = fmaxf(fmaxf(pmax, p[r]), p[r + 1]); \
            pmax = fmaxf(pmax, p[15]); \
            { auto rr = __builtin_amdgcn_permlane32_swap(__float_as_uint(pmax), __float_as_uint(pmax), false, false); pmax = fmaxf(__uint_as_float(rr[0]), __uint_as_float(rr[1])); } \
              \
              \
            dead = __all(pmax - m_reg < DEADQ); \
            if (!dead) { float mn; \
            if (__builtin_expect(__all(pmax - m_reg <= THRQ), 1)) { mn = m_reg; alpha = 1.f; } \
            else { mn = fmaxf(m_reg, pmax); alpha = __builtin_amdgcn_exp2f((m_reg - mn) * asl); m_reg = mn; } \
            float ps = 0.f; const float nm = -mn * asl; \
            _Pragma("unroll") for (int r = 0; r < 16; ++r) { p[r] = __builtin_amdgcn_exp2f(fmaf(p[r], asl, nm)); ps += p[r]; } \
            { auto rr = __builtin_amdgcn_permlane32_swap(__float_as_uint(ps), __float_as_uint(ps), false, false); ps = __uint_as_float(rr[0]) + __uint_as_float(rr[1]); } \
            l_reg = l_reg * alpha + ps; \
            pack_p2(p, pa0, pa1); } } while (0)
#define ATT_S2(KH) do { if (!dead) { \
            if (__any(alpha < 1.f)) { if (hi == 0) al_l[r32] = alpha; LDS_WAIT(); \
                _Pragma("unroll") for (int r = 0; r < 16; ++r) { const float a = al_l[crow(r, hi)]; \
                    _Pragma("unroll") for (int d = 0; d < 8; ++d) o[d][r] *= a; } } \
            pv_half8<KH>(o, vb, pa0, pa1); } } while (0)
        int tcn = (NMETA + qb * 256 + 128 + 48) / 64; tcn = tcn < t_lo ? t_lo : (tcn > t_hi ? t_hi : tcn);
        if (t_lo == 0 && t_hi == 128) tcn = 0;
        const int nright = t_hi - tcn + 1;
#define ATT_TILE(i) (((i) < nright) ? tcn + (i) : tcn - 1 - ((i) - nright))
        ATT_ISSUE(ATT_TILE(0), 0); WAITBAR();
        if (grp == 1) BARF();
#pragma unroll 1
        for (int tt = 0; tt < ntl; ++tt) {
            const int t = ATT_TILE(tt), cur = tt & 1;
            const float qrel = qposf - (float)(t == 0 ? 0 : 64 * t - 48);
            const float q8 = (t == 0) ? 1e30f : qrel;
            const int vb = vb0 + cur * 32768;
            bf16x8 pa0, pa1; float alpha; bool dead;
            ATT_S1(0);
            BARF();
            if (tt + 1 < ntl) ATT_ISSUE(ATT_TILE(tt + 1), cur ^ 1);
            ATT_S2(0);
            BARF();
            if (t != 0) ATT_S1(1);
            asm volatile("s_waitcnt vmcnt(0)" ::: "memory");
            BARF();
            if (t != 0) ATT_S2(1);
            BARF();
        }
        if (grp == 0) BARF();
#undef ATT_ISSUE
#undef ATT_S1
#undef ATT_S2
#undef ATT_TILE
        if (hi == 0) li_l[r32] = l_reg; LDS_WAIT();
        const int hio = opaque(hi), lno = opaque(lane);
        f32x4* st4 = (f32x4*)(stash + (size_t)wid * 8192) + lno;
        if (mp == 0) {
#pragma unroll
            for (int q4 = 0; q4 < 4; ++q4) { float rl[4];
#pragma unroll
                for (int i = 0; i < 4; ++i) rl[i] = __builtin_amdgcn_rcpf(li_l[crow(4 * q4 + i, hio)]);
#pragma unroll
                for (int d = 0; d < 8; ++d) st4[(d * 4 + q4) * 64] = (f32x4){o[d][4 * q4] * rl[0], o[d][4 * q4 + 1] * rl[1], o[d][4 * q4 + 2] * rl[2], o[d][4 * q4 + 3] * rl[3]}; }
        } else {
            const int r32o = lno & 31;
            float gsc[8];
#pragma unroll
            for (int d = 0; d < 8; ++d) gsc[d] = subg[d * 32 + r32o] * 0.8f;
            lchar* tl = lds + wid * 16896;
#pragma unroll
            for (int q4 = 0; q4 < 4; ++q4) {
                f32x4 sv[8];
#pragma unroll
                for (int d = 0; d < 8; ++d) sv[d] = st4[(d * 4 + q4) * 64];
                asm volatile("" ::: "memory");
#pragma unroll
                for (int i = 0; i < 4; ++i) { const int r = 4 * q4 + i; const float rl = __builtin_amdgcn_rcpf(li_l[crow(r, hio)]) * lam; float ss = 0.f; float v[8];
#pragma unroll
                    for (int d = 0; d < 8; ++d) { v[d] = sv[d][i] - o[d][r] * rl; ss += v[d] * v[d]; }
                    ss = half_sum(ss);
                    const float rs = 1.0f / sqrtf(ss * (1.f / 256.f) + EPS);
#pragma unroll
                    for (int d = 0; d < 8; ++d) *(LAS bf16*)(tl + crow(r, hio) * 528 + (d * 32 + r32o) * 2) = (bf16)f2bf(v[d] * rs * gsc[d]); }
                asm volatile("" ::: "memory"); }
            LDS_WAIT();
            bf16* orow = Og + (size_t)(b * SEQ + qb * 256 + wid * 32 + (lno >> 5)) * D + h * 256 + (lno & 31) * 8;
#pragma unroll
            for (int i = 0; i < 16; ++i) { const lchar* sp = tl + (2 * i + (lno >> 5)) * 528 + (lno & 31) * 16; const u32x2 lo = *(const LAS u32x2*)sp, hi2 = *(const LAS u32x2*)(sp + 8);
                *(u32x4*)(orow + (size_t)(2 * i) * D) = (u32x4){lo.x, lo.y, hi2.x, hi2.y}; }
            LDS_WAIT();
        }
        BARF();
    }
}
__device__ __forceinline__ void normmax_phase(Frame& F, const bf16* Qg, const bf16* Kg, unsigned* nrm) {
    using namespace mx;
    LAS unsigned* red = (LAS unsigned*)(F.lds + 131072);
    if (F.tid < 64) red[F.tid] = 0u;
    __syncthreads();
    for (int c = F.vcu; c < 256; c += F.G) {
        const int b = c >> 7; float mq[8], mk[8];
#pragma unroll
        for (int j = 0; j < 8; ++j) { mq[j] = 0.f; mk[j] = 0.f; }
        const int nrow = (c == 0 || c == 128) ? 10 : 8;
        for (int i = 0; i < nrow; ++i) {
            const int row = (i < 8) ? c * 64 + F.wave * 8 + i : NX + F.wave * 2 + (i - 8);
#pragma unroll
            for (int j = 0; j < 8; ++j) {
                const u32x4 kv = *(const u32x4*)(Kg + (size_t)row * D + 512 * j + 8 * F.lane);
                float sk = bflo(kv.x) * bflo(kv.x) + bfhi(kv.x) * bfhi(kv.x) + bflo(kv.y) * bflo(kv.y) + bfhi(kv.y) * bfhi(kv.y) + bflo(kv.z) * bflo(kv.z) + bfhi(kv.z) * bfhi(kv.z) + bflo(kv.w) * bflo(kv.w) + bfhi(kv.w) * bfhi(kv.w);
                sk += swz_xor<1>(sk); sk += swz_xor<2>(sk); sk += swz_xor<4>(sk); sk += swz_xor<8>(sk); mk[j] = fmaxf(mk[j], sk);
                if (i < 8) { const u32x4 qv = *(const u32x4*)(Qg + (size_t)row * D + 512 * j + 8 * F.lane);
                    float sq = bflo(qv.x) * bflo(qv.x) + bfhi(qv.x) * bfhi(qv.x) + bflo(qv.y) * bflo(qv.y) + bfhi(qv.y) * bfhi(qv.y) + bflo(qv.z) * bflo(qv.z) + bfhi(qv.z) * bfhi(qv.z) + bflo(qv.w) * bflo(qv.w) + bfhi(qv.w) * bfhi(qv.w);
                    sq += swz_xor<1>(sq); sq += swz_xor<2>(sq); sq += swz_xor<4>(sq); sq += swz_xor<8>(sq); mq[j] = fmaxf(mq[j], sq); } }
        }
        if ((F.lane & 15) == 0) {
#pragma unroll
            for (int j = 0; j < 8; ++j) { const int seg = 4 * j + (F.lane >> 4); __hip_atomic_fetch_max(red + seg, __float_as_uint(mq[j]), __ATOMIC_RELAXED, __HIP_MEMORY_SCOPE_WORKGROUP); __hip_atomic_fetch_max(red + 32 + seg, __float_as_uint(mk[j]), __ATOMIC_RELAXED, __HIP_MEMORY_SCOPE_WORKGROUP); } }
        __syncthreads();
        if (F.tid < 64) { const int tsr = F.tid >> 5, seg = F.tid & 31; __hip_atomic_fetch_max(nrm + (tsr * 2 + b) * 32 + seg, red[F.tid], __ATOMIC_RELAXED, __HIP_MEMORY_SCOPE_AGENT); red[F.tid] = 0u; }
        __syncthreads();
    }
}

__device__ __forceinline__ void ret_local_unit(lchar* lds, const bf16* Kg, const bf16* Vg, bf16* ST, int b, int h, int c, float lgf2, float lgb2) {
    using namespace mx;
    const int tid = threadIdx.x, wid = __builtin_amdgcn_readfirstlane(tid >> 6), lane = tid & 63, r32 = lane & 31, hi = lane >> 5;
    __syncthreads();
    { const int tq = opaque(tid); const size_t hb = ((size_t)((b * NH + h) * SEQ + 128 * c)) * 256;
      const char* kg = (const char*)(Kg + hb); const char* vg = (const char*)(Vg + hb);
#pragma unroll
      for (int hf = 0; hf < 2; ++hf)
#pragma unroll
        for (int i = 0; i < 4; ++i) { int k, c2; vimg_rc((i * 512 + tq) * 16, k, c2); const unsigned off = (unsigned)((64 * hf + k) * 512 + c2 * 2);
            glds16(kg + off, lds + hf * 32768 + (i * 8 + wid) * 1024); glds16(vg + off, lds + 65536 + hf * 32768 + (i * 8 + wid) * 1024); } }
    WAITBAR();
    const int vbK = lds_addr(lds) + v_rd_base(lane) + wid * 512, vbV = lds_addr(lds) + 65536 + v_rd_base(lane);
#pragma unroll 1
    for (int dir = 0; dir < 2; ++dir) {
        f32x16 acc[8];
#pragma unroll
        for (int d = 0; d < 8; ++d)
#pragma unroll
            for (int r = 0; r < 16; ++r) acc[d][r] = 0.f;
        const float lg = dir == 0 ? lgf2 : lgb2;
#define RL_W(T) __builtin_amdgcn_exp2f(lg * (float)(dir == 0 ? 127 - (T) : (T)))
#define RL_STEP(HF, KS) do { const int vk_ = vbK + (HF) * 32768, vv_ = vbV + (HF) * 32768; \
            const s16x4 al = tr_read<vro(0, KS, 0)>(vk_), ah = tr_read<vro(0, KS, 1)>(vk_); \
            const s16x4 l0 = tr_read<vro(0, KS, 0)>(vv_), h0 = tr_read<vro(0, KS, 1)>(vv_), l1 = tr_read<vro(1, KS, 0)>(vv_), h1 = tr_read<vro(1, KS, 1)>(vv_), l2 = tr_read<vro(2, KS, 0)>(vv_), h2 = tr_read<vro(2, KS, 1)>(vv_), l3 = tr_read<vro(3, KS, 0)>(vv_), h3 = tr_read<vro(3, KS, 1)>(vv_); \
            const s16x4 l4 = tr_read<vro(4, KS, 0)>(vv_), h4 = tr_read<vro(4, KS, 1)>(vv_), l5 = tr_read<vro(5, KS, 0)>(vv_), h5 = tr_read<vro(5, KS, 1)>(vv_), l6 = tr_read<vro(6, KS, 0)>(vv_), h6 = tr_read<vro(6, KS, 1)>(vv_), l7 = tr_read<vro(7, KS, 0)>(vv_), h7 = tr_read<vro(7, KS, 1)>(vv_); \
            const int tb_ = 64 * (HF) + 16 * (KS) + 8 * hi; \
            const float w0 = RL_W(tb_), w1 = RL_W(tb_ + 1), w2 = RL_W(tb_ + 2), w3 = RL_W(tb_ + 3), w4 = RL_W(tb_ + 4), w5 = RL_W(tb_ + 5), w6 = RL_W(tb_ + 6), w7 = RL_W(tb_ + 7); \
            asm volatile("s_waitcnt lgkmcnt(0)" ::: "memory"); SBAR(); \
            const bf16x8 ar = MX_PK(al, ah); const u32x4 aw = *reinterpret_cast<const u32x4*>(&ar); u32x4 as_; \
            as_.x = cvtpk(bflo(aw.x) * w0, bfhi(aw.x) * w1); as_.y = cvtpk(bflo(aw.y) * w2, bfhi(aw.y) * w3); as_.z = cvtpk(bflo(aw.z) * w4, bfhi(aw.z) * w5); as_.w = cvtpk(bflo(aw.w) * w6, bfhi(aw.w) * w7); \
            const bf16x8 a = *reinterpret_cast<const bf16x8*>(&as_); \
            acc[0] = __builtin_amdgcn_mfma_f32_32x32x16_bf16(a, MX_PK(l0, h0), acc[0], 0, 0, 0); acc[1] = __builtin_amdgcn_mfma_f32_32x32x16_bf16(a, MX_PK(l1, h1), acc[1], 0, 0, 0); \
            acc[2] = __builtin_amdgcn_mfma_f32_32x32x16_bf16(a, MX_PK(l2, h2), acc[2], 0, 0, 0); acc[3] = __builtin_amdgcn_mfma_f32_32x32x16_bf16(a, MX_PK(l3, h3), acc[3], 0, 0, 0); \
            acc[4] = __builtin_amdgcn_mfma_f32_32x32x16_bf16(a, MX_PK(l4, h4), acc[4], 0, 0, 0); acc[5] = __builtin_amdgcn_mfma_f32_32x32x16_bf16(a, MX_PK(l5, h5), acc[5], 0, 0, 0); \
            acc[6] = __builtin_amdgcn_mfma_f32_32x32x16_bf16(a, MX_PK(l6, h6), acc[6], 0, 0, 0); acc[7] = __builtin_amdgcn_mfma_f32_32x32x16_bf16(a, MX_PK(l7, h7), acc[7], 0, 0, 0); } while (0)
        RL_STEP(0, 0); RL_STEP(0, 1); RL_STEP(0, 2); RL_STEP(0, 3); RL_STEP(1, 0); RL_STEP(1, 1); RL_STEP(1, 2); RL_STEP(1, 3);
#undef RL_STEP
#undef RL_W
        bf16* S = ST + ((size_t)(((b * NH + h) * 2 + dir) * 64 + c) << 16);
        const int hio = opaque(hi), r32o = opaque(r32);
#pragma unroll
        for (int r = 0; r < 16; ++r) { bf16* sp = S + (size_t)(32 * wid + crow(r, hio)) * 256 + r32o;
#pragma unroll
            for (int d = 0; d < 8; ++d) sp[d * 32] = (bf16)f2bf(acc[d][r]); }
    }
}
__device__ __forceinline__ void ret_scan(Frame& F, const bf16* Kg, const bf16* Vg, bf16* ST, const float* logdec) {
    using namespace mx;
    const int gid = F.vcu * 512 + F.tid, NT = F.G * 512, NV = 64 * 8192;
    for (int vb = gid; vb < NV; vb += 4 * NT) {
        float s[4][8], dec[4]; bf16* base[4]; int dirs[4]; bool ok[4]; u32x4 nx[4];
#pragma unroll
        for (int q = 0; q < 4; ++q) {
            const int v0 = vb + q * NT; ok[q] = v0 < NV; const int vv0 = ok[q] ? v0 : gid;
            const int seq = vv0 >> 13, e = (vv0 & 8191) * 8, dir = seq & 1, h = (seq >> 1) & 15, dk = e >> 8, dv = e & 255; dirs[q] = dir;
            const float lg2 = -expf(logdec[dir * NH + h]) * LOG2E; dec[q] = __builtin_amdgcn_exp2f(lg2 * 128.f);
#pragma unroll
            for (int j = 0; j < 8; ++j) s[q][j] = 0.f;
            if (dir == 0) {
                for (int m = 0; m < NMETA; ++m) { const float w = __builtin_amdgcn_exp2f(lg2 * (float)(15 - m)) * __uint_as_float((unsigned)Kg[(size_t)(NX + m) * D + h * 256 + dk] << 16);
                    const u32x4 vv = *(const u32x4*)(Vg + (size_t)(NX + m) * D + h * 256 + dv);
                    s[q][0] += w * bflo(vv.x); s[q][1] += w * bfhi(vv.x); s[q][2] += w * bflo(vv.y); s[q][3] += w * bfhi(vv.y); s[q][4] += w * bflo(vv.z); s[q][5] += w * bfhi(vv.z); s[q][6] += w * bflo(vv.w); s[q][7] += w * bfhi(vv.w); }
            }
            base[q] = ST + ((size_t)(seq * 64) << 16) + e;
            nx[q] = *(const u32x4*)(base[q] + ((size_t)(dir == 0 ? 0 : 63) << 16));
        }
#pragma unroll 2
        for (int st = 0; st < 64; ++st) {
            u32x4 t[4];
#pragma unroll
            for (int q = 0; q < 4; ++q) { t[q] = nx[q]; if (st + 1 < 64) nx[q] = *(const u32x4*)(base[q] + ((size_t)(dirs[q] == 0 ? st + 1 : 62 - st) << 16)); }
#pragma unroll
            for (int q = 0; q < 4; ++q) { bf16* p = base[q] + ((size_t)(dirs[q] == 0 ? st : 63 - st) << 16);
                u32x4 w; w.x = pk2(s[q][0], s[q][1]); w.y = pk2(s[q][2], s[q][3]); w.z = pk2(s[q][4], s[q][5]); w.w = pk2(s[q][6], s[q][7]);
                if (ok[q]) *(u32x4*)p = w;
                const float d = dec[q];
                s[q][0] = s[q][0] * d + bflo(t[q].x); s[q][1] = s[q][1] * d + bfhi(t[q].x); s[q][2] = s[q][2] * d + bflo(t[q].y); s[q][3] = s[q][3] * d + bfhi(t[q].y);
                s[q][4] = s[q][4] * d + bflo(t[q].z); s[q][5] = s[q][5] * d + bfhi(t[q].z); s[q][6] = s[q][6] * d + bflo(t[q].w); s[q][7] = s[q][7] * d + bfhi(t[q].w); }
        }
    }
}
struct RoUnit { int b, h, c; };
__device__ __forceinline__ RoUnit ro_unit(int id) { RoUnit u; const int bh = id >> 6; u.b = bh >> 4; u.h = bh & 15; u.c = id & 63; return u; }
__device__ __forceinline__ void ret_out_phase(lchar* lds, const bf16* Qg, const bf16* Kg, const bf16* Vg, const bf16* Gg, const bf16* ST, bf16* Og, const float* logdec, int vcu, int G) {
    using namespace mx;
    const int tid = threadIdx.x, wid = __builtin_amdgcn_readfirstlane(tid >> 6), lane = tid & 63, r32 = lane & 31, hi = lane >> 5, rb = wid & 3, dh = wid >> 2;
    LAS unsigned* offl = (LAS unsigned*)(lds + 131072);
    LAS float* ssl = (LAS float*)(lds + 147456);
    { const int tq = opaque(tid);
#pragma unroll
      for (int i = 0; i < 4; ++i) { const int P = (i * 512 + tq) * 16; int r, cc; kimg_rc(P & 16383, r, cc); cc += (P >> 14) * 128; int k, c2; vimg_rc(P, k, c2);
          offl[i * 512 + tq] = (unsigned)(r * 512 + cc * 2); offl[(4 + i) * 512 + tq] = (unsigned)(k * 512 + c2 * 2); } }
    __syncthreads();
    const int nun = (2048 - vcu + G - 1) / G;
#define RO_ISSUE(u, k, SLOT) do { const size_t hb_ = ((size_t)(((u).b * NH + (u).h) * SEQ + 128 * (u).c)) * 256; const LAS unsigned* of_ = offl + opaque(tid); \
        if ((k) < 4) { const bf16* src_ = (((k) & 1) ? Vg : Kg) + hb_ + (size_t)(64 * ((k) >> 1)) * 256; \
            _Pragma("unroll") for (int i_ = 0; i_ < 4; ++i_) glds16((const char*)src_ + of_[(((k) & 1) * 4 + i_) * 512], lds + (SLOT) * 32768 + (i_ * 8 + wid) * 1024); } \
        else { const char* src_ = (const char*)(ST + ((size_t)((((u).b * NH + (u).h) * 2 + (((k) - 4) >> 2)) * 64 + (u).c) << 16)) + (size_t)(((k) - 4) & 3) * 64 * 512; \
            _Pragma("unroll") for (int i_ = 0; i_ < 4; ++i_) glds16(src_ + of_[(4 + i_) * 512], lds + (SLOT) * 32768 + (i_ * 8 + wid) * 1024); } } while (0)
    RoUnit cu = ro_unit(vcu);
    RO_ISSUE(cu, 0, 0); RO_ISSUE(cu, 1, 1); RO_ISSUE(cu, 2, 2);
    const int ka0 = lds_addr(lds) + r32 * 256 + ((hi * 16) ^ ((r32 & 7) << 4));
    const int vb0 = lds_addr(lds) + v_rd_base(lane) + dh * 2048;
#pragma unroll 1
    for (int ui = 0; ui < nun; ++ui) {
        const bool lastu = (ui + 1 == nun); const RoUnit nu = ro_unit(vcu + (ui + 1) * G);
        const float lgf2 = -expf(logdec[cu.h]) * LOG2E, lgb2 = -expf(logdec[NH + cu.h]) * LOG2E;
        const int r0 = cu.b * SEQ + 128 * cu.c, ii = 32 * rb + r32;
        bf16x8 qr[16];
        const size_t hb = ((size_t)((cu.b * NH + cu.h) * SEQ + 128 * cu.c)) * 256;
        { const bf16* Qw = Qg + hb + (size_t)opaque(ii) * 256 + opaque(hi) * 8;
#pragma unroll
          for (int d0 = 0; d0 < 16; ++d0) qr[d0] = *(const bf16x8*)(Qw + d0 * 16); }
        f32x16 o[4]; bf16x8 pa0, pa1, pa2, pa3;
#pragma unroll
        for (int d = 0; d < 4; ++d)
#pragma unroll
            for (int r = 0; r < 16; ++r) o[d][r] = 0.f;
#define RO_OPEN(k) do { if (lastu && (k) >= 10) { if ((k) == 10) asm volatile("s_waitcnt vmcnt(4)" ::: "memory"); else asm volatile("s_waitcnt vmcnt(0)" ::: "memory"); } else asm volatile("s_waitcnt vmcnt(8)" ::: "memory"); \
        BARF(); if ((k) + 3 < 12) RO_ISSUE(cu, (k) + 3, ((k) + 3) & 3); else if (!lastu) RO_ISSUE(nu, (k) + 3 - 12, ((k) + 3) & 3); } while (0)
#define RO_QKCHAIN(P, KB, OFF) do { bf16x8 k0, k1, k2, k3, k4, k5, k6, k7; \
            asm volatile("ds_read_b128 %0, %1 offset:%2" : "=&v"(k0) : "v"(KB), "i"(OFF) : "memory"); asm volatile("ds_read_b128 %0, %1 offset:%2" : "=&v"(k1) : "v"(KB ^ 32), "i"(OFF) : "memory"); \
            asm volatile("ds_read_b128 %0, %1 offset:%2" : "=&v"(k2) : "v"(KB ^ 64), "i"(OFF) : "memory"); asm volatile("ds_read_b128 %0, %1 offset:%2" : "=&v"(k3) : "v"(KB ^ 96), "i"(OFF) : "memory"); \
            asm volatile("ds_read_b128 %0, %1 offset:%2" : "=&v"(k4) : "v"(KB), "i"(OFF + 128) : "memory"); asm volatile("ds_read_b128 %0, %1 offset:%2" : "=&v"(k5) : "v"(KB ^ 32), "i"(OFF + 128) : "memory"); \
            asm volatile("ds_read_b128 %0, %1 offset:%2" : "=&v"(k6) : "v"(KB ^ 64), "i"(OFF + 128) : "memory"); asm volatile("ds_read_b128 %0, %1 offset:%2" : "=&v"(k7) : "v"(KB ^ 96), "i"(OFF + 128) : "memory"); \
            asm volatile("s_waitcnt lgkmcnt(4)" ::: "memory"); SBAR(); \
            P = __builtin_amdgcn_mfma_f32_32x32x16_bf16(k0, qr[(OFF >= 16384 ? 8 : 0) + 0], P, 0, 0, 0); P = __builtin_amdgcn_mfma_f32_32x32x16_bf16(k1, qr[(OFF >= 16384 ? 8 : 0) + 1], P, 0, 0, 0); \
            P = __builtin_amdgcn_mfma_f32_32x32x16_bf16(k2, qr[(OFF >= 16384 ? 8 : 0) + 2], P, 0, 0, 0); P = __builtin_amdgcn_mfma_f32_32x32x16_bf16(k3, qr[(OFF >= 16384 ? 8 : 0) + 3], P, 0, 0, 0); SBAR(); \
            asm volatile("s_waitcnt lgkmcnt(0)" ::: "memory"); SBAR(); \
            P = __builtin_amdgcn_mfma_f32_32x32x16_bf16(k4, qr[(OFF >= 16384 ? 8 : 0) + 4], P, 0, 0, 0); P = __builtin_amdgcn_mfma_f32_32x32x16_bf16(k5, qr[(OFF >= 16384 ? 8 : 0) + 5], P, 0, 0, 0); \
            P = __builtin_amdgcn_mfma_f32_32x32x16_bf16(k6, qr[(OFF >= 16384 ? 8 : 0) + 6], P, 0, 0, 0); P = __builtin_amdgcn_mfma_f32_32x32x16_bf16(k7, qr[(OFF >= 16384 ? 8 : 0) + 7], P, 0, 0, 0); SBAR(); } while (0)
#define RO_SCORES(SLOT, KT) do { f32x16 p0, p1; \
            _Pragma("unroll") for (int r = 0; r < 16; ++r) { p0[r] = 0.f; p1[r] = 0.f; } \
            { const int kb_ = opaque(ka0) + (SLOT) * 32768; RO_QKCHAIN(p0, kb_, 0); RO_QKCHAIN(p0, kb_, 16384); const int kc_ = opaque(kb_) + 8192; RO_QKCHAIN(p1, kc_, 0); RO_QKCHAIN(p1, kc_, 16384); } \
            const float df = (float)(opaque(ii) - 64 * (KT) - 4 * opaque(hi)); \
            _Pragma("unroll") for (int r = 0; r < 16; ++r) { const float d0_ = df - (float)((r & 3) + 8 * (r >> 2)), d1_ = d0_ - 32.f; \
                p0[r] *= __builtin_amdgcn_exp2f(d0_ >= 0.f ? lgf2 * d0_ : -lgb2 * d0_); p1[r] *= __builtin_amdgcn_exp2f(d1_ >= 0.f ? lgf2 * d1_ : -lgb2 * d1_); } \
            pack_p(p0, p1, pa0, pa1, pa2, pa3); } while (0)
#define RO_BRD(D0, L0, H0, L1, H1, L2, H2, L3, H3) const s16x4 L0 = tr_read<vro(D0, 0, 0)>(vb_), H0 = tr_read<vro(D0, 0, 1)>(vb_), L1 = tr_read<vro(D0, 1, 0)>(vb_), H1 = tr_read<vro(D0, 1, 1)>(vb_), \
            L2 = tr_read<vro(D0, 2, 0)>(vb_), H2 = tr_read<vro(D0, 2, 1)>(vb_), L3 = tr_read<vro(D0, 3, 0)>(vb_), H3 = tr_read<vro(D0, 3, 1)>(vb_)
#define RO_BMM(ACC, A0, A1, A2, A3, L0, H0, L1, H1, L2, H2, L3, H3) do { ACC = __builtin_amdgcn_mfma_f32_32x32x16_bf16(A0, MX_PK(L0, H0), ACC, 0, 0, 0); ACC = __builtin_amdgcn_mfma_f32_32x32x16_bf16(A1, MX_PK(L1, H1), ACC, 0, 0, 0); \
            ACC = __builtin_amdgcn_mfma_f32_32x32x16_bf16(A2, MX_PK(L2, H2), ACC, 0, 0, 0); ACC = __builtin_amdgcn_mfma_f32_32x32x16_bf16(A3, MX_PK(L3, H3), ACC, 0, 0, 0); } while (0)
#define RO_MUL(ACC, SLOT, A0, A1, A2, A3) do { const int vb_ = opaque(vb0) + (SLOT) * 32768; \
            RO_BRD(0, a_l0, a_h0, a_l1, a_h1, a_l2, a_h2, a_l3, a_h3); RO_BRD(1, b_l0, b_h0, b_l1, b_h1, b_l2, b_h2, b_l3, b_h3); \
            asm volatile("s_waitcnt lgkmcnt(8)" ::: "memory"); SBAR(); RO_BMM(ACC[0], A0, A1, A2, A3, a_l0, a_h0, a_l1, a_h1, a_l2, a_h2, a_l3, a_h3); SBAR(); \
            RO_BRD(2, c_l0, c_h0, c_l1, c_h1, c_l2, c_h2, c_l3, c_h3); \
            asm volatile("s_waitcnt lgkmcnt(8)" ::: "memory"); SBAR(); RO_BMM(ACC[1], A0, A1, A2, A3, b_l0, b_h0, b_l1, b_h1, b_l2, b_h2, b_l3, b_h3); SBAR(); \
            RO_BRD(3, d_l0, d_h0, d_l1, d_h1, d_l2, d_h2, d_l3, d_h3); \
            asm volatile("s_waitcnt lgkmcnt(8)" ::: "memory"); SBAR(); RO_BMM(ACC[2], A0, A1, A2, A3, c_l0, c_h0, c_l1, c_h1, c_l2, c_h2, c_l3, c_h3); SBAR(); \
            asm volatile("s_waitcnt lgkmcnt(0)" ::: "memory"); SBAR(); RO_BMM(ACC[3], A0, A1, A2, A3, d_l0, d_h0, d_l1, d_h1, d_l2, d_h2, d_l3, d_h3); } while (0)
#define RO_QSC(DST, SRC, F) do { const u32x4 w_ = *reinterpret_cast<const u32x4*>(&(SRC)); u32x4 x_; x_.x = cvtpk(bflo(w_.x) * (F), bfhi(w_.x) * (F)); x_.y = cvtpk(bflo(w_.y) * (F), bfhi(w_.y) * (F)); \
            x_.z = cvtpk(bflo(w_.z) * (F), bfhi(w_.z) * (F)); x_.w = cvtpk(bflo(w_.w) * (F), bfhi(w_.w) * (F)); DST = *reinterpret_cast<bf16x8*>(&x_); } while (0)
#define RO_STATE(SLOT, DT, F) do { bf16x8 q0_, q1_, q2_, q3_; RO_QSC(q0_, qr[4 * (DT)], F); RO_QSC(q1_, qr[4 * (DT) + 1], F); RO_QSC(q2_, qr[4 * (DT) + 2], F); RO_QSC(q3_, qr[4 * (DT) + 3], F); RO_MUL(o, SLOT, q0_, q1_, q2_, q3_); } while (0)
        RO_OPEN(0); RO_SCORES(0, 0);
        RO_OPEN(1); RO_MUL(o, 1, pa0, pa1, pa2, pa3);
        RO_OPEN(2); RO_SCORES(2, 1);
        RO_OPEN(3); RO_MUL(o, 3, pa0, pa1, pa2, pa3);
        { const float ff = __builtin_amdgcn_exp2f(lgf2 * (float)(opaque(ii) + 1));
          RO_OPEN(4); RO_STATE(0, 0, ff);
          RO_OPEN(5); RO_STATE(1, 1, ff);
          RO_OPEN(6); RO_STATE(2, 2, ff);
          RO_OPEN(7); RO_STATE(3, 3, ff); }
        { const float fb = __builtin_amdgcn_exp2f(lgb2 * (float)(128 - opaque(ii)));
          RO_OPEN(8); RO_STATE(0, 0, fb);
          RO_OPEN(9); RO_STATE(1, 1, fb);
          RO_OPEN(10); RO_STATE(2, 2, fb);
          RO_OPEN(11); RO_STATE(3, 3, fb); }
        { const int hio = opaque(hi), r32o = opaque(r32);
#pragma unroll
          for (int r = 0; r < 16; ++r) { float ss = 0.f;
#pragma unroll
              for (int d = 0; d < 4; ++d) ss += o[d][r] * o[d][r];
              ss = half_sum(ss);
              if (r32 == 0) ssl[(rb * 2 + dh) * 32 + crow(r, hio)] = ss; }
          LDS_WAIT(); BARF();
#pragma unroll
          for (int r = 0; r < 16; ++r) { const int rw = crow(r, hio); const float tot = ssl[(rb * 2) * 32 + rw] + ssl[(rb * 2 + 1) * 32 + rw]; const float rs = 1.0f / sqrtf(tot * (1.f / 256.f) + EPS);
              const size_t gi = hb + (size_t)(32 * rb + rw) * 256 + 128 * dh + r32o, go = (size_t)(r0 + 32 * rb + rw) * D + cu.h * 256 + 128 * dh + r32o;
#pragma unroll
              for (int d = 0; d < 4; ++d) { const float g = __uint_as_float((unsigned)Gg[gi + d * 32] << 16); Og[go + d * 32] = (bf16)f2bf(o[d][r] * rs * g); } }
          asm volatile("s_waitcnt vmcnt(0) lgkmcnt(0)" ::: "memory"); BARF(); }
        cu = nu;
    }
#undef RO_ISSUE
#undef RO_OPEN
#undef RO_QKCHAIN
#undef RO_SCORES
#undef RO_BRD
#undef RO_BMM
#undef RO_MUL
#undef RO_QSC
#undef RO_STATE
}

#ifndef MK_N_LAUNCHES
#define MK_N_LAUNCHES 1
#endif
#ifndef WGM_P1
#define WGM_P1 4
#endif
#ifndef WGM_SQ
#define WGM_SQ 4
#endif
#ifndef WGM_P9
#define WGM_P9 4
#endif
#ifndef WGM_P10
#define WGM_P10 4
#endif
constexpr int NPH = 12;
struct Args { const float* in[15]; float* out; unsigned char* ws; int ph_lo, ph_hi, flags, pad; };
__global__ void __launch_bounds__(NWAVES * 64, 2) fwd(Args args) {
    extern __shared__ __attribute__((aligned(16))) unsigned char lds_raw[];
    Frame F;
    F.lds = (lchar*)lds_raw; F.MISC = (volatile LAS unsigned*)(F.lds + MISC_OFF);
    F.tid = threadIdx.x; F.lane = F.tid & 63; F.wave = __builtin_amdgcn_readfirstlane(F.tid >> 6);
    F.G = gridDim.x; { const int bx = blockIdx.x; F.vcu = (F.G % 8 == 0) ? (bx % 8) * (F.G / 8) + bx / 8 : bx; }
    F.ws = args.ws; F.ctl = (unsigned*)(args.ws + WS_CTL); F.out = args.out;
#pragma unroll
    for (int i = 0; i < 15; ++i) F.in[i] = args.in[i];
    if (F.tid < 64) ((LAS unsigned*)(F.lds + MISC_OFF))[F.tid] = 0u;
    __syncthreads();
    const int lo = args.ph_lo, hi = args.ph_hi;
    XcdBarrier bar; bar.bar = F.ctl + CW_BAR; bar.x = 0; bar.st = nullptr;
    if (hi - lo > 1) bar = xcd_barrier_post(F.ctl + CW_BAR, F.MISC + 8);
#ifndef PH_MASK
#define PH_MASK 0xFFF
#endif
#define IN(k) (((PH_MASK >> (k)) & 1) && lo <= (k) && (k) < hi)
#define SEAM(k) do { if (IN(k) && IN((k) + 1)) xcd_barrier(bar); } while (0)
    bf16* WIN = (bf16*)(F.ws + WS_WIN); bf16* WBR = (bf16*)(F.ws + WS_WBR); bf16* WBD = (bf16*)(F.ws + WS_WBD); bf16* WO = (bf16*)(F.ws + WS_WO); bf16* WGU = (bf16*)(F.ws + WS_WGU); bf16* WDN = (bf16*)(F.ws + WS_WDN);
    bf16* U = (bf16*)(F.ws + WS_U); bf16* PROJ = (bf16*)(F.ws + WS_PROJ); bf16* ST = (bf16*)(F.ws + WS_ST);
    bf16* MIXED = (bf16*)(F.ws + WS_MIXED); bf16* U2 = (bf16*)(F.ws + WS_U2); bf16* ACT = (bf16*)(F.ws + WS_ACT);
    bf16* G_RQ = PROJ, *G_RK = PROJ + GS, *G_RV = PROJ + 2 * GS, *G_RG = PROJ + 3 * GS, *G_DQ = PROJ + 4 * GS, *G_DK = PROJ + 5 * GS, *G_DV = PROJ + 6 * GS, *G_GA = PROJ + 7 * GS, *G_GB = PROJ + 8 * GS;

    if (IN(0)) { p0_prologue(F); __syncthreads(); }
    SEAM(0);
    if (IN(1)) { pg8::Gemm g{U, WIN, NX, DIN, D}; pg8::StaticOrder S; S.init(NX, DIN, F.G, (int)blockIdx.x, WGM_P1);
        pg8::EpiProj E{PROJ, GS};
        pg8::gemm_phase<pg8::EpiProj, pg8::StaticOrder, true, true>((PG8_LAS unsigned char*)F.lds, g, S, E);
        __syncthreads();
        meta_proj(F.lds, U, WIN, PROJ, F.vcu, F.G); }
    SEAM(1);
    if (IN(2)) {
        normmax_phase(F, G_DQ, G_DK, F.ctl + CW_NRM);
        for (int id = F.vcu; id < 2048; id += F.G) { const int bh = id >> 6, c = id & 63, h = bh & 15;
            const float lgf2 = -expf(F.in[4][h]) * LOG2E, lgb2 = -expf(F.in[4][NH + h]) * LOG2E;
            ret_local_unit(F.lds, G_RK, G_RV, ST, bh >> 4, h, c, lgf2, lgb2); }
    }
    SEAM(2);
    if (IN(3)) ret_scan(F, G_RK, G_RV, ST, F.in[4]);
    SEAM(3);
    if (IN(4)) {
        float lam; { const float* lp = F.in[5]; const float a = wave_sum(lp[F.lane] * lp[128 + F.lane] + lp[64 + F.lane] * lp[192 + F.lane]), c = wave_sum(lp[256 + F.lane] * lp[384 + F.lane] + lp[320 + F.lane] * lp[448 + F.lane]);
            lam = expf(a) - expf(c) + 0.2f; }
        float* stash = F.out + (size_t)blockIdx.x * 65536;
        const bool w_first = (((int)blockIdx.x >> 3) & 1) == 0;
        const int w_hi = (F.G == 256) ? P0_NITEMS - I_FF : P0_NITEMS;
        if (w_first) { p0_items(F, I_IN, w_hi, mx::opaque((int)threadIdx.x) & 63); __syncthreads(); }
        for (int id = F.vcu; id < 1024; id += F.G) { const int bh = id >> 5, b = bh >> 4, hh = bh & 15, px = hh & 7, xp = (b == 0) ? px : (int)((0x32017645u >> (4 * px)) & 7u), h = (hh < 8) ? xp : 15 - xp, qb = ((id & 31) + 16 * b) & 31;
            attn_unit(F.lds, G_DQ, G_DK, G_DV, G_DQ, stash, F.in[6], F.ctl + CW_NRM, b, h, qb, lam); }
        if (!w_first) { __syncthreads(); p0_items(F, I_IN, w_hi, mx::opaque((int)threadIdx.x) & 63); }
    }
    SEAM(4);
    if (IN(5)) ret_out_phase(F.lds, G_RQ, G_RK, G_RV, G_RG, ST, (bf16*)(F.ws + WS_YR), F.in[4], F.vcu, F.G);
    SEAM(5);
    if (IN(6)) { pg8::Gemm g{(const bf16*)(F.ws + WS_YR), WBR, NX, D, D}, g2{G_DQ, WBD, NX, D, D}; pg8::StaticOrder S; S.init(NX, D, F.G, (int)blockIdx.x, WGM_SQ); pg8::EpiMix2 E{G_GA, G_GB, MIXED};
        pg8::gemm_phase2<pg8::EpiMix2, pg8::StaticOrder, true, true>((PG8_LAS unsigned char*)F.lds, g, g2, S, E); }
    SEAM(6);
    if (IN(7)) { pg8::Gemm g{MIXED, WO, NX, D, D}; pg8::StaticOrder S; S.init(NX, D, F.G, (int)blockIdx.x, WGM_SQ); pg8::EpiResBf E{F.in[0], U2, (float*)(F.ws + WS_PS)};
        pg8::gemm_phase<pg8::EpiResBf, pg8::StaticOrder, true, true>((PG8_LAS unsigned char*)F.lds, g, S, E); }
    SEAM(7);
    if (IN(8)) { const float* PS = (const float*)(F.ws + WS_PS); float* RS = (float*)(F.ws + WS_RSTD);
        for (int row = F.vcu * 512 + F.tid; row < NX; row += F.G * 512) { const pg8::f32x4* p = (const pg8::f32x4*)(PS + (size_t)row * 64); float s = 0.f;
#pragma unroll
            for (int j = 0; j < 16; ++j) { const pg8::f32x4 v = p[j]; s += (v[0] + v[1]) + (v[2] + v[3]); }
            RS[row] = 1.0f / sqrtf(s * (1.f / D) + EPS); } }
    SEAM(8);
    if (IN(9)) { pg8::Gemm g{U2, WGU, NX, 2 * DFF, D}; pg8::StaticOrder S; S.init(NX, 2 * DFF, F.G, (int)blockIdx.x, WGM_P9); pg8::EpiSwiGLUr E{ACT, DFF, (const float*)(F.ws + WS_RSTD)};
        pg8::gemm_phase<pg8::EpiSwiGLUr, pg8::StaticOrder, true, true>((PG8_LAS unsigned char*)F.lds, g, S, E);
        if (F.G == 256 && (int)blockIdx.x >= 128) { __syncthreads(); p0_items(F, P0_NITEMS - I_FF, P0_NITEMS, mx::opaque((int)threadIdx.x) & 63, ((int)blockIdx.x - 128) * NWAVES + F.wave, 128 * NWAVES); } }
    SEAM(9);
    if (IN(10)) { pg8::Gemm g{ACT, WDN, NX, D, DFF}; pg8::StaticOrder S; S.init(NX, D, F.G, (int)blockIdx.x, WGM_P10); pg8::EpiResBf2 E{U2, (bf16*)(F.ws + WS_H2)};
        pg8::gemm_phase<pg8::EpiResBf2, pg8::StaticOrder, true, true>((PG8_LAS unsigned char*)F.lds, g, S, E); }
    SEAM(10);
    if (IN(11)) { const int gw = F.vcu * NWAVES + F.wave, NGW = F.G * NWAVES; const bf16* H2 = (const bf16*)(F.ws + WS_H2);
        for (int m = gw; m < NX; m += NGW) rms_row_bf(H2 + (size_t)m * D, F.in[14], F.out + (size_t)m * D, F.lane); }
#undef IN
#undef SEAM
}

extern "C" void kernel_launch(void* const* d_in, const int* in_sizes, int n_in, void* d_out, int out_size, void* d_ws, size_t ws_size, hipStream_t stream) {
    static int grid = 0;
    if (grid == 0) {
        if (n_in != 15 || in_sizes[0] != NX * D || out_size != NX * D || ws_size < WS_END) { fprintf(stderr, "kernel_launch: unexpected shapes (n_in %d, in0 %d, out %d, ws %zu)\n", n_in, n_in > 0 ? in_sizes[0] : -1, out_size, ws_size); grid = -1; return; }
        int dev = 0, cus = 0, per_cu = 0;
        if (hipGetDevice(&dev) != hipSuccess || hipDeviceGetAttribute(&cus, hipDeviceAttributeMultiprocessorCount, dev) != hipSuccess) { grid = -1; return; }
        if (hipFuncSetAttribute((const void*)fwd, hipFuncAttributeMaxDynamicSharedMemorySize, LDS_BYTES) != hipSuccess) { fprintf(stderr, "kernel_launch: hipFuncSetAttribute failed\n"); grid = -1; return; }
        if (hipOccupancyMaxActiveBlocksPerMultiprocessor(&per_cu, (const void*)fwd, NWAVES * 64, LDS_BYTES) != hipSuccess || per_cu < 1) fprintf(stderr, "kernel_launch: occupancy query reports %d\n", per_cu);
        (void)hipGetLastError();
        grid = cus;
    }
    if (grid < 0) return;
    if (hipMemsetAsync((char*)d_ws + WS_CTL, 0, CTL_ZERO_BYTES, stream) != hipSuccess) return;
    Args a{};
    for (int i = 0; i < 15; ++i) a.in[i] = (const float*)d_in[i];
    a.out = (float*)d_out; a.ws = (unsigned char*)d_ws;
#if MK_N_LAUNCHES == 1
    a.ph_lo = 0; a.ph_hi = NPH;
    hipLaunchKernelGGL(fwd, dim3(grid), dim3(NWAVES * 64), LDS_BYTES, stream, a);
#else
    for (int p = 0; p < NPH; ++p) { a.ph_lo = p; a.ph_hi = p + 1;
        hipLaunchKernelGGL(fwd, dim3(grid), dim3(NWAVES * 64), LDS_BYTES, stream, a); }
#endif
    const hipError_t le = hipPeekAtLastError();
    if (le != hipSuccess) fprintf(stderr, "kernel_launch: launch failed: %s\n", hipGetErrorName(le));
}
```
